# Optimizing an MI355X kernel written in HIP

```python
import math
import jax, jax.numpy as jnp
from jax import lax
import numpy as np

D_MODEL = 1024
BATCH = 2
SEQ = 8192
DEPTH = 4

CHUNK = 64
D_MIX = D_MODEL
W_GROUP = D_MIX // 4
RET_HEADS = 4
RET_DV = W_GROUP // RET_HEADS
RET_DK = RET_DV // 2
ROPE_BASE = 10000.0
CONF_CH = W_GROUP
CONF_KERNEL = 31
SC_CH = W_GROUP
SC_KERNEL = 3
FOX_HEADS = 4
FOX_DH = W_GROUP // FOX_HEADS
FOX_FORGET_BIAS = 3.0
Q_BLOCK = 128
N_EXPERTS = 32
TOP_K = 4
D_FF_EXPERT = D_MODEL
SWIGLU_ALPHA = 1.702
SWIGLU_LIMIT = 7.0
MOE_BLOCK = 128
DEEPNORM_ALPHA = (2 * DEPTH) ** 0.25
DEEPNORM_BETA = (8 * DEPTH) ** -0.25
LN_EPS = 1e-5
SPLIT_SIZES = (
    RET_HEADS * RET_DK, RET_HEADS * RET_DK, RET_HEADS * RET_DV, RET_HEADS * RET_DV,
    CONF_CH, CONF_CH,
    SC_CH, SC_CH, SC_CH,
    W_GROUP, W_GROUP, W_GROUP, FOX_HEADS,
)
D_IN = 2820

kernel_name = 'hybrid_ret_conv_fox_moe_deepnorm'


def layer_norm(x, g, b=None):
    xf = x.astype(jnp.float32)
    mu = jnp.mean(xf, axis=-1, keepdims=True)
    var = jnp.mean(jnp.square(xf - mu), axis=-1, keepdims=True)
    y = (xf - mu) * lax.rsqrt(var + LN_EPS) * g.astype(jnp.float32)
    if b is not None:
        y = y + b.astype(jnp.float32)
    return y.astype(x.dtype)


def causal_depthwise_conv(x, w):
    width = w.shape[0]
    return lax.conv_general_dilated(
        x, w[:, None, :].astype(x.dtype), window_strides=(1,), padding=((width - 1, 0),),
        dimension_numbers=('NWC', 'WIO', 'NWC'), feature_group_count=x.shape[-1])


def rope(x, pos):
    half = x.shape[-1] // 2
    freqs = ROPE_BASE ** (-jnp.arange(half, dtype=jnp.float32) / half)
    ang = pos.astype(jnp.float32)[:, None] * freqs[None, :]
    cos = jnp.cos(ang)[:, None, :].astype(x.dtype)
    sin = jnp.sin(ang)[:, None, :].astype(x.dtype)
    x1, x2 = x[..., :half], x[..., half:]
    return jnp.concatenate([x1 * cos - x2 * sin, x1 * sin + x2 * cos], axis=-1)


def chunk_retention(q, k, v):
    bsz, seq, heads, dk = q.shape
    dv = v.shape[-1]
    nc = seq // CHUNK
    log_g = jnp.log1p(-(2.0 ** (-5.0 - jnp.arange(heads, dtype=jnp.float32))))
    qc = q.reshape(bsz, nc, CHUNK, heads, dk)
    kc = k.reshape(bsz, nc, CHUNK, heads, dk)
    vc = v.reshape(bsz, nc, CHUNK, heads, dv)
    idx = jnp.arange(CHUNK, dtype=jnp.float32)
    dist = jnp.abs(idx[:, None] - idx[None, :])
    intra_decay = jnp.exp(log_g[:, None, None] * dist[None]).astype(q.dtype)
    scores = jnp.einsum('bcnhd,bcmhd->bchnm', qc, kc) * intra_decay
    o_intra = jnp.einsum('bchnm,bcmhe->bcnhe', scores, vc)
    k_decay = jnp.exp(log_g[None, :] * (CHUNK - 1 - idx)[:, None]).astype(k.dtype)
    kv = jnp.einsum('bcmhd,bcmhe->bchde', kc * k_decay[:, :, None], vc)
    chunk_decay = jnp.exp(log_g * CHUNK).astype(kv.dtype)[:, None, None]

    def step(state, kv_c):
        return chunk_decay * state + kv_c, state

    _, prev = lax.scan(step, jnp.zeros_like(kv[:, 0]), jnp.moveaxis(kv, 1, 0))
    prev = jnp.moveaxis(prev, 0, 1)
    q_decay = jnp.exp(log_g[None, :] * (idx + 1.0)[:, None]).astype(q.dtype)
    o_cross = jnp.einsum('bcnhd,bchde->bcnhe', qc * q_decay[:, :, None], prev)
    return (o_intra + o_cross).reshape(bsz, seq, heads, dv)


def forgetting_attention(q, k, v, log_f):
    bsz, seq, heads, dh = q.shape
    nb = seq // Q_BLOCK
    scale = dh ** -0.5
    F = jnp.cumsum(log_f, axis=1)
    Fk = jnp.transpose(F, (0, 2, 1))
    kpos = jnp.arange(seq)
    qb = jnp.moveaxis(q.reshape(bsz, nb, Q_BLOCK, heads, dh), 1, 0)
    Fb = jnp.moveaxis(F.reshape(bsz, nb, Q_BLOCK, heads), 1, 0)
    posb = kpos.reshape(nb, Q_BLOCK)

    def block(args):
        qi, Fi, pi = args
        s = jnp.einsum('bqhd,bkhd->bhqk', qi, k).astype(jnp.float32) * scale
        s = s + jnp.transpose(Fi, (0, 2, 1))[..., None] - Fk[:, :, None, :]
        s = jnp.where(kpos[None, None, None, :] <= pi[None, None, :, None], s, -jnp.inf)
        p = jax.nn.softmax(s, axis=-1).astype(v.dtype)
        return jnp.einsum('bhqk,bkhd->bqhd', p, v)

    out = lax.map(block, (qb, Fb, posb))
    return jnp.moveaxis(out, 0, 1).reshape(bsz, seq, heads, dh)


def hybrid_mixer(h, w_in, fox_b_f, conf_dw, conf_dw_b, conf_ln_g, conf_ln_b, sc_dw, ret_gn_g, w_o):
    bsz, seq, _ = h.shape
    proj = h @ w_in
    (ret_q, ret_k, ret_v, ret_g, conf_a, conf_b, sc_b, sc_c, sc_h,
     fox_q, fox_k, fox_v, fox_f) = jnp.split(proj, [int(i) for i in np.cumsum(SPLIT_SIZES)[:-1]], axis=-1)
    pos = jnp.arange(seq)
    rq = rope(ret_q.reshape(bsz, seq, RET_HEADS, RET_DK), pos)
    rk = rope(ret_k.reshape(bsz, seq, RET_HEADS, RET_DK), pos) * (RET_DK ** -0.5)
    rv = ret_v.reshape(bsz, seq, RET_HEADS, RET_DV)
    ro = layer_norm(chunk_retention(rq, rk, rv), ret_gn_g.reshape(RET_HEADS, RET_DV))
    ret_out = jax.nn.silu(ret_g) * ro.reshape(bsz, seq, W_GROUP)
    u = conf_a * jax.nn.sigmoid(conf_b)
    u = causal_depthwise_conv(u, conf_dw) + conf_dw_b
    conf_out = jax.nn.silu(layer_norm(u, conf_ln_g, conf_ln_b))
    sc_out = sc_b * causal_depthwise_conv(sc_c * sc_h, sc_dw)
    log_f = jax.nn.log_sigmoid((fox_f + fox_b_f).astype(jnp.float32))
    fo = forgetting_attention(fox_q.reshape(bsz, seq, FOX_HEADS, FOX_DH),
                              fox_k.reshape(bsz, seq, FOX_HEADS, FOX_DH),
                              fox_v.reshape(bsz, seq, FOX_HEADS, FOX_DH), log_f)
    fox_out = fo.reshape(bsz, seq, W_GROUP)
    mixed = jnp.concatenate([ret_out, conf_out, sc_out, fox_out], axis=-1)
    return mixed @ w_o


def moe_ffn(x, router_w, router_b, w1, b1, w2, b2):
    bsz, seq, d = x.shape
    n_tok = bsz * seq
    nk = n_tok * TOP_K
    xf = x.reshape(n_tok, d)
    logits = (xf @ router_w + router_b).astype(jnp.float32)
    top_v, top_i = lax.top_k(logits, TOP_K)
    gates = jax.nn.softmax(top_v, axis=-1)
    flat_e = top_i.reshape(-1).astype(jnp.int32)
    flat_tok = jnp.arange(nk, dtype=jnp.int32) // TOP_K
    order = jnp.argsort(flat_e)
    se, stok, sg = flat_e[order], flat_tok[order], gates.reshape(-1)[order]
    counts = jnp.bincount(flat_e, length=N_EXPERTS).astype(jnp.int32)
    padded = (counts + MOE_BLOCK - 1) // MOE_BLOCK * MOE_BLOCK
    start_sorted = jnp.cumsum(counts) - counts
    cum_pad = jnp.cumsum(padded)
    start_pad = cum_pad - padded
    dest = start_pad[se] + jnp.arange(nk, dtype=jnp.int32) - start_sorted[se]
    n_blocks = -(-nk // MOE_BLOCK) + N_EXPERTS
    n_rows = n_blocks * MOE_BLOCK
    row_tok = jnp.full((n_rows,), n_tok, jnp.int32).at[dest].set(stok)
    row_gate = jnp.zeros((n_rows,), jnp.float32).at[dest].set(sg)
    block_e = jnp.minimum(jnp.searchsorted(cum_pad, jnp.arange(n_blocks, dtype=jnp.int32) * MOE_BLOCK,
                                           side='right'), N_EXPERTS - 1).astype(jnp.int32)
    x_pad = jnp.concatenate([xf, jnp.zeros((1, d), xf.dtype)], axis=0)
    xb = x_pad[row_tok].reshape(n_blocks, MOE_BLOCK, d)

    def expert_block(args):
        xblk, e = args
        hdn = xblk @ w1[e] + b1[e]
        glu, lin = hdn[:, :D_FF_EXPERT], hdn[:, D_FF_EXPERT:]
        glu = jnp.minimum(glu, SWIGLU_LIMIT)
        lin = jnp.clip(lin, -SWIGLU_LIMIT, SWIGLU_LIMIT)
        act = glu * jax.nn.sigmoid(SWIGLU_ALPHA * glu) * (lin + 1.0)
        return act @ w2[e] + b2[e]

    yb = lax.map(expert_block, (xb, block_e))
    y = yb.reshape(n_rows, d) * row_gate[:, None].astype(yb.dtype)
    out = jnp.zeros((n_tok + 1, d), y.dtype).at[row_tok].add(y)[:n_tok]
    return out.reshape(bsz, seq, d)


def setup_inputs(seed: int = 0) -> dict:
    key = jax.random.key(seed)
    ks = jax.random.split(key, 20)
    L = DEPTH

    def nrm(k, shape, scale):
        return scale * jax.random.normal(k, shape, jnp.float32)

    return {
        'x': nrm(ks[0], (BATCH, SEQ, D_MODEL), 1.0),
        'w_in': nrm(ks[1], (L, D_MODEL, D_IN), D_MODEL ** -0.5),
        'fox_b_f': FOX_FORGET_BIAS + nrm(ks[2], (L, FOX_HEADS), 0.1),
        'conf_dw': nrm(ks[3], (L, CONF_KERNEL, CONF_CH), CONF_KERNEL ** -0.5),
        'conf_dw_b': nrm(ks[4], (L, CONF_CH), 0.02),
        'conf_ln_g': 1.0 + nrm(ks[5], (L, CONF_CH), 0.05),
        'conf_ln_b': nrm(ks[6], (L, CONF_CH), 0.02),
        'sc_dw': nrm(ks[7], (L, SC_KERNEL, SC_CH), SC_KERNEL ** -0.5),
        'ret_gn_g': 1.0 + nrm(ks[8], (L, W_GROUP), 0.05),
        'w_o': nrm(ks[9], (L, D_MIX, D_MODEL), DEEPNORM_BETA * D_MIX ** -0.5),
        'ln1_g': 1.0 + nrm(ks[10], (L, D_MODEL), 0.05),
        'ln1_b': nrm(ks[11], (L, D_MODEL), 0.02),
        'router_w': nrm(ks[12], (L, D_MODEL, N_EXPERTS), D_MODEL ** -0.5),
        'router_b': nrm(ks[13], (L, N_EXPERTS), 0.01),
        'w1': nrm(ks[14], (L, N_EXPERTS, D_MODEL, 2 * D_FF_EXPERT), D_MODEL ** -0.5),
        'b1': nrm(ks[15], (L, N_EXPERTS, 2 * D_FF_EXPERT), 0.02),
        'w2': nrm(ks[16], (L, N_EXPERTS, D_FF_EXPERT, D_MODEL), DEEPNORM_BETA * D_FF_EXPERT ** -0.5),
        'b2': nrm(ks[17], (L, N_EXPERTS, D_MODEL), 0.02),
        'ln2_g': 1.0 + nrm(ks[18], (L, D_MODEL), 0.05),
        'ln2_b': nrm(ks[19], (L, D_MODEL), 0.02),
    }


def reference(x, w_in, fox_b_f, conf_dw, conf_dw_b, conf_ln_g, conf_ln_b, sc_dw, ret_gn_g, w_o,
              ln1_g, ln1_b, router_w, router_b, w1, b1, w2, b2, ln2_g, ln2_b):
    for l in range(DEPTH):
        mix = hybrid_mixer(x, w_in[l], fox_b_f[l], conf_dw[l], conf_dw_b[l], conf_ln_g[l], conf_ln_b[l],
                           sc_dw[l], ret_gn_g[l], w_o[l])
        x = layer_norm(DEEPNORM_ALPHA * x + mix, ln1_g[l], ln1_b[l])
        ffn = moe_ffn(x, router_w[l], router_b[l], w1[l], b1[l], w2[l], b2[l])
        x = layer_norm(DEEPNORM_ALPHA * x + ffn, ln2_g[l], ln2_b[l])
    return x
```

```cpp
#include <hip/hip_runtime.h>
#include <cstdio>
#include <cstdint>
#include <cmath>
namespace pg8 {
#define PG8_LAS __attribute__((address_space(3)))
typedef unsigned short bf16_t;
typedef short bf16x8 __attribute__((ext_vector_type(8)));
typedef float f32x4 __attribute__((ext_vector_type(4)));
typedef unsigned u32x4 __attribute__((ext_vector_type(4)));
constexpr int BM = 256, BK = 64, HALF = 128, HTB = HALF * BK * 2  , STAGE_BYTES = 8 * HTB, NXCD = 8, WGM = 8;

__host__ __device__ __forceinline__ int lds_byte(int r, int c) { const int st = (r >> 4) * 2 + (c >> 5), rr = r & 15, cc = c & 31, ob = rr * 64 + cc * 2; return st * 1024 + (ob ^ (((ob >> 9) & 1) << 5)); }
__host__ __device__ __forceinline__ void stage_rc(int b, int& R, int& C) { const int st = b / 1024, sb = b % 1024, swz = sb ^ (((sb >> 9) & 1) << 5); R = (st >> 1) * 16 + swz / 64; C = (st & 1) * 32 + (swz % 64) / 2; }
__host__ __device__ __forceinline__ int perm32(int rho) { const int n = rho >> 4, i = rho & 15; return 8 * (i >> 2) + 4 * n + (i & 3); }

struct Unit { int pm, pn; };
struct Gemm { const bf16_t* A; const bf16_t* Bt; int M, N, K; };

struct StaticOrder {
    int nM, nN, nwg, G, c;
    __host__ __device__ void init(int M, int N, int G_, int c_) { nM = M / BM; nN = N / BM; nwg = nM * nN; G = G_; c = c_; }
    __host__ __device__ bool next(int i, Unit& u) const {
        const long L = (long)i * G + c; if (L >= nwg) return false;
        int wgid = (int)L; { const int q = nwg / NXCD, r = nwg % NXCD, xcd = wgid % NXCD, off = wgid / NXCD; wgid = (xcd < r ? xcd * (q + 1) : r * (q + 1) + (xcd - r) * q) + off; }
        const int nig = WGM * nN, gid = wgid / nig, fm = gid * WGM, gsz = (nM - fm) < WGM ? (nM - fm) : WGM;
        u.pm = fm + ((wgid % nig) % gsz); u.pn = (wgid % nig) / gsz; return true;
    }
    __device__ __forceinline__ void a_ready(const Unit&) const {}
    __device__ __forceinline__ void done(const Unit&) const {}
};

__device__ __forceinline__ unsigned cvt_pk_bf16(float lo, float hi) { unsigned r; asm volatile("v_cvt_pk_bf16_f32 %0, %1, %2" : "=v"(r) : "v"(lo), "v"(hi)); return r; }
typedef float f32x2 __attribute__((ext_vector_type(2)));
__device__ __forceinline__ f32x2 gelu_pk(f32x2 v) {
    const f32x2 av = __builtin_elementwise_abs(v), d = av * 0.2316418882f + 1.0f;
    f32x2 t; t.x = __builtin_amdgcn_rcpf(d.x); t.y = __builtin_amdgcn_rcpf(d.y);
    f32x2 q = t * 0.5307027145f + (-0.7265760135f); q = q * t + 0.7107068705f; q = q * t + (-0.142248368f); q = q * t + 0.127414796f; q = q * t;
    const f32x2 s = (v * v) * (-0.72134752044f);
    f32x2 e; e.x = __builtin_amdgcn_exp2f(s.x); e.y = __builtin_amdgcn_exp2f(s.y);
    const f32x2 m = v * (q * e), r = v - m;
    f32x2 o; o.x = v.x < 0.f ? m.x : r.x; o.y = v.y < 0.f ? m.y : r.y; return o;
}

template <int ACT  > struct EpiBf16 {
    static constexpr bool PERM = true, AFTER_DRAIN = false; static_assert(ACT == 0 || ACT == 1, "EpiBf16: ACT is 0 (none) or 1 (gelu_pk)");
    bf16_t* O; int ldc; const float* bias; int split_cols; size_t split_stride; float scale0;
    __device__ __forceinline__ void operator()(const f32x4 (&acc)[2][2][4][2], const Unit& u, int wr, int wc, int fr, int fq) const {
        const int row0 = u.pm * BM + wr * 64 + fr; int colt = u.pn * BM; bf16_t* base = O;
        float sc = 1.f; if (split_cols) { const int t = colt / split_cols; base += (size_t)t * split_stride; colt -= t * split_cols; if (t == 0) sc = scale0; }
        const int col0 = colt + wc * 32 + 8 * fq, bcol0 = u.pn * BM + wc * 32 + 8 * fq;
        f32x4 bv[2][2];
#pragma unroll
        for (int bj = 0; bj < 2; ++bj)
#pragma unroll
            for (int n = 0; n < 2; ++n) bv[bj][n] = bias ? *(const f32x4*)(bias + bcol0 + bj * HALF + 4 * n) : (f32x4){0.f, 0.f, 0.f, 0.f};
#pragma unroll
        for (int ai = 0; ai < 2; ++ai)
#pragma unroll
            for (int m = 0; m < 4; ++m) { bf16_t* rowp = base + (size_t)(row0 + ai * HALF + m * 16) * ldc + col0;
#pragma unroll
                for (int bj = 0; bj < 2; ++bj) { f32x4 v0 = acc[ai][bj][m][0] + bv[bj][0], v1 = acc[ai][bj][m][1] + bv[bj][1];
                    if (ACT == 1) { f32x2 a = gelu_pk((f32x2){v0[0], v0[1]}), b = gelu_pk((f32x2){v0[2], v0[3]}), c = gelu_pk((f32x2){v1[0], v1[1]}), d = gelu_pk((f32x2){v1[2], v1[3]});
                        v0 = (f32x4){a.x, a.y, b.x, b.y}; v1 = (f32x4){c.x, c.y, d.x, d.y}; }
                    v0 = v0 * sc; v1 = v1 * sc; u32x4 w; w.x = cvt_pk_bf16(v0[0], v0[1]); w.y = cvt_pk_bf16(v0[2], v0[3]); w.z = cvt_pk_bf16(v1[0], v1[1]); w.w = cvt_pk_bf16(v1[2], v1[3]);
                    *(u32x4*)(rowp + bj * HALF) = w; } }
    }
};

struct PanelStats {
    unsigned* xbuf;
    unsigned* cnt;
    unsigned* tmo;
    int ntn; float eps;
    unsigned code;
    __device__ __forceinline__ bool run(const f32x4 (&v)[2][2][4][2], const Unit& u, int wr, int wc, int fr, int fq, PG8_LAS unsigned char* lds, int wid, int lane) const {
        typedef float f32x2v __attribute__((ext_vector_type(2)));
        PG8_LAS f32x2v* P = (PG8_LAS f32x2v*)lds;
        PG8_LAS f32x2v* S = (PG8_LAS f32x2v*)(lds + 8192);
        PG8_LAS unsigned* flag = (PG8_LAS unsigned*)(lds + 8192 + 2048);
#pragma unroll
        for (int ai = 0; ai < 2; ++ai)
#pragma unroll
            for (int m = 0; m < 4; ++m) {
                float s = 0.f;
#pragma unroll
                for (int bj = 0; bj < 2; ++bj)
#pragma unroll
                    for (int n = 0; n < 2; ++n) { const f32x4 x = v[ai][bj][m][n]; s += (x[0] + x[1]) + (x[2] + x[3]); }
                s += __shfl_xor(s, 16); s += __shfl_xor(s, 32);
                const float mw = s * (1.0f / 64.0f); float q = 0.f;
#pragma unroll
                for (int bj = 0; bj < 2; ++bj)
#pragma unroll
                    for (int n = 0; n < 2; ++n) { const f32x4 d = v[ai][bj][m][n] - mw; q += (d[0] * d[0] + d[1] * d[1]) + (d[2] * d[2] + d[3] * d[3]); }
                q += __shfl_xor(q, 16); q += __shfl_xor(q, 32);
                if (fq == 0) P[(ai * HALF + wr * 64 + m * 16 + fr) * 4 + wc] = (f32x2v){mw, q};
            }
        asm volatile("s_waitcnt lgkmcnt(0)" ::: "memory"); __builtin_amdgcn_s_barrier(); asm volatile("" ::: "memory");
#if defined(BROKEN_EXCHANGE_NO_WAIT)
#warning BROKEN CONTROL BUILD: the row-statistics exchange does not wait; results are wrong by design
        if (blockIdx.x >= 64) { const long long t0_ = clock64(); while (clock64() - t0_ < 60000) __builtin_amdgcn_s_sleep(8); }
#endif
        const int row = wid * 32 + (lane & 31);
        if (lane < 32) {
            const f32x2v a = P[row * 4 + 0], b = P[row * 4 + 1], c = P[row * 4 + 2], d = P[row * 4 + 3];
            const float mt = (a.x + b.x + c.x + d.x) * 0.25f;
            const float da = a.x - mt, db = b.x - mt, dc = c.x - mt, dd = d.x - mt;
            const float m2 = (a.y + b.y) + (c.y + d.y) + 64.0f * ((da * da + db * db) + (dc * dc + dd * dd));
            unsigned long long* slot = (unsigned long long*)xbuf + ((size_t)(u.pm * BM + row) * 4 + u.pn);
            __hip_atomic_store(slot, ((unsigned long long)__float_as_uint(m2) << 32) | __float_as_uint(mt), __ATOMIC_RELAXED, __HIP_MEMORY_SCOPE_AGENT);
        }
        asm volatile("s_waitcnt vmcnt(0)" ::: "memory");
        if (lane == 0) __hip_atomic_fetch_add(cnt + 64 * u.pm, 1u, __ATOMIC_RELAXED, __HIP_MEMORY_SCOPE_AGENT);
        if (wid == 0) {
            bool dead = false; const unsigned long long t0 = __builtin_amdgcn_s_memrealtime(); const unsigned want = 8u * (unsigned)ntn;
            for (;;) {
#if defined(BROKEN_EXCHANGE_NO_WAIT)
                break;
#endif
                if ((unsigned)__builtin_amdgcn_readfirstlane(__hip_atomic_load(cnt + 64 * u.pm, __ATOMIC_RELAXED, __HIP_MEMORY_SCOPE_AGENT)) >= want) break;
                if (__builtin_amdgcn_s_memrealtime() - t0 > 2000000ull) {
                    if (lane == 0) { unsigned expect = 0u; __hip_atomic_compare_exchange_strong(tmo + 1, &expect, code | (unsigned)(u.pm & 0xff), __ATOMIC_RELAXED, __ATOMIC_RELAXED, __HIP_MEMORY_SCOPE_AGENT);
                                     __hip_atomic_store(tmo, 1u, __ATOMIC_RELAXED, __HIP_MEMORY_SCOPE_AGENT); }
                    dead = true; break; }
                __builtin_amdgcn_s_sleep(2);
            }
            __builtin_amdgcn_fence(__ATOMIC_ACQUIRE, "agent");
            if (lane == 0) flag[0] = dead ? 1u : 0u;
        }
        asm volatile("s_waitcnt vmcnt(0) lgkmcnt(0)" ::: "memory"); __builtin_amdgcn_s_barrier(); asm volatile("" ::: "memory");
        const bool bad = flag[0] != 0u;
        if (lane < 32) {
            const unsigned long long* slot = (const unsigned long long*)xbuf + (size_t)(u.pm * BM + row) * 4; float mt[4], m2[4]; float ms = 0.f;
#pragma unroll
            for (int t = 0; t < 4; ++t) { if (t < ntn) { const unsigned long long w = __hip_atomic_load(slot + t, __ATOMIC_RELAXED, __HIP_MEMORY_SCOPE_AGENT); mt[t] = __uint_as_float((unsigned)w); m2[t] = __uint_as_float((unsigned)(w >> 32)); } else { mt[t] = 0.f; m2[t] = 0.f; } ms += mt[t]; }
            const float mean = ms / (float)ntn; float q = 0.f;
#pragma unroll
            for (int t = 0; t < 4; ++t) if (t < ntn) { const float dm = mt[t] - mean; q += m2[t] + 256.0f * dm * dm; }
            S[row] = (f32x2v){mean, 1.0f / sqrtf(q / (256.0f * (float)ntn) + eps)};
        }
        asm volatile("s_waitcnt lgkmcnt(0)" ::: "memory"); __builtin_amdgcn_s_barrier(); asm volatile("" ::: "memory");
        return bad;
    }
};
struct EpiLnRes {
    static constexpr bool PERM = false, AFTER_DRAIN = true;
    const float* base; float* out; int ldc; const float* bias; PanelStats st; unsigned poison;
    __device__ __forceinline__ void fused(f32x4 (&acc)[2][2][4][2], const Unit& u, int wr, int wc, int fr, int fq, PG8_LAS unsigned char* lds, int wid, int lane) const {
        typedef float f32x2v __attribute__((ext_vector_type(2)));
        const PG8_LAS f32x2v* S = (const PG8_LAS f32x2v*)(lds + 8192);
        const int col0 = u.pn * BM + wc * 32 + 4 * fq;
#pragma unroll
        for (int bj = 0; bj < 2; ++bj)
#pragma unroll
            for (int n = 0; n < 2; ++n) { const f32x4 bv = bias ? *(const f32x4*)(bias + col0 + bj * HALF + n * 16) : (f32x4){0.f, 0.f, 0.f, 0.f};
#pragma unroll
                for (int ai = 0; ai < 2; ++ai)
#pragma unroll
                    for (int m = 0; m < 4; ++m) acc[ai][bj][m][n] += bv; }
        f32x4 pre[4][2][2];
#pragma unroll
        for (int m = 0; m < 4; ++m) { const size_t off = (size_t)(u.pm * BM + wr * 64 + m * 16 + fr) * ldc + col0;
#pragma unroll
            for (int bj = 0; bj < 2; ++bj)
#pragma unroll
                for (int n = 0; n < 2; ++n) pre[m][bj][n] = *(const f32x4*)(base + off + bj * HALF + n * 16); }
        const bool bad = st.run(acc, u, wr, wc, fr, fq, lds, wid, lane) || poison != 0u;
        const float qnan = __builtin_nanf("");
#pragma unroll
        for (int ai = 0; ai < 2; ++ai)
#pragma unroll
            for (int m = 0; m < 4; ++m) { const int r = ai * HALF + wr * 64 + m * 16 + fr; const f32x2v sr = S[r]; const size_t off = (size_t)(u.pm * BM + r) * ldc + col0;
#pragma unroll
                for (int bj = 0; bj < 2; ++bj)
#pragma unroll
                    for (int n = 0; n < 2; ++n) { const f32x4 bs = ai == 0 ? pre[m][bj][n] : *(const f32x4*)(base + off + bj * HALF + n * 16); f32x4 o = bs + (acc[ai][bj][m][n] - sr.x) * sr.y;
                        if (bad) o = (f32x4){qnan, qnan, qnan, qnan}; *(f32x4*)(out + off + bj * HALF + n * 16) = o; }
                if (m & 1) asm volatile("" ::: "memory"); }
    }
};
struct EpiLnResLn {
    static constexpr bool PERM = false, AFTER_DRAIN = true;
    const float* base; float* out; bf16_t* xn; int ldc; const float* bias; PanelStats st1, st2; unsigned poison;
    __device__ __forceinline__ void fused(f32x4 (&acc)[2][2][4][2], const Unit& u, int wr, int wc, int fr, int fq, PG8_LAS unsigned char* lds, int wid, int lane) const {
        typedef float f32x2v __attribute__((ext_vector_type(2))); typedef unsigned u32x2v __attribute__((ext_vector_type(2)));
        const PG8_LAS f32x2v* S = (const PG8_LAS f32x2v*)(lds + 8192);
        const int col0 = u.pn * BM + wc * 32 + 4 * fq;
#pragma unroll
        for (int bj = 0; bj < 2; ++bj)
#pragma unroll
            for (int n = 0; n < 2; ++n) { const f32x4 bv = bias ? *(const f32x4*)(bias + col0 + bj * HALF + n * 16) : (f32x4){0.f, 0.f, 0.f, 0.f};
#pragma unroll
                for (int ai = 0; ai < 2; ++ai)
#pragma unroll
                    for (int m = 0; m < 4; ++m) acc[ai][bj][m][n] += bv; }
        bool bad = st1.run(acc, u, wr, wc, fr, fq, lds, wid, lane) || poison != 0u;
        const float qnan = __builtin_nanf("");
#pragma unroll
        for (int ai = 0; ai < 2; ++ai)
#pragma unroll
            for (int m = 0; m < 4; ++m) { const int r = ai * HALF + wr * 64 + m * 16 + fr; const f32x2v sr = S[r]; const size_t off = (size_t)(u.pm * BM + r) * ldc + col0;
#pragma unroll
                for (int bj = 0; bj < 2; ++bj)
#pragma unroll
                    for (int n = 0; n < 2; ++n) { const f32x4 bs = *(const f32x4*)(base + off + bj * HALF + n * 16); acc[ai][bj][m][n] = bs + (acc[ai][bj][m][n] - sr.x) * sr.y; }
                asm volatile("" : "+v"(acc[ai][0][m][0]), "+v"(acc[ai][0][m][1]), "+v"(acc[ai][1][m][0]), "+v"(acc[ai][1][m][1]));
                if (m & 1) asm volatile("" ::: "memory"); }
        const bool bad1 = bad;
        bad = st2.run(acc, u, wr, wc, fr, fq, lds, wid, lane) || bad;
#pragma unroll
        for (int ai = 0; ai < 2; ++ai)
#pragma unroll
            for (int m = 0; m < 4; ++m) { const int r = ai * HALF + wr * 64 + m * 16 + fr; const f32x2v sr = S[r]; const size_t off = (size_t)(u.pm * BM + r) * ldc + col0;
#pragma unroll
                for (int bj = 0; bj < 2; ++bj)
#pragma unroll
                    for (int n = 0; n < 2; ++n) { const f32x4 x1 = acc[ai][bj][m][n]; *(f32x4*)(out + off + bj * HALF + n * 16) = bad1 ? (f32x4){qnan, qnan, qnan, qnan} : x1;
                        const f32x4 o = (x1 - sr.x) * sr.y; u32x2v w; w.x = cvt_pk_bf16(o[0], o[1]); w.y = cvt_pk_bf16(o[2], o[3]);
                        if (bad) { w.x = 0x7fc07fc0u; w.y = 0x7fc07fc0u; } *(u32x2v*)(xn + off + bj * HALF + n * 16) = w; }
                asm volatile("" ::: "memory"); }
    }
};

template <class Epi, class Sched, bool ALIGN_EPI = false, bool SP2 = false>
__device__ __forceinline__ void gemm_phase(PG8_LAS unsigned char* lds, const Gemm g, const Sched& S, const Epi& E) {
    const int tid = threadIdx.x, wid = __builtin_amdgcn_readfirstlane(tid >> 6), lane = tid & 63, wr = wid >> 2, wc = wid & 3, fr = lane & 15, fq = lane >> 4;
    const int K = g.K, nt = K / BK;
    unsigned voffA[2], voffB[2];
#pragma unroll
    for (int i = 0; i < 2; ++i) { int R, C; stage_rc(tid * 16 + i * 8192, R, C); const int Rb = Epi::PERM ? ((R & ~31) + perm32(R & 31)) : R;
        voffA[i] = (unsigned)(R * K + C) * 2u; voffB[i] = (unsigned)(Rb * K + C) * 2u; }
    const size_t kstep = (size_t)(BK * 2);
    const size_t hstep = (size_t)HALF * K * 2;
    const size_t tstep = 2 * hstep;
    const unsigned ldsw = (unsigned)wid * 1024u;
    const int aoff = lds_byte(wr * 64 + fr, fq * 8), boff = lds_byte(wc * 32 + fr, fq * 8);
#define PG8_SA(b, h) (((b) * 2 + (h)) * HTB)
#define PG8_SB(b, h) ((4 + (b) * 2 + (h)) * HTB)
#define PG8_STAGE(bufoff, gbase, voff) do { _Pragma("unroll") for (int _i = 0; _i < 2; ++_i) \
        __builtin_amdgcn_global_load_lds((const unsigned*)((const char*)(gbase) + (voff)[_i]), (PG8_LAS unsigned*)(lds + (bufoff) + ldsw + _i * 8192), 16, 0, 0); } while (0)
#define PG8_LDA(dst, b, h) do { _Pragma("unroll") for (int m = 0; m < 4; ++m) _Pragma("unroll") for (int k = 0; k < 2; ++k) dst[m][k] = *(const PG8_LAS bf16x8*)(lds + PG8_SA(b, h) + aoff + m * 2048 + k * 1024); } while (0)
#define PG8_LDB(dst, b, h) do { _Pragma("unroll") for (int n = 0; n < 2; ++n) _Pragma("unroll") for (int k = 0; k < 2; ++k) dst[n][k] = *(const PG8_LAS bf16x8*)(lds + PG8_SB(b, h) + boff + n * 2048 + k * 1024); } while (0)
#define PG8_MMA(ai, bj, At, Bt) do { __builtin_amdgcn_s_setprio(1); _Pragma("unroll") for (int m = 0; m < 4; ++m) _Pragma("unroll") for (int n = 0; n < 2; ++n) _Pragma("unroll") for (int k = 0; k < 2; ++k) \
        acc[ai][bj][m][n] = __builtin_amdgcn_mfma_f32_16x16x32_bf16(Bt[n][k], At[m][k], acc[ai][bj][m][n], 0, 0, 0); __builtin_amdgcn_s_setprio(0); } while (0)
#define PG8_WAIT_V(n) asm volatile("s_waitcnt vmcnt(" #n ")" ::: "memory")
#define PG8_WAIT_L(n) asm volatile("s_waitcnt lgkmcnt(" #n ")" ::: "memory")
#define PG8_BAR __builtin_amdgcn_s_barrier()
#define PG8_SCHED __builtin_amdgcn_sched_barrier(0)
    Unit cur, nxt; int ui = 0;
    if (!S.next(0, cur)) return;
    f32x4 acc[2][2][4][2];
#pragma unroll
    for (int a = 0; a < 2; ++a)
#pragma unroll
        for (int b = 0; b < 2; ++b)
#pragma unroll
            for (int m = 0; m < 4; ++m)
#pragma unroll
                for (int n = 0; n < 2; ++n) acc[a][b][m][n] = (f32x4){0.f, 0.f, 0.f, 0.f};
    bf16x8 At[4][2], B0[2][2], B1[2][2];
    const char* cA = (const char*)g.A + (size_t)cur.pm * tstep; const char* cB = (const char*)g.Bt + (size_t)cur.pn * tstep;
    S.a_ready(cur);
    if constexpr (SP2) {
        PG8_STAGE(PG8_SB(0, 0), cB, voffB); PG8_STAGE(PG8_SB(0, 1), cB + hstep, voffB); PG8_STAGE(PG8_SA(0, 0), cA, voffA); PG8_STAGE(PG8_SA(0, 1), cA + hstep, voffA);
        if (wr == 1) PG8_BAR;
        PG8_WAIT_V(2); PG8_BAR;
        PG8_STAGE(PG8_SB(1, 0), cB + kstep, voffB); PG8_STAGE(PG8_SA(1, 0), cA + kstep, voffA); PG8_STAGE(PG8_SB(1, 1), cB + hstep + kstep, voffB);
        PG8_WAIT_V(6); PG8_BAR;
    } else {
        PG8_STAGE(PG8_SB(0, 0), cB, voffB); PG8_STAGE(PG8_SA(0, 0), cA, voffA); PG8_STAGE(PG8_SB(0, 1), cB + hstep, voffB); PG8_STAGE(PG8_SA(0, 1), cA + hstep, voffA);
        if (wr == 1) PG8_BAR;
        PG8_WAIT_V(4); PG8_BAR;
        PG8_STAGE(PG8_SB(1, 0), cB + kstep, voffB); PG8_STAGE(PG8_SA(1, 0), cA + kstep, voffA); PG8_STAGE(PG8_SB(1, 1), cB + hstep + kstep, voffB);
        PG8_WAIT_V(6); PG8_BAR;
    }
    for (;;) {
        const bool has_next = S.next(ui + 1, nxt);
        const char* nA = has_next ? (const char*)g.A + (size_t)nxt.pm * tstep : cA; const char* nB = has_next ? (const char*)g.Bt + (size_t)nxt.pn * tstep : cB;
        for (int t = 0; t < nt; t += 2) {
            const bool last = (t == nt - 2);
            const char* a1 = cA + (size_t)(t + 1) * kstep;
            const char* a2 = last ? nA : cA + (size_t)(t + 2) * kstep; const char* b2 = last ? nB : cB + (size_t)(t + 2) * kstep;
            const char* a3 = a2 + kstep; const char* b3 = b2 + kstep;
            if (last && has_next) S.a_ready(nxt);
            if constexpr (SP2) {
            PG8_LDB(B0, 0, 0); PG8_LDB(B1, 0, 1); PG8_SCHED; PG8_LDA(At, 0, 0); PG8_STAGE(PG8_SA(1, 1), a1 + hstep, voffA);
            PG8_WAIT_V(8); PG8_WAIT_L(0); PG8_BAR; PG8_MMA(0, 0, At, B0); PG8_MMA(0, 1, At, B1); PG8_BAR; PG8_SCHED;
            PG8_LDA(At, 0, 1); PG8_STAGE(PG8_SB(0, 0), b2, voffB); PG8_STAGE(PG8_SB(0, 1), b2 + hstep, voffB); PG8_STAGE(PG8_SA(0, 0), a2, voffA);
            PG8_WAIT_V(8); PG8_WAIT_L(0); PG8_BAR; PG8_MMA(1, 0, At, B0); PG8_MMA(1, 1, At, B1); PG8_BAR; PG8_SCHED;
            PG8_LDB(B0, 1, 0); PG8_LDB(B1, 1, 1); PG8_SCHED; PG8_LDA(At, 1, 0); PG8_STAGE(PG8_SA(0, 1), a2 + hstep, voffA);
            PG8_WAIT_V(8); PG8_WAIT_L(0); PG8_BAR; PG8_MMA(0, 0, At, B0); PG8_MMA(0, 1, At, B1); PG8_BAR; PG8_SCHED;
            PG8_LDA(At, 1, 1); PG8_STAGE(PG8_SB(1, 0), b3, voffB); PG8_STAGE(PG8_SB(1, 1), b3 + hstep, voffB); PG8_STAGE(PG8_SA(1, 0), a3, voffA);
            PG8_WAIT_V(8); PG8_WAIT_L(0); PG8_BAR; PG8_MMA(1, 0, At, B0); PG8_MMA(1, 1, At, B1); PG8_BAR; PG8_SCHED;
            } else {
            PG8_LDB(B0, 0, 0); PG8_SCHED; PG8_LDA(At, 0, 0); PG8_STAGE(PG8_SA(1, 1), a1 + hstep, voffA);
            PG8_WAIT_L(8); PG8_BAR; PG8_WAIT_L(0); PG8_MMA(0, 0, At, B0); PG8_BAR; PG8_SCHED;
            PG8_LDB(B1, 0, 1); PG8_STAGE(PG8_SB(0, 0), b2, voffB);
            PG8_BAR; PG8_WAIT_L(0); PG8_MMA(0, 1, At, B1); PG8_BAR;
            PG8_LDA(At, 0, 1); PG8_STAGE(PG8_SA(0, 0), a2, voffA);
            PG8_BAR; PG8_WAIT_L(0); PG8_MMA(1, 0, At, B0); PG8_BAR; PG8_SCHED;
            PG8_STAGE(PG8_SB(0, 1), b2 + hstep, voffB);
            PG8_WAIT_V(6); PG8_BAR; PG8_MMA(1, 1, At, B1); PG8_BAR;
            PG8_LDB(B0, 1, 0); PG8_SCHED; PG8_LDA(At, 1, 0); PG8_STAGE(PG8_SA(0, 1), a2 + hstep, voffA);
            PG8_WAIT_L(8); PG8_BAR; PG8_WAIT_L(0); PG8_MMA(0, 0, At, B0); PG8_BAR; PG8_SCHED;
            PG8_LDB(B1, 1, 1); PG8_STAGE(PG8_SB(1, 0), b3, voffB);
            PG8_BAR; PG8_WAIT_L(0); PG8_MMA(0, 1, At, B1); PG8_BAR;
            PG8_LDA(At, 1, 1); PG8_STAGE(PG8_SA(1, 0), a3, voffA);
            PG8_BAR; PG8_WAIT_L(0); PG8_MMA(1, 0, At, B0); PG8_BAR; PG8_SCHED;
            PG8_STAGE(PG8_SB(1, 1), b3 + hstep, voffB);
            PG8_WAIT_V(6); PG8_BAR; PG8_MMA(1, 1, At, B1); PG8_BAR;
            }
        }
        if constexpr (ALIGN_EPI) { if (wr == 0) PG8_BAR; }
        if constexpr (!Epi::AFTER_DRAIN) { E(acc, cur, wr, wc, fr, fq); S.done(cur); }
        if (!has_next) break;
#pragma unroll
        for (int a = 0; a < 2; ++a)
#pragma unroll
            for (int b = 0; b < 2; ++b)
#pragma unroll
                for (int m = 0; m < 4; ++m)
#pragma unroll
                    for (int n = 0; n < 2; ++n) acc[a][b][m][n] = (f32x4){0.f, 0.f, 0.f, 0.f};
        cur = nxt; cA = nA; cB = nB; ++ui;
        if constexpr (ALIGN_EPI) { if (wr == 1) PG8_BAR; }
    }
    PG8_WAIT_V(0);
    if constexpr (!ALIGN_EPI) { if (wr == 0) PG8_BAR; }
    PG8_BAR;
    if constexpr (Epi::AFTER_DRAIN) { E.fused(acc, cur, wr, wc, fr, fq, lds, wid, lane); S.done(cur); }
#undef PG8_SA
#undef PG8_SB
#undef PG8_STAGE
#undef PG8_LDA
#undef PG8_LDB
#undef PG8_MMA
#undef PG8_WAIT_V
#undef PG8_WAIT_L
#undef PG8_BAR
#undef PG8_SCHED
}
}
namespace pg8 {
struct EpiF32 {
    static constexpr bool PERM = false, AFTER_DRAIN = false;
    float* C; int ldc; const float* bias;
    __device__ __forceinline__ void operator()(const f32x4 (&acc)[2][2][4][2], const Unit& u, int wr, int wc, int fr, int fq) const {
        const int row0 = u.pm * BM + wr * 64 + fr, col0 = u.pn * BM + wc * 32 + 4 * fq;
        f32x4 bv[2][2];
#pragma unroll
        for (int bj = 0; bj < 2; ++bj)
#pragma unroll
            for (int n = 0; n < 2; ++n) bv[bj][n] = bias ? *(const f32x4*)(bias + col0 + bj * HALF + n * 16) : (f32x4){0.f, 0.f, 0.f, 0.f};
#pragma unroll
        for (int ai = 0; ai < 2; ++ai)
#pragma unroll
            for (int m = 0; m < 4; ++m) { float* rowp = C + (size_t)(row0 + ai * HALF + m * 16) * ldc + col0;
#pragma unroll
                for (int bj = 0; bj < 2; ++bj)
#pragma unroll
                    for (int n = 0; n < 2; ++n) *(f32x4*)(rowp + bj * HALF + n * 16) = acc[ai][bj][m][n] + bv[bj][n]; }
    }
};

constexpr int MOE_CAP = 16384;
struct MUnit { int e, rt, pn, nvalid; };
struct MoeSched {
    const PG8_LAS int* tp; const PG8_LAS int* cnt; int NPn, G, c;
    __device__ __forceinline__ bool next(int i, MUnit& u) const {
        const int T = tp[32]; const long Lx = (long)i * G + c; if (Lx >= (long)T * NPn) return false;
        const int L = (int)Lx, tile = L / NPn; int e = 0;
#pragma unroll
        for (int k = 1; k < 32; ++k) e += (tp[k] <= tile) ? 1 : 0;
        const int rt = tile - tp[e]; int rem = cnt[e] - rt * 256; rem = rem < 256 ? rem : 256;
        u.e = __builtin_amdgcn_readfirstlane(e); u.rt = __builtin_amdgcn_readfirstlane(rt); u.pn = __builtin_amdgcn_readfirstlane(L % NPn); u.nvalid = __builtin_amdgcn_readfirstlane(rem);
        return true;
    }
};
__device__ __forceinline__ float sigmoid_fast(float z) { return __builtin_amdgcn_rcpf(1.0f + __builtin_amdgcn_exp2f(-1.4426950408889634f * z)); }
struct EpiSwiglu {
    static constexpr bool PERM = true;
    bf16_t* act; const float* b1;
    __device__ __forceinline__ void operator()(const f32x4 (&acc)[2][2][4][2], const MUnit& u, int wr, int wc, int fr, int fq) const {
        const int c0 = wc * 32 + 8 * fq; const float* bb = b1 + (size_t)u.e * 2048 + 128 * u.pn + c0;
        f32x4 bg[2], bl[2];
#pragma unroll
        for (int n = 0; n < 2; ++n) { bg[n] = *(const f32x4*)(bb + 4 * n); bl[n] = *(const f32x4*)(bb + 1024 + 4 * n); }
        bf16_t* base = act + ((size_t)u.e * MOE_CAP + (size_t)u.rt * 256 + wr * 64 + fr) * 1024 + 128 * u.pn + c0;
#pragma unroll
        for (int ai = 0; ai < 2; ++ai)
#pragma unroll
            for (int m = 0; m < 4; ++m) {
                unsigned w[4];
#pragma unroll
                for (int n = 0; n < 2; ++n) { const f32x4 g4 = acc[ai][0][m][n] + bg[n], l4 = acc[ai][1][m][n] + bl[n]; float a[4];
#pragma unroll
                    for (int j = 0; j < 4; ++j) { const float g = fminf(g4[j], 7.0f), li = fminf(fmaxf(l4[j], -7.0f), 7.0f); a[j] = g * sigmoid_fast(1.702f * g) * (li + 1.0f); }
                    w[2 * n] = cvt_pk_bf16(a[0], a[1]); w[2 * n + 1] = cvt_pk_bf16(a[2], a[3]); }
                u32x4 o; o.x = w[0]; o.y = w[1]; o.z = w[2]; o.w = w[3];
                *(u32x4*)(base + (size_t)(ai * HALF + m * 16) * 1024) = o; }
    }
};
struct EpiGateScatter {
    static constexpr bool PERM = true;
    bf16_t* y4; const float* b2; const int* tk; const float* gate;
    __device__ __forceinline__ void operator()(const f32x4 (&acc)[2][2][4][2], const MUnit& u, int wr, int wc, int fr, int fq) const {
        const int c0 = 256 * u.pn + wc * 32 + 8 * fq; const float* bb = b2 + (size_t)u.e * 1024 + c0;
        f32x4 bv[2][2];
#pragma unroll
        for (int bj = 0; bj < 2; ++bj)
#pragma unroll
            for (int n = 0; n < 2; ++n) bv[bj][n] = *(const f32x4*)(bb + bj * HALF + 4 * n);
        const size_t lbase = (size_t)u.e * MOE_CAP + (size_t)u.rt * 256;
#pragma unroll
        for (int ai = 0; ai < 2; ++ai)
#pragma unroll
            for (int m = 0; m < 4; ++m) { const int r = ai * HALF + wr * 64 + m * 16 + fr;
                if (r < u.nvalid) { const int t = tk[lbase + r]; const float g = gate[lbase + r]; bf16_t* dst = y4 + (size_t)t * 1024 + c0;
#pragma unroll
                    for (int bj = 0; bj < 2; ++bj) { const f32x4 v0 = (acc[ai][bj][m][0] + bv[bj][0]) * g, v1 = (acc[ai][bj][m][1] + bv[bj][1]) * g;
                        u32x4 o; o.x = cvt_pk_bf16(v0[0], v0[1]); o.y = cvt_pk_bf16(v0[2], v0[3]); o.z = cvt_pk_bf16(v1[0], v1[1]); o.w = cvt_pk_bf16(v1[2], v1[3]);
                        *(u32x4*)(dst + bj * HALF) = o; } } }
    }
};

template <class Epi, bool GATHER>
__device__ __forceinline__ void gemm_phase_moe(PG8_LAS unsigned char* lds, const bf16_t* A, const bf16_t* Bt, const int K, const int NB, const int* rowlist, const MoeSched& S, const Epi& E) {
    const int tid = threadIdx.x, wid = __builtin_amdgcn_readfirstlane(tid >> 6), lane = tid & 63, wr = wid >> 2, wc = wid & 3, fr = lane & 15, fq = lane >> 4;
    const int nt = K / BK;
    int RA[2]; unsigned cbA[2], voffB[2];
#pragma unroll
    for (int i = 0; i < 2; ++i) { int R, C; stage_rc(tid * 16 + i * 8192, R, C); const int Rb = Epi::PERM ? ((R & ~31) + perm32(R & 31)) : R;
        RA[i] = R; cbA[i] = (unsigned)C * 2u; voffB[i] = (unsigned)(Rb * K + C) * 2u; }
    const size_t kstep = (size_t)(BK * 2);
    const size_t hstep = (size_t)HALF * K * 2;
    const unsigned ldsw = (unsigned)wid * 1024u;
    const int aoff = lds_byte(wr * 64 + fr, fq * 8), boff = lds_byte(wc * 32 + fr, fq * 8);
#define PG8_SA(b, h) (((b) * 2 + (h)) * HTB)
#define PG8_SB(b, h) ((4 + (b) * 2 + (h)) * HTB)
#define PG8_STAGE(bufoff, gbase, voff) do { _Pragma("unroll") for (int _i = 0; _i < 2; ++_i) \
        __builtin_amdgcn_global_load_lds((const unsigned*)((const char*)(gbase) + (voff)[_i]), (PG8_LAS unsigned*)(lds + (bufoff) + ldsw + _i * 8192), 16, 0, 0); } while (0)
#define PG8_LDA(dst, b, h) do { _Pragma("unroll") for (int m = 0; m < 4; ++m) _Pragma("unroll") for (int k = 0; k < 2; ++k) dst[m][k] = *(const PG8_LAS bf16x8*)(lds + PG8_SA(b, h) + aoff + m * 2048 + k * 1024); } while (0)
#define PG8_LDB(dst, b, h) do { _Pragma("unroll") for (int n = 0; n < 2; ++n) _Pragma("unroll") for (int k = 0; k < 2; ++k) dst[n][k] = *(const PG8_LAS bf16x8*)(lds + PG8_SB(b, h) + boff + n * 2048 + k * 1024); } while (0)
#define PG8_MMA(ai, bj, At, Bt_) do { __builtin_amdgcn_s_setprio(1); _Pragma("unroll") for (int m = 0; m < 4; ++m) _Pragma("unroll") for (int n = 0; n < 2; ++n) _Pragma("unroll") for (int k = 0; k < 2; ++k) \
        acc[ai][bj][m][n] = __builtin_amdgcn_mfma_f32_16x16x32_bf16(Bt_[n][k], At[m][k], acc[ai][bj][m][n], 0, 0, 0); __builtin_amdgcn_s_setprio(0); } while (0)
#define PG8_WAIT_V(n) asm volatile("s_waitcnt vmcnt(" #n ")" ::: "memory")
#define PG8_WAIT_L(n) asm volatile("s_waitcnt lgkmcnt(" #n ")" ::: "memory")
#define PG8_BAR __builtin_amdgcn_s_barrier()
#define PG8_SCHED __builtin_amdgcn_sched_barrier(0)
#define PG8_AOFFS(dst, u) do { _Pragma("unroll") for (int _h = 0; _h < 2; ++_h) _Pragma("unroll") for (int _i = 0; _i < 2; ++_i) { \
        if constexpr (GATHER) { int _r = _h * HALF + RA[_i]; _r = _r < (u).nvalid ? _r : (u).nvalid - 1; \
            const int _tk = rowlist[(size_t)(u).e * MOE_CAP + (size_t)(u).rt * 256 + _r]; dst[_h][_i] = (unsigned)(_tk >> 2) * (unsigned)(K * 2) + cbA[_i]; } \
        else dst[_h][_i] = (unsigned)((_h * HALF + RA[_i]) * K) * 2u + cbA[_i]; } } while (0)
#define PG8_ABASE(u) (GATHER ? (const char*)A : (const char*)A + ((size_t)(u).e * MOE_CAP + (size_t)(u).rt * 256) * (size_t)K * 2)
#define PG8_BBASE(u) ((const char*)Bt + ((size_t)(u).e * NB + (size_t)(u).pn * 256) * (size_t)K * 2)
    MUnit cur, nxt; int ui = 0;
    if (!S.next(0, cur)) return;
    f32x4 acc[2][2][4][2];
#pragma unroll
    for (int a = 0; a < 2; ++a)
#pragma unroll
        for (int b = 0; b < 2; ++b)
#pragma unroll
            for (int m = 0; m < 4; ++m)
#pragma unroll
                for (int n = 0; n < 2; ++n) acc[a][b][m][n] = (f32x4){0.f, 0.f, 0.f, 0.f};
    bf16x8 At[4][2], B0[2][2], B1[2][2];
    unsigned ca[2][2], na[2][2];
    PG8_AOFFS(ca, cur);
    const char* cA = PG8_ABASE(cur); const char* cB = PG8_BBASE(cur);
    PG8_STAGE(PG8_SB(0, 0), cB, voffB); PG8_STAGE(PG8_SB(0, 1), cB + hstep, voffB); PG8_STAGE(PG8_SA(0, 0), cA, ca[0]); PG8_STAGE(PG8_SA(0, 1), cA, ca[1]);
    if (wr == 1) PG8_BAR;
    PG8_WAIT_V(2); PG8_BAR;
    PG8_STAGE(PG8_SB(1, 0), cB + kstep, voffB); PG8_STAGE(PG8_SA(1, 0), cA + kstep, ca[0]); PG8_STAGE(PG8_SB(1, 1), cB + hstep + kstep, voffB);
    PG8_WAIT_V(6); PG8_BAR;
    for (;;) {
        const bool has_next = S.next(ui + 1, nxt);
        const char* nA = has_next ? PG8_ABASE(nxt) : cA; const char* nB = has_next ? PG8_BBASE(nxt) : cB;
#pragma unroll
        for (int h = 0; h < 2; ++h)
#pragma unroll
            for (int i = 0; i < 2; ++i) na[h][i] = ca[h][i];
        for (int t = 0; t < nt; t += 2) {
            const bool last = (t == nt - 2);
            if constexpr (GATHER) { if (t == nt - 4 && has_next) PG8_AOFFS(na, nxt); }
            const char* a1 = cA + (size_t)(t + 1) * kstep;
            const char* a2 = last ? nA : cA + (size_t)(t + 2) * kstep; const char* b2 = last ? nB : cB + (size_t)(t + 2) * kstep;
            const char* a3 = a2 + kstep; const char* b3 = b2 + kstep;
            PG8_LDB(B0, 0, 0); PG8_LDB(B1, 0, 1); PG8_SCHED; PG8_LDA(At, 0, 0); PG8_STAGE(PG8_SA(1, 1), a1, ca[1]);
            if constexpr (GATHER) { if (last) {
#pragma unroll
                for (int h = 0; h < 2; ++h)
#pragma unroll
                    for (int i = 0; i < 2; ++i) ca[h][i] = na[h][i]; } }
            PG8_WAIT_V(8); PG8_WAIT_L(0); PG8_BAR; PG8_MMA(0, 0, At, B0); PG8_MMA(0, 1, At, B1); PG8_BAR; PG8_SCHED;
            PG8_LDA(At, 0, 1); PG8_STAGE(PG8_SB(0, 0), b2, voffB); PG8_STAGE(PG8_SB(0, 1), b2 + hstep, voffB); PG8_STAGE(PG8_SA(0, 0), a2, ca[0]);
            PG8_WAIT_V(8); PG8_WAIT_L(0); PG8_BAR; PG8_MMA(1, 0, At, B0); PG8_MMA(1, 1, At, B1); PG8_BAR; PG8_SCHED;
            PG8_LDB(B0, 1, 0); PG8_LDB(B1, 1, 1); PG8_SCHED; PG8_LDA(At, 1, 0); PG8_STAGE(PG8_SA(0, 1), a2, ca[1]);
            PG8_WAIT_V(8); PG8_WAIT_L(0); PG8_BAR; PG8_MMA(0, 0, At, B0); PG8_MMA(0, 1, At, B1); PG8_BAR; PG8_SCHED;
            PG8_LDA(At, 1, 1); PG8_STAGE(PG8_SB(1, 0), b3, voffB); PG8_STAGE(PG8_SB(1, 1), b3 + hstep, voffB); PG8_STAGE(PG8_SA(1, 0), a3, ca[0]);
            PG8_WAIT_V(8); PG8_WAIT_L(0); PG8_BAR; PG8_MMA(1, 0, At, B0); PG8_MMA(1, 1, At, B1); PG8_BAR; PG8_SCHED;
        }
        if (wr == 0) PG8_BAR;
        E(acc, cur, wr, wc, fr, fq);
        if (!has_next) break;
#pragma unroll
        for (int a = 0; a < 2; ++a)
#pragma unroll
            for (int b = 0; b < 2; ++b)
#pragma unroll
                for (int m = 0; m < 4; ++m)
#pragma unroll
                    for (int n = 0; n < 2; ++n) acc[a][b][m][n] = (f32x4){0.f, 0.f, 0.f, 0.f};
        cur = nxt; cA = nA; cB = nB; ++ui;
        if (wr == 1) PG8_BAR;
    }
    PG8_WAIT_V(0);
    PG8_BAR;
#undef PG8_SA
#undef PG8_SB
#undef PG8_STAGE
#undef PG8_LDA
#undef PG8_LDB
#undef PG8_MMA
#undef PG8_WAIT_V
#undef PG8_WAIT_L
#undef PG8_BAR
#undef PG8_SCHED
#undef PG8_AOFFS
#undef PG8_ABASE
#undef PG8_BBASE
}
}

#define LAS __attribute__((address_space(3)))
#define GAS __attribute__((address_space(1)))
typedef unsigned short bf16;
typedef float f32x4 __attribute__((ext_vector_type(4)));
typedef unsigned v4u __attribute__((ext_vector_type(4)));
typedef unsigned v2u __attribute__((ext_vector_type(2)));
constexpr int NB_ = 2, SEQ = 8192, M = NB_ * SEQ, D = 1024, DIN = 2820, NPJ = 2816, NL = 4, NE = 32, TOPK = 4, CAP = pg8::MOE_CAP;
constexpr float LN_EPS = 1e-5f, ALPHA = 1.6817928305074290f  , LOG2E = 1.4426950408889634f;
constexpr int NWAVES = 8, NTHR = 512, LDS_BYTES = 147456, RING_BYTES = 131072, LDSCTL_OFF = RING_BYTES;
constexpr int C_RQ = 0, C_RK = 128, C_RV = 256, C_RG = 512, C_CA = 768, C_CB = 1024, C_SB = 1280, C_SC = 1536, C_SH = 1792, C_FQ = 2048, C_FK = 2304, C_FV = 2560, C_FF = 2816;

constexpr size_t MiB = 1u << 20;
constexpr size_t WS_CTL = 0, CTL_ZERO_BYTES = 1 * MiB;
constexpr size_t WS_ROPE = 1 * MiB;
constexpr size_t WS_LOGF = 2 * MiB;
constexpr size_t WS_F = 3 * MiB;
constexpr size_t WS_TK = 4 * MiB;
constexpr size_t WS_GATE = 6 * MiB;
constexpr size_t WS_WIN = 8 * MiB;
constexpr size_t WS_WO = 32 * MiB;
constexpr size_t WS_XB = 64 * MiB;
constexpr size_t WS_X1B = 96 * MiB;
constexpr size_t WS_MIXED = 128 * MiB;
constexpr size_t WS_XF = 160 * MiB;
constexpr size_t WS_X1 = 224 * MiB;
constexpr size_t WS_MIX = 288 * MiB;
constexpr size_t WS_PROJ = 352 * MiB;
constexpr size_t WS_Y4 = 448 * MiB;
constexpr size_t WS_W1 = 576 * MiB;
constexpr size_t WS_W2 = 1088 * MiB;
constexpr size_t WS_ACT = 1344 * MiB;
constexpr size_t WS_END = 2368 * MiB;
constexpr int CW_CURSOR = 1024;

__device__ __forceinline__ float bf2f(unsigned v) { return __uint_as_float(v << 16); }
__device__ __forceinline__ unsigned f2bf(float f) { unsigned u = __float_as_uint(f); return (u + 0x7fffu + ((u >> 16) & 1u)) >> 16; }
__device__ __forceinline__ unsigned pk2(float lo, float hi) { return f2bf(lo) | (f2bf(hi) << 16); }
#define LDS_WAIT() asm volatile("s_waitcnt lgkmcnt(0)" ::: "memory")
__device__ __forceinline__ float wave_sum(float v) {
#pragma unroll
    for (int o = 1; o < 64; o <<= 1) v += __shfl_xor(v, o);
    return v;
}
__device__ __forceinline__ float wave_max(float v) {
#pragma unroll
    for (int o = 1; o < 64; o <<= 1) v = fmaxf(v, __shfl_xor(v, o));
    return v;
}

struct Params {
    const float* in[20]; float* out; unsigned char* ws;
};

__device__ __forceinline__ void transpose_item(const float* W, size_t ldw, bf16* WT, int Kd, int k0, int n0, int drow0, LAS float* scr, int lane) {
#pragma unroll 8
    for (int i = 0; i < 32; ++i) { const int kk = 2 * i + (lane >> 5); scr[kk * 33 + (lane & 31)] = W[(size_t)(k0 + kk) * ldw + n0 + (lane & 31)]; }
    LDS_WAIT(); asm volatile("" ::: "memory");
    const int c = lane & 7;
#pragma unroll
    for (int j = 0; j < 4; ++j) { const int n = (lane >> 3) + 8 * j; const LAS float* s = scr + (8 * c) * 33 + n;
        v4u o; o.x = pk2(s[0 * 33], s[1 * 33]); o.y = pk2(s[2 * 33], s[3 * 33]); o.z = pk2(s[4 * 33], s[5 * 33]); o.w = pk2(s[6 * 33], s[7 * 33]);
        *(GAS v4u*)(WT + (size_t)(drow0 + n) * Kd + k0 + 8 * c) = o; }
    LDS_WAIT(); asm volatile("" ::: "memory");
}
__device__ __forceinline__ float log_sigmoid(float z) { return fminf(z, 0.f) - log1pf(expf(-fabsf(z))); }
__device__ __forceinline__ void row_logf(const f32x4 (&v)[4], const float* w_in_l, const float* fox_b_l, float* logf_row, int lane) {
    float a0 = 0.f, a1 = 0.f, a2 = 0.f, a3 = 0.f;
#pragma unroll
    for (int j = 0; j < 4; ++j)
#pragma unroll
        for (int q = 0; q < 4; ++q) { const int k = 256 * j + 4 * lane + q; const f32x4 w = *(const f32x4*)(w_in_l + (size_t)k * DIN + C_FF); const float xv = v[j][q];
            a0 += xv * w[0]; a1 += xv * w[1]; a2 += xv * w[2]; a3 += xv * w[3]; }
    a0 = wave_sum(a0); a1 = wave_sum(a1); a2 = wave_sum(a2); a3 = wave_sum(a3);
    if (lane == 0) { f32x4 o; o[0] = log_sigmoid(a0 + fox_b_l[0]); o[1] = log_sigmoid(a1 + fox_b_l[1]); o[2] = log_sigmoid(a2 + fox_b_l[2]); o[3] = log_sigmoid(a3 + fox_b_l[3]); *(f32x4*)logf_row = o; }
}
__global__ void __launch_bounds__(NTHR, 2) k_prologue(Params p) {
    extern __shared__ __attribute__((aligned(16))) unsigned char lds[];
    const int tid = threadIdx.x, lane = tid & 63, wave = tid >> 6;
    LAS float* scr = (LAS float*)((LAS unsigned char*)lds + wave * 16384);
    const int gw = blockIdx.x * NWAVES + wave, NGW = gridDim.x * NWAVES;
    unsigned char* ws = p.ws;
    constexpr int I_IN = 16 * 88, I_O = 16 * 32, I_W1 = 32 * 16 * 64, I_W2 = 32 * 16 * 32, I_L = I_IN + I_O + I_W1 + I_W2;
    for (int it = gw; it < NL * I_L; it += NGW) {
        const int l = it / I_L; int r = it % I_L;
        if (r < I_IN) { const int kb = r / 88, nb = r % 88; transpose_item(p.in[1] + (size_t)l * D * DIN, DIN, (bf16*)(ws + WS_WIN) + (size_t)l * NPJ * D, D, 64 * kb, 32 * nb, 32 * nb, scr, lane); continue; } r -= I_IN;
        if (r < I_O) { const int kb = r / 32, nb = r % 32; transpose_item(p.in[9] + (size_t)l * D * D, D, (bf16*)(ws + WS_WO) + (size_t)l * D * D, D, 64 * kb, 32 * nb, 32 * nb, scr, lane); continue; } r -= I_O;
        if (r < I_W1) { const int e = r / 1024, q = r % 1024, kb = q / 64, nb = q % 64, n0 = 32 * nb, s = n0 >> 10, c0 = n0 & 1023, drow0 = 256 * (c0 >> 7) + 128 * s + (c0 & 127);
            transpose_item(p.in[14] + ((size_t)l * NE + e) * D * 2048, 2048, (bf16*)(ws + WS_W1) + ((size_t)l * NE + e) * 2048 * D, D, 64 * kb, n0, drow0, scr, lane); continue; } r -= I_W1;
        { const int e = r / 512, q = r % 512, kb = q / 32, nb = q % 32;
            transpose_item(p.in[16] + ((size_t)l * NE + e) * D * D, D, (bf16*)(ws + WS_W2) + ((size_t)l * NE + e) * D * D, D, 64 * kb, 32 * nb, 32 * nb, scr, lane); }
    }
    for (int idx = blockIdx.x * NTHR + tid; idx < SEQ * 16; idx += gridDim.x * NTHR) { const int pos = idx >> 4, i = idx & 15;
        const float freq = powf(10000.0f, -(float)i / 16.0f); const float ang = (float)pos * freq; const double a = (double)ang;
        float* cs = (float*)(ws + WS_ROPE) + 2 * idx; cs[0] = (float)cos(a); cs[1] = (float)sin(a); }
    for (int m = gw; m < M; m += NGW) {
        const GAS f32x4* xr = (const GAS f32x4*)(p.in[0] + (size_t)m * D) + lane; f32x4 v[4];
#pragma unroll
        for (int j = 0; j < 4; ++j) v[j] = xr[64 * j];
        GAS v2u* o8 = (GAS v2u*)((bf16*)(ws + WS_XB) + (size_t)m * D) + lane;
#pragma unroll
        for (int j = 0; j < 4; ++j) { v2u w; w.x = pk2(v[j][0], v[j][1]); w.y = pk2(v[j][2], v[j][3]); o8[64 * j] = w; }
        row_logf(v, p.in[1], p.in[2], (float*)(ws + WS_LOGF) + (size_t)m * 4, lane);
    }
}

__global__ void __launch_bounds__(NTHR, 2) k_inproj(Params p, int l) {
    extern __shared__ __attribute__((aligned(16))) unsigned char lds[];
    pg8::Gemm g{(const bf16*)(p.ws + WS_XB), (const bf16*)(p.ws + WS_WIN) + (size_t)l * NPJ * D, M, NPJ, D}; pg8::StaticOrder S; S.init(M, NPJ, gridDim.x, (int)blockIdx.x);
    pg8::EpiBf16<0> E{(bf16*)(p.ws + WS_PROJ), NPJ, nullptr, 0, 0, 1.f};
    pg8::gemm_phase<pg8::EpiBf16<0>, pg8::StaticOrder, true, true>((LAS unsigned char*)lds, g, S, E);
}
__global__ void __launch_bounds__(NTHR, 2) k_outproj(Params p, int l) {
    extern __shared__ __attribute__((aligned(16))) unsigned char lds[];
    pg8::Gemm g{(const bf16*)(p.ws + WS_MIXED), (const bf16*)(p.ws + WS_WO) + (size_t)l * D * D, M, D, D}; pg8::StaticOrder S; S.init(M, D, gridDim.x, (int)blockIdx.x);
    pg8::EpiF32 E{(float*)(p.ws + WS_MIX), D, nullptr};
    pg8::gemm_phase<pg8::EpiF32, pg8::StaticOrder, true, true>((LAS unsigned char*)lds, g, S, E);
}
__device__ __forceinline__ void moe_table(LAS int* tp, LAS int* cnt, const unsigned* cursor) {
    if (threadIdx.x < 32) cnt[threadIdx.x] = (int)__hip_atomic_load(cursor + threadIdx.x, __ATOMIC_RELAXED, __HIP_MEMORY_SCOPE_AGENT);
    __syncthreads();
    if (threadIdx.x == 0) { int s = 0; for (int e = 0; e < 32; ++e) { tp[e] = s; s += (cnt[e] + 255) >> 8; } tp[32] = s; }
    __syncthreads();
}
__global__ void __launch_bounds__(NTHR, 2) k_gemm1(Params p, int l) {
    extern __shared__ __attribute__((aligned(16))) unsigned char lds[];
    LAS int* tp = (LAS int*)((LAS unsigned char*)lds + LDSCTL_OFF + 1024); LAS int* cnt = tp + 64;
    moe_table(tp, cnt, (const unsigned*)(p.ws + WS_CTL) + CW_CURSOR + 32 * l);
    pg8::MoeSched S{tp, cnt, 8, (int)gridDim.x, (int)blockIdx.x};
    pg8::EpiSwiglu E{(bf16*)(p.ws + WS_ACT), p.in[15] + (size_t)l * NE * 2048};
    pg8::gemm_phase_moe<pg8::EpiSwiglu, true>((LAS unsigned char*)lds, (const bf16*)(p.ws + WS_X1B), (const bf16*)(p.ws + WS_W1) + (size_t)l * NE * 2048 * D, D, 2048, (const int*)(p.ws + WS_TK), S, E);
}
__global__ void __launch_bounds__(NTHR, 2) k_gemm2(Params p, int l) {
    extern __shared__ __attribute__((aligned(16))) unsigned char lds[];
    LAS int* tp = (LAS int*)((LAS unsigned char*)lds + LDSCTL_OFF + 1024); LAS int* cnt = tp + 64;
    moe_table(tp, cnt, (const unsigned*)(p.ws + WS_CTL) + CW_CURSOR + 32 * l);
    pg8::MoeSched S{tp, cnt, 4, (int)gridDim.x, (int)blockIdx.x};
    pg8::EpiGateScatter E{(bf16*)(p.ws + WS_Y4), p.in[17] + (size_t)l * NE * D, (const int*)(p.ws + WS_TK), (const float*)(p.ws + WS_GATE)};
    pg8::gemm_phase_moe<pg8::EpiGateScatter, false>((LAS unsigned char*)lds, (const bf16*)(p.ws + WS_ACT), (const bf16*)(p.ws + WS_W2) + (size_t)l * NE * D * D, D, 1024, nullptr, S, E);
}

__global__ void __launch_bounds__(NTHR) k_fscan(Params p) {
    __shared__ float wtot[NWAVES];
    const int bh = blockIdx.x, b = bh >> 2, h = bh & 3, tid = threadIdx.x, lane = tid & 63, wave = tid >> 6;
    const float* lf = (const float*)(p.ws + WS_LOGF) + ((size_t)b * SEQ + 16 * tid) * 4 + h;
    float v[16]; float s = 0.f;
#pragma unroll
    for (int j = 0; j < 16; ++j) { s += lf[4 * j]; v[j] = s; }
    float inc = s;
#pragma unroll
    for (int o = 1; o < 64; o <<= 1) { const float t = __shfl_up(inc, o); if (lane >= o) inc += t; }
    if (lane == 63) wtot[wave] = inc;
    __syncthreads();
    float base = inc - s;
    for (int w = 0; w < wave; ++w) base += wtot[w];
    float* F = (float*)(p.ws + WS_F) + (size_t)bh * SEQ + 16 * tid;
#pragma unroll
    for (int j = 0; j < 16; ++j) F[j] = base + v[j];
}
__global__ void __launch_bounds__(NTHR) k_conv(Params p, int l) {
    __shared__ float red[NWAVES][2];
    const int tid = threadIdx.x, lane = tid & 63, wave = tid >> 6, c = tid & 255, sub = tid >> 8;
    const bf16* proj = (const bf16*)(p.ws + WS_PROJ); bf16* mixed = (bf16*)(p.ws + WS_MIXED);
    const float* dw = p.in[3] + (size_t)l * 31 * 256; const float dwb = p.in[4][l * 256 + c], lg = p.in[5][l * 256 + c], lb = p.in[6][l * 256 + c];
    const float* sw = p.in[7] + (size_t)l * 3 * 256;
    for (int tp = blockIdx.x * 2; tp < M; tp += gridDim.x * 2) {
        const int t = tp + sub, pos = t & (SEQ - 1);
        float acc = dwb;
        for (int j = 0; j < 31; ++j) { const int sp = pos - 30 + j; if (sp >= 0) { const size_t r = (size_t)(t - 30 + j) * NPJ;
            const float a = bf2f(proj[r + C_CA + c]), bg = bf2f(proj[r + C_CB + c]); acc += dw[j * 256 + c] * (a / (1.0f + expf(-bg))); } }
        float s1 = wave_sum(acc); if (lane == 0) red[wave][0] = s1;
        __syncthreads();
        const int w0 = sub * 4; const float mean = (red[w0][0] + red[w0 + 1][0] + red[w0 + 2][0] + red[w0 + 3][0]) * (1.0f / 256.0f);
        const float d = acc - mean; float s2 = wave_sum(d * d); if (lane == 0) red[wave][1] = s2;
        __syncthreads();
        const float var = (red[w0][1] + red[w0 + 1][1] + red[w0 + 2][1] + red[w0 + 3][1]) * (1.0f / 256.0f);
        const float y = d * rsqrtf(var + LN_EPS) * lg + lb;
        mixed[(size_t)t * D + 256 + c] = (bf16)f2bf(y / (1.0f + expf(-y)));
        float sacc = 0.f;
        for (int j = 0; j < 3; ++j) { const int sp = pos - 2 + j; if (sp >= 0) { const size_t r = (size_t)(t - 2 + j) * NPJ; sacc += sw[j * 256 + c] * (bf2f(proj[r + C_SC + c]) * bf2f(proj[r + C_SH + c])); } }
        mixed[(size_t)t * D + 512 + c] = (bf16)f2bf(bf2f(proj[(size_t)t * NPJ + C_SB + c]) * sacc);
    }
}
template <bool FOX>
__global__ void __launch_bounds__(256) k_naive_mix(Params p, int l) {
    constexpr int DK = FOX ? 64 : 32;
    __shared__ float Ks[64][DK]; __shared__ float Vs[64][64]; __shared__ float Fs[64];
    const int unit = blockIdx.x, bh = unit >> 5, qb = unit & 31, b = bh >> 2, h = bh & 3, tid = threadIdx.x;
    const int i = qb * 256 + tid; const size_t row = (size_t)b * SEQ + i;
    const bf16* proj = (const bf16*)(p.ws + WS_PROJ); bf16* mixed = (bf16*)(p.ws + WS_MIXED);
    const float* cs = (const float*)(p.ws + WS_ROPE); const float* F = (const float*)(p.ws + WS_F) + (size_t)bh * SEQ;
    const int qcol = FOX ? C_FQ + h * 64 : C_RQ + h * 32, kcol = FOX ? C_FK + h * 64 : C_RK + h * 32, vcol = FOX ? C_FV + h * 64 : C_RV + h * 64;
    float q[DK];
#pragma unroll
    for (int d = 0; d < DK; ++d) q[d] = bf2f(proj[row * NPJ + qcol + d]);
    if (!FOX) {
#pragma unroll
        for (int d = 0; d < 16; ++d) { const float c = cs[(i * 16 + d) * 2], s = cs[(i * 16 + d) * 2 + 1], x1 = q[d], x2 = q[d + 16]; q[d] = x1 * c - x2 * s; q[d + 16] = x1 * s + x2 * c; }
    } else {
#pragma unroll
        for (int d = 0; d < DK; ++d) q[d] *= 0.125f;
    }
    const float Fi = FOX ? F[i] : 0.f;
    const float lg2 = FOX ? 0.f : log2f(1.0f - exp2f(-5.0f - (float)h));
    const float kscale = 0.17677669529663687f;
    float o[64];
#pragma unroll
    for (int e = 0; e < 64; ++e) o[e] = 0.f;
    float mx = -INFINITY, lsum = 0.f;
    const int ntile = 4 * qb + 4;
    for (int t = 0; t < ntile; ++t) {
        __syncthreads();
        for (int e = tid; e < 64 * DK; e += 256) { const int j = e / DK, d = e % DK; Ks[j][d] = bf2f(proj[((size_t)b * SEQ + 64 * t + j) * NPJ + kcol + d]); }
        for (int e = tid; e < 4096; e += 256) { const int j = e >> 6, d = e & 63; Vs[j][d] = bf2f(proj[((size_t)b * SEQ + 64 * t + j) * NPJ + vcol + d]); }
        if (FOX && tid < 64) Fs[tid] = F[64 * t + tid];
        __syncthreads();
        if (!FOX) {
            for (int e = tid; e < 64 * 16; e += 256) { const int j = e >> 4, d = e & 15, pos = 64 * t + j; const float c = cs[(pos * 16 + d) * 2], s = cs[(pos * 16 + d) * 2 + 1], x1 = Ks[j][d], x2 = Ks[j][d + 16];
                Ks[j][d] = (x1 * c - x2 * s) * kscale; Ks[j][d + 16] = (x1 * s + x2 * c) * kscale; }
            __syncthreads();
        }
        if (!FOX && t > (i >> 6)) continue;
        for (int j0 = 0; j0 < 64; j0 += 8) {
            float sc[8];
#pragma unroll
            for (int jj = 0; jj < 8; ++jj) { const int j = j0 + jj; float dot = 0.f;
#pragma unroll
                for (int d = 0; d < DK; d += 4) { const f32x4 kk = *(const f32x4*)&Ks[j][d]; dot += q[d] * kk[0] + q[d + 1] * kk[1] + q[d + 2] * kk[2] + q[d + 3] * kk[3]; }
                const int pos = 64 * t + j;
                if (FOX) sc[jj] = (pos <= i) ? (dot + Fi - Fs[j]) * LOG2E : -INFINITY;
                else { const int dist = pos > i ? pos - i : i - pos; sc[jj] = dot * exp2f(lg2 * (float)dist); } }
            if (FOX) {
                float gm = sc[0];
#pragma unroll
                for (int jj = 1; jj < 8; ++jj) gm = fmaxf(gm, sc[jj]);
                if (gm > mx) { const float r = exp2f(mx - gm); lsum *= r;
#pragma unroll
                    for (int e = 0; e < 64; ++e) o[e] *= r;
                    mx = gm; }
#pragma unroll
                for (int jj = 0; jj < 8; ++jj) { sc[jj] = exp2f(sc[jj] - mx); lsum += sc[jj]; }
            }
#pragma unroll
            for (int jj = 0; jj < 8; ++jj) { const int j = j0 + jj; const float pj = sc[jj];
#pragma unroll
                for (int e = 0; e < 64; e += 4) { const f32x4 vv = *(const f32x4*)&Vs[j][e]; o[e] += pj * vv[0]; o[e + 1] += pj * vv[1]; o[e + 2] += pj * vv[2]; o[e + 3] += pj * vv[3]; } }
        }
    }
    if (FOX) {
        const float inv = 1.0f / lsum;
#pragma unroll
        for (int e = 0; e < 64; e += 2) *(unsigned*)(mixed + row * D + 768 + h * 64 + e) = pk2(o[e] * inv, o[e + 1] * inv);
    } else {
        float mean = 0.f;
#pragma unroll
        for (int e = 0; e < 64; ++e) mean += o[e];
        mean *= (1.0f / 64.0f); float var = 0.f;
#pragma unroll
        for (int e = 0; e < 64; ++e) { const float d = o[e] - mean; var += d * d; }
        const float rstd = rsqrtf(var * (1.0f / 64.0f) + LN_EPS);
        const float* gg = p.in[8] + l * 256 + h * 64;
#pragma unroll
        for (int e = 0; e < 64; e += 2) { float y0 = (o[e] - mean) * rstd * gg[e], y1 = (o[e + 1] - mean) * rstd * gg[e + 1];
            const float g0 = bf2f(proj[row * NPJ + C_RG + h * 64 + e]), g1 = bf2f(proj[row * NPJ + C_RG + h * 64 + e + 1]);
            y0 *= g0 / (1.0f + expf(-g0)); y1 *= g1 / (1.0f + expf(-g1));
            *(unsigned*)(mixed + row * D + h * 64 + e) = pk2(y0, y1); }
    }
}

__global__ void __launch_bounds__(NTHR, 2) k_ln1_router(Params p, int l) {
    extern __shared__ __attribute__((aligned(16))) unsigned char lds[];
    const int tid = threadIdx.x, lane = tid & 63, wave = tid >> 6;
    LAS float* yrow = (LAS float*)((LAS unsigned char*)lds + wave * 8192);
    LAS int* sel_e = (LAS int*)((LAS unsigned char*)lds + 65536); LAS float* sel_g = (LAS float*)((LAS unsigned char*)lds + 65536 + 1024);
    LAS int* wcnt = (LAS int*)((LAS unsigned char*)lds + 65536 + 2048);
    LAS int* ebase = (LAS int*)((LAS unsigned char*)lds + 65536 + 2048 + 512);
    const float* xin = (l == 0) ? p.in[0] : (const float*)(p.ws + WS_XF);
    const float* mix = (const float*)(p.ws + WS_MIX);
    float* x1 = (float*)(p.ws + WS_X1); bf16* x1b = (bf16*)(p.ws + WS_X1B);
    const float* g1 = p.in[10] + l * D; const float* b1 = p.in[11] + l * D;
    const float* Wr = p.in[12] + (size_t)l * D * NE; const float* rb = p.in[13] + l * NE;
    unsigned* cursor = (unsigned*)(p.ws + WS_CTL) + CW_CURSOR + 32 * l;
    for (int t0 = blockIdx.x * 64; t0 < M; t0 += gridDim.x * 64) {
        for (int pair = 0; pair < 4; ++pair) {
#pragma unroll
            for (int r2 = 0; r2 < 2; ++r2) { const int t = t0 + wave * 8 + pair * 2 + r2;
                const GAS f32x4* xr = (const GAS f32x4*)(xin + (size_t)t * D) + lane; const GAS f32x4* mr = (const GAS f32x4*)(mix + (size_t)t * D) + lane;
                f32x4 v[4]; float s = 0.f;
#pragma unroll
                for (int j = 0; j < 4; ++j) { v[j] = xr[64 * j] * ALPHA + mr[64 * j]; s += (v[j][0] + v[j][1]) + (v[j][2] + v[j][3]); }
                const float mean = wave_sum(s) * (1.0f / D); float s2 = 0.f;
#pragma unroll
                for (int j = 0; j < 4; ++j) { v[j] = v[j] - mean; s2 += (v[j][0] * v[j][0] + v[j][1] * v[j][1]) + (v[j][2] * v[j][2] + v[j][3] * v[j][3]); }
                const float rstd = rsqrtf(wave_sum(s2) * (1.0f / D) + LN_EPS);
#pragma unroll
                for (int j = 0; j < 4; ++j) { const f32x4 gg = *(const f32x4*)(g1 + 256 * j + 4 * lane), bb = *(const f32x4*)(b1 + 256 * j + 4 * lane); const f32x4 y = v[j] * rstd * gg + bb;
                    ((GAS f32x4*)(x1 + (size_t)t * D))[64 * j + lane] = y; v2u w; w.x = pk2(y[0], y[1]); w.y = pk2(y[2], y[3]); ((GAS v2u*)(x1b + (size_t)t * D))[64 * j + lane] = w;
                    *(LAS f32x4*)(yrow + r2 * 1024 + 256 * j + 4 * lane) = y; } }
            LDS_WAIT(); asm volatile("" ::: "memory");
            const int e = lane & 31, kh = lane >> 5; float a0 = 0.f, a1 = 0.f;
            for (int k = kh * 512; k < kh * 512 + 512; ++k) { const float w = Wr[(size_t)k * NE + e]; a0 += yrow[k] * w; a1 += yrow[1024 + k] * w; }
            a0 += __shfl_xor(a0, 32); a1 += __shfl_xor(a1, 32);
            a0 += rb[e]; a1 += rb[e];
#pragma unroll
            for (int r2 = 0; r2 < 2; ++r2) { float val = (lane < 32) ? (r2 ? a1 : a0) : -INFINITY; float tv[4]; int ti[4];
#pragma unroll
                for (int r = 0; r < 4; ++r) { const float mxv = wave_max(val); const unsigned long long bal = __ballot(val == mxv); const int who = __ffsll((long long)bal) - 1; tv[r] = mxv; ti[r] = who; if (lane == who) val = -INFINITY; }
                const float e1 = expf(tv[1] - tv[0]), e2 = expf(tv[2] - tv[0]), e3 = expf(tv[3] - tv[0]); const float inv = 1.0f / (1.0f + e1 + e2 + e3);
                const int tl = wave * 8 + pair * 2 + r2;
                if (lane == 0) { sel_e[tl * 4 + 0] = ti[0]; sel_e[tl * 4 + 1] = ti[1]; sel_e[tl * 4 + 2] = ti[2]; sel_e[tl * 4 + 3] = ti[3];
                    sel_g[tl * 4 + 0] = inv; sel_g[tl * 4 + 1] = e1 * inv; sel_g[tl * 4 + 2] = e2 * inv; sel_g[tl * 4 + 3] = e3 * inv; } }
            LDS_WAIT(); asm volatile("" ::: "memory");
        }
        __syncthreads();
        int mye = 0, myrank = 0;
        if (wave < 4) { mye = sel_e[tid];
            for (int e2 = 0; e2 < 32; ++e2) { const unsigned long long bal = __ballot(mye == e2); if (mye == e2) myrank = __popcll(bal & ((1ull << lane) - 1ull)); if (lane == 0) wcnt[wave * 32 + e2] = __popcll(bal); } }
        __syncthreads();
        if (tid < 32) { const int tot = wcnt[tid] + wcnt[32 + tid] + wcnt[64 + tid] + wcnt[96 + tid]; ebase[tid] = tot ? (int)atomicAdd(cursor + tid, (unsigned)tot) : 0; }
        __syncthreads();
        if (wave < 4) { int pos = ebase[mye] + myrank; for (int w = 0; w < wave; ++w) pos += wcnt[w * 32 + mye];
            ((int*)(p.ws + WS_TK))[(size_t)mye * CAP + pos] = t0 * 4 + tid; ((float*)(p.ws + WS_GATE))[(size_t)mye * CAP + pos] = sel_g[tid]; }
        __syncthreads();
    }
}
__global__ void __launch_bounds__(NTHR, 2) k_ln2(Params p, int l) {
    const int tid = threadIdx.x, lane = tid & 63, wave = tid >> 6;
    const int gw = blockIdx.x * NWAVES + wave, NGW = gridDim.x * NWAVES;
    const float* x1 = (const float*)(p.ws + WS_X1); const bf16* y4 = (const bf16*)(p.ws + WS_Y4);
    float* xo = (l == NL - 1) ? p.out : (float*)(p.ws + WS_XF); bf16* xb = (bf16*)(p.ws + WS_XB);
    const float* g2 = p.in[18] + l * D; const float* b2 = p.in[19] + l * D;
    for (int t = gw; t < M; t += NGW) {
        f32x4 v[4]; float s = 0.f;
#pragma unroll
        for (int j = 0; j < 4; ++j) { v[j] = ((const GAS f32x4*)(x1 + (size_t)t * D))[64 * j + lane] * ALPHA;
#pragma unroll
            for (int k = 0; k < 4; ++k) { const v2u w = ((const GAS v2u*)(y4 + ((size_t)t * 4 + k) * D))[64 * j + lane];
                v[j][0] += bf2f(w.x & 0xffffu); v[j][1] += bf2f(w.x >> 16); v[j][2] += bf2f(w.y & 0xffffu); v[j][3] += bf2f(w.y >> 16); }
            s += (v[j][0] + v[j][1]) + (v[j][2] + v[j][3]); }
        const float mean = wave_sum(s) * (1.0f / D); float s2 = 0.f;
#pragma unroll
        for (int j = 0; j < 4; ++j) { v[j] = v[j] - mean; s2 += (v[j][0] * v[j][0] + v[j][1] * v[j][1]) + (v[j][2] * v[j][2] + v[j][3] * v[j][3]); }
        const float rstd = rsqrtf(wave_sum(s2) * (1.0f / D) + LN_EPS);
#pragma unroll
        for (int j = 0; j < 4; ++j) { const f32x4 gg = *(const f32x4*)(g2 + 256 * j + 4 * lane), bb = *(const f32x4*)(b2 + 256 * j + 4 * lane); v[j] = v[j] * rstd * gg + bb;
            ((GAS f32x4*)(xo + (size_t)t * D))[64 * j + lane] = v[j]; }
        if (l < NL - 1) {
#pragma unroll
            for (int j = 0; j < 4; ++j) { v2u w; w.x = pk2(v[j][0], v[j][1]); w.y = pk2(v[j][2], v[j][3]); ((GAS v2u*)(xb + (size_t)t * D))[64 * j + lane] = w; }
            row_logf(v, p.in[1] + (size_t)(l + 1) * D * DIN, p.in[2] + (l + 1) * 4, (float*)(p.ws + WS_LOGF) + (size_t)t * 4, lane);
        }
    }
}

extern "C" void kernel_launch(void* const* d_in, const int* in_sizes, int n_in, void* d_out, int out_size, void* d_ws, size_t ws_size, hipStream_t stream) {
    static int grid = 0;
    if (grid == 0) {
        if (n_in != 20 || in_sizes[0] != M * D || out_size != M * D || ws_size < WS_END) { fprintf(stderr, "kernel_launch: unexpected shapes / workspace (n_in %d, in0 %d, out %d, ws %zu, need %zu)\n", n_in, n_in > 0 ? in_sizes[0] : -1, out_size, ws_size, (size_t)WS_END); grid = -1; return; }
        int dev = 0, cus = 0;
        if (hipGetDevice(&dev) != hipSuccess || hipDeviceGetAttribute(&cus, hipDeviceAttributeMultiprocessorCount, dev) != hipSuccess) { grid = -1; return; }
        (void)hipFuncSetAttribute((const void*)k_prologue, hipFuncAttributeMaxDynamicSharedMemorySize, LDS_BYTES);
        (void)hipFuncSetAttribute((const void*)k_inproj, hipFuncAttributeMaxDynamicSharedMemorySize, LDS_BYTES);
        (void)hipFuncSetAttribute((const void*)k_outproj, hipFuncAttributeMaxDynamicSharedMemorySize, LDS_BYTES);
        (void)hipFuncSetAttribute((const void*)k_gemm1, hipFuncAttributeMaxDynamicSharedMemorySize, LDS_BYTES);
        (void)hipFuncSetAttribute((const void*)k_gemm2, hipFuncAttributeMaxDynamicSharedMemorySize, LDS_BYTES);
        (void)hipFuncSetAttribute((const void*)k_ln1_router, hipFuncAttributeMaxDynamicSharedMemorySize, LDS_BYTES);
        grid = cus > 0 ? cus : 256;
    }
    if (grid < 0) return;
    (void)hipMemsetAsync((char*)d_ws + WS_CTL, 0, CTL_ZERO_BYTES, stream);
    Params p{};
    for (int i = 0; i < 20; ++i) p.in[i] = (const float*)d_in[i];
    p.out = (float*)d_out; p.ws = (unsigned char*)d_ws;
    hipLaunchKernelGGL(k_prologue, dim3(grid), dim3(NTHR), LDS_BYTES, stream, p);
    for (int l = 0; l < NL; ++l) {
        hipLaunchKernelGGL(k_inproj, dim3(grid), dim3(NTHR), LDS_BYTES, stream, p, l);
        hipLaunchKernelGGL(k_fscan, dim3(8), dim3(NTHR), 0, stream, p);
        hipLaunchKernelGGL(k_conv, dim3(grid), dim3(NTHR), 0, stream, p, l);
        hipLaunchKernelGGL(k_naive_mix<false>, dim3(256), dim3(256), 0, stream, p, l);
        hipLaunchKernelGGL(k_naive_mix<true>, dim3(256), dim3(256), 0, stream, p, l);
        hipLaunchKernelGGL(k_outproj, dim3(grid), dim3(NTHR), LDS_BYTES, stream, p, l);
        hipLaunchKernelGGL(k_ln1_router, dim3(grid), dim3(NTHR), LDS_BYTES, stream, p, l);
        hipLaunchKernelGGL(k_gemm1, dim3(grid), dim3(NTHR), LDS_BYTES, stream, p, l);
        hipLaunchKernelGGL(k_gemm2, dim3(grid), dim3(NTHR), LDS_BYTES, stream, p, l);
        hipLaunchKernelGGL(k_ln2, dim3(grid), dim3(NTHR), 0, stream, p, l);
    }
}
```

```cpp
#include <hip/hip_runtime.h>
#include <cstdio>
#include <cstdint>
#include <cmath>
namespace pg8 {
#define PG8_LAS __attribute__((address_space(3)))
typedef unsigned short bf16_t;
typedef short bf16x8 __attribute__((ext_vector_type(8)));
typedef float f32x4 __attribute__((ext_vector_type(4)));
typedef unsigned u32x4 __attribute__((ext_vector_type(4)));
constexpr int BM = 256, BK = 64, HALF = 128, HTB = HALF * BK * 2  , STAGE_BYTES = 8 * HTB, NXCD = 8, WGM = 8;

__host__ __device__ __forceinline__ int lds_byte(int r, int c) { const int st = (r >> 4) * 2 + (c >> 5), rr = r & 15, cc = c & 31, ob = rr * 64 + cc * 2; return st * 1024 + (ob ^ (((ob >> 9) & 1) << 5)); }
__host__ __device__ __forceinline__ void stage_rc(int b, int& R, int& C) { const int st = b / 1024, sb = b % 1024, swz = sb ^ (((sb >> 9) & 1) << 5); R = (st >> 1) * 16 + swz / 64; C = (st & 1) * 32 + (swz % 64) / 2; }
__host__ __device__ __forceinline__ int perm32(int rho) { const int n = rho >> 4, i = rho & 15; return 8 * (i >> 2) + 4 * n + (i & 3); }

struct Unit { int pm, pn; };
struct Gemm { const bf16_t* A; const bf16_t* Bt; int M, N, K; };

struct StaticOrder {
    int nM, nN, nwg, G, c;
    __host__ __device__ void init(int M, int N, int G_, int c_) { nM = M / BM; nN = N / BM; nwg = nM * nN; G = G_; c = c_; }
    __host__ __device__ bool next(int i, Unit& u) const {
        const long L = (long)i * G + c; if (L >= nwg) return false;
        int wgid = (int)L; { const int q = nwg / NXCD, r = nwg % NXCD, xcd = wgid % NXCD, off = wgid / NXCD; wgid = (xcd < r ? xcd * (q + 1) : r * (q + 1) + (xcd - r) * q) + off; }
        const int nig = WGM * nN, gid = wgid / nig, fm = gid * WGM, gsz = (nM - fm) < WGM ? (nM - fm) : WGM;
        u.pm = fm + ((wgid % nig) % gsz); u.pn = (wgid % nig) / gsz; return true;
    }
    __device__ __forceinline__ void a_ready(const Unit&) const {}
    __device__ __forceinline__ void done(const Unit&) const {}
};

__device__ __forceinline__ unsigned cvt_pk_bf16(float lo, float hi) { unsigned r; asm volatile("v_cvt_pk_bf16_f32 %0, %1, %2" : "=v"(r) : "v"(lo), "v"(hi)); return r; }
typedef float f32x2 __attribute__((ext_vector_type(2)));
__device__ __forceinline__ f32x2 gelu_pk(f32x2 v) {
    const f32x2 av = __builtin_elementwise_abs(v), d = av * 0.2316418882f + 1.0f;
    f32x2 t; t.x = __builtin_amdgcn_rcpf(d.x); t.y = __builtin_amdgcn_rcpf(d.y);
    f32x2 q = t * 0.5307027145f + (-0.7265760135f); q = q * t + 0.7107068705f; q = q * t + (-0.142248368f); q = q * t + 0.127414796f; q = q * t;
    const f32x2 s = (v * v) * (-0.72134752044f);
    f32x2 e; e.x = __builtin_amdgcn_exp2f(s.x); e.y = __builtin_amdgcn_exp2f(s.y);
    const f32x2 m = v * (q * e), r = v - m;
    f32x2 o; o.x = v.x < 0.f ? m.x : r.x; o.y = v.y < 0.f ? m.y : r.y; return o;
}

template <int ACT  > struct EpiBf16 {
    static constexpr bool PERM = true, AFTER_DRAIN = false; static_assert(ACT == 0 || ACT == 1, "EpiBf16: ACT is 0 (none) or 1 (gelu_pk)");
    bf16_t* O; int ldc; const float* bias; int split_cols; size_t split_stride; float scale0;
    __device__ __forceinline__ void operator()(const f32x4 (&acc)[2][2][4][2], const Unit& u, int wr, int wc, int fr, int fq) const {
        const int row0 = u.pm * BM + wr * 64 + fr; int colt = u.pn * BM; bf16_t* base = O;
        float sc = 1.f; if (split_cols) { const int t = colt / split_cols; base += (size_t)t * split_stride; colt -= t * split_cols; if (t == 0) sc = scale0; }
        const int col0 = colt + wc * 32 + 8 * fq, bcol0 = u.pn * BM + wc * 32 + 8 * fq;
        f32x4 bv[2][2];
#pragma unroll
        for (int bj = 0; bj < 2; ++bj)
#pragma unroll
            for (int n = 0; n < 2; ++n) bv[bj][n] = bias ? *(const f32x4*)(bias + bcol0 + bj * HALF + 4 * n) : (f32x4){0.f, 0.f, 0.f, 0.f};
#pragma unroll
        for (int ai = 0; ai < 2; ++ai)
#pragma unroll
            for (int m = 0; m < 4; ++m) { bf16_t* rowp = base + (size_t)(row0 + ai * HALF + m * 16) * ldc + col0;
#pragma unroll
                for (int bj = 0; bj < 2; ++bj) { f32x4 v0 = acc[ai][bj][m][0] + bv[bj][0], v1 = acc[ai][bj][m][1] + bv[bj][1];
                    if (ACT == 1) { f32x2 a = gelu_pk((f32x2){v0[0], v0[1]}), b = gelu_pk((f32x2){v0[2], v0[3]}), c = gelu_pk((f32x2){v1[0], v1[1]}), d = gelu_pk((f32x2){v1[2], v1[3]});
                        v0 = (f32x4){a.x, a.y, b.x, b.y}; v1 = (f32x4){c.x, c.y, d.x, d.y}; }
                    v0 = v0 * sc; v1 = v1 * sc; u32x4 w; w.x = cvt_pk_bf16(v0[0], v0[1]); w.y = cvt_pk_bf16(v0[2], v0[3]); w.z = cvt_pk_bf16(v1[0], v1[1]); w.w = cvt_pk_bf16(v1[2], v1[3]);
                    *(u32x4*)(rowp + bj * HALF) = w; } }
    }
};

struct PanelStats {
    unsigned* xbuf;
    unsigned* cnt;
    unsigned* tmo;
    int ntn; float eps;
    unsigned code;
    __device__ __forceinline__ bool run(const f32x4 (&v)[2][2][4][2], const Unit& u, int wr, int wc, int fr, int fq, PG8_LAS unsigned char* lds, int wid, int lane) const {
        typedef float f32x2v __attribute__((ext_vector_type(2)));
        PG8_LAS f32x2v* P = (PG8_LAS f32x2v*)lds;
        PG8_LAS f32x2v* S = (PG8_LAS f32x2v*)(lds + 8192);
        PG8_LAS unsigned* flag = (PG8_LAS unsigned*)(lds + 8192 + 2048);
#pragma unroll
        for (int ai = 0; ai < 2; ++ai)
#pragma unroll
            for (int m = 0; m < 4; ++m) {
                float s = 0.f;
#pragma unroll
                for (int bj = 0; bj < 2; ++bj)
#pragma unroll
                    for (int n = 0; n < 2; ++n) { const f32x4 x = v[ai][bj][m][n]; s += (x[0] + x[1]) + (x[2] + x[3]); }
                s += __shfl_xor(s, 16); s += __shfl_xor(s, 32);
                const float mw = s * (1.0f / 64.0f); float q = 0.f;
#pragma unroll
                for (int bj = 0; bj < 2; ++bj)
#pragma unroll
                    for (int n = 0; n < 2; ++n) { const f32x4 d = v[ai][bj][m][n] - mw; q += (d[0] * d[0] + d[1] * d[1]) + (d[2] * d[2] + d[3] * d[3]); }
                q += __shfl_xor(q, 16); q += __shfl_xor(q, 32);
                if (fq == 0) P[(ai * HALF + wr * 64 + m * 16 + fr) * 4 + wc] = (f32x2v){mw, q};
            }
        asm volatile("s_waitcnt lgkmcnt(0)" ::: "memory"); __builtin_amdgcn_s_barrier(); asm volatile("" ::: "memory");
#if defined(BROKEN_EXCHANGE_NO_WAIT)
#warning BROKEN CONTROL BUILD: the row-statistics exchange does not wait; results are wrong by design
        if (blockIdx.x >= 64) { const long long t0_ = clock64(); while (clock64() - t0_ < 60000) __builtin_amdgcn_s_sleep(8); }
#endif
        const int row = wid * 32 + (lane & 31);
        if (lane < 32) {
            const f32x2v a = P[row * 4 + 0], b = P[row * 4 + 1], c = P[row * 4 + 2], d = P[row * 4 + 3];
            const float mt = (a.x + b.x + c.x + d.x) * 0.25f;
            const float da = a.x - mt, db = b.x - mt, dc = c.x - mt, dd = d.x - mt;
            const float m2 = (a.y + b.y) + (c.y + d.y) + 64.0f * ((da * da + db * db) + (dc * dc + dd * dd));
            unsigned long long* slot = (unsigned long long*)xbuf + ((size_t)(u.pm * BM + row) * 4 + u.pn);
            __hip_atomic_store(slot, ((unsigned long long)__float_as_uint(m2) << 32) | __float_as_uint(mt), __ATOMIC_RELAXED, __HIP_MEMORY_SCOPE_AGENT);
        }
        asm volatile("s_waitcnt vmcnt(0)" ::: "memory");
        if (lane == 0) __hip_atomic_fetch_add(cnt + 64 * u.pm, 1u, __ATOMIC_RELAXED, __HIP_MEMORY_SCOPE_AGENT);
        if (wid == 0) {
            bool dead = false; const unsigned long long t0 = __builtin_amdgcn_s_memrealtime(); const unsigned want = 8u * (unsigned)ntn;
            for (;;) {
#if defined(BROKEN_EXCHANGE_NO_WAIT)
                break;
#endif
                if ((unsigned)__builtin_amdgcn_readfirstlane(__hip_atomic_load(cnt + 64 * u.pm, __ATOMIC_RELAXED, __HIP_MEMORY_SCOPE_AGENT)) >= want) break;
                if (__builtin_amdgcn_s_memrealtime() - t0 > 2000000ull) {
                    if (lane == 0) { unsigned expect = 0u; __hip_atomic_compare_exchange_strong(tmo + 1, &expect, code | (unsigned)(u.pm & 0xff), __ATOMIC_RELAXED, __ATOMIC_RELAXED, __HIP_MEMORY_SCOPE_AGENT);
                                     __hip_atomic_store(tmo, 1u, __ATOMIC_RELAXED, __HIP_MEMORY_SCOPE_AGENT); }
                    dead = true; break; }
                __builtin_amdgcn_s_sleep(2);
            }
            __builtin_amdgcn_fence(__ATOMIC_ACQUIRE, "agent");
            if (lane == 0) flag[0] = dead ? 1u : 0u;
        }
        asm volatile("s_waitcnt vmcnt(0) lgkmcnt(0)" ::: "memory"); __builtin_amdgcn_s_barrier(); asm volatile("" ::: "memory");
        const bool bad = flag[0] != 0u;
        if (lane < 32) {
            const unsigned long long* slot = (const unsigned long long*)xbuf + (size_t)(u.pm * BM + row) * 4; float mt[4], m2[4]; float ms = 0.f;
#pragma unroll
            for (int t = 0; t < 4; ++t) { if (t < ntn) { const unsigned long long w = __hip_atomic_load(slot + t, __ATOMIC_RELAXED, __HIP_MEMORY_SCOPE_AGENT); mt[t] = __uint_as_float((unsigned)w); m2[t] = __uint_as_float((unsigned)(w >> 32)); } else { mt[t] = 0.f; m2[t] = 0.f; } ms += mt[t]; }
            const float mean = ms / (float)ntn; float q = 0.f;
#pragma unroll
            for (int t = 0; t < 4; ++t) if (t < ntn) { const float dm = mt[t] - mean; q += m2[t] + 256.0f * dm * dm; }
            S[row] = (f32x2v){mean, 1.0f / sqrtf(q / (256.0f * (float)ntn) + eps)};
        }
        asm volatile("s_waitcnt lgkmcnt(0)" ::: "memory"); __builtin_amdgcn_s_barrier(); asm volatile("" ::: "memory");
        return bad;
    }
};
struct EpiLnRes {
    static constexpr bool PERM = false, AFTER_DRAIN = true;
    const float* base; float* out; int ldc; const float* bias; PanelStats st; unsigned poison;
    __device__ __forceinline__ void fused(f32x4 (&acc)[2][2][4][2], const Unit& u, int wr, int wc, int fr, int fq, PG8_LAS unsigned char* lds, int wid, int lane) const {
        typedef float f32x2v __attribute__((ext_vector_type(2)));
        const PG8_LAS f32x2v* S = (const PG8_LAS f32x2v*)(lds + 8192);
        const int col0 = u.pn * BM + wc * 32 + 4 * fq;
#pragma unroll
        for (int bj = 0; bj < 2; ++bj)
#pragma unroll
            for (int n = 0; n < 2; ++n) { const f32x4 bv = bias ? *(const f32x4*)(bias + col0 + bj * HALF + n * 16) : (f32x4){0.f, 0.f, 0.f, 0.f};
#pragma unroll
                for (int ai = 0; ai < 2; ++ai)
#pragma unroll
                    for (int m = 0; m < 4; ++m) acc[ai][bj][m][n] += bv; }
        f32x4 pre[4][2][2];
#pragma unroll
        for (int m = 0; m < 4; ++m) { const size_t off = (size_t)(u.pm * BM + wr * 64 + m * 16 + fr) * ldc + col0;
#pragma unroll
            for (int bj = 0; bj < 2; ++bj)
#pragma unroll
                for (int n = 0; n < 2; ++n) pre[m][bj][n] = *(const f32x4*)(base + off + bj * HALF + n * 16); }
        const bool bad = st.run(acc, u, wr, wc, fr, fq, lds, wid, lane) || poison != 0u;
        const float qnan = __builtin_nanf("");
#pragma unroll
        for (int ai = 0; ai < 2; ++ai)
#pragma unroll
            for (int m = 0; m < 4; ++m) { const int r = ai * HALF + wr * 64 + m * 16 + fr; const f32x2v sr = S[r]; const size_t off = (size_t)(u.pm * BM + r) * ldc + col0;
#pragma unroll
                for (int bj = 0; bj < 2; ++bj)
#pragma unroll
                    for (int n = 0; n < 2; ++n) { const f32x4 bs = ai == 0 ? pre[m][bj][n] : *(const f32x4*)(base + off + bj * HALF + n * 16); f32x4 o = bs + (acc[ai][bj][m][n] - sr.x) * sr.y;
                        if (bad) o = (f32x4){qnan, qnan, qnan, qnan}; *(f32x4*)(out + off + bj * HALF + n * 16) = o; }
                if (m & 1) asm volatile("" ::: "memory"); }
    }
};
struct EpiLnResLn {
    static constexpr bool PERM = false, AFTER_DRAIN = true;
    const float* base; float* out; bf16_t* xn; int ldc; const float* bias; PanelStats st1, st2; unsigned poison;
    __device__ __forceinline__ void fused(f32x4 (&acc)[2][2][4][2], const Unit& u, int wr, int wc, int fr, int fq, PG8_LAS unsigned char* lds, int wid, int lane) const {
        typedef float f32x2v __attribute__((ext_vector_type(2))); typedef unsigned u32x2v __attribute__((ext_vector_type(2)));
        const PG8_LAS f32x2v* S = (const PG8_LAS f32x2v*)(lds + 8192);
        const int col0 = u.pn * BM + wc * 32 + 4 * fq;
#pragma unroll
        for (int bj = 0; bj < 2; ++bj)
#pragma unroll
            for (int n = 0; n < 2; ++n) { const f32x4 bv = bias ? *(const f32x4*)(bias + col0 + bj * HALF + n * 16) : (f32x4){0.f, 0.f, 0.f, 0.f};
#pragma unroll
                for (int ai = 0; ai < 2; ++ai)
#pragma unroll
                    for (int m = 0; m < 4; ++m) acc[ai][bj][m][n] += bv; }
        bool bad = st1.run(acc, u, wr, wc, fr, fq, lds, wid, lane) || poison != 0u;
        const float qnan = __builtin_nanf("");
#pragma unroll
        for (int ai = 0; ai < 2; ++ai)
#pragma unroll
            for (int m = 0; m < 4; ++m) { const int r = ai * HALF + wr * 64 + m * 16 + fr; const f32x2v sr = S[r]; const size_t off = (size_t)(u.pm * BM + r) * ldc + col0;
#pragma unroll
                for (int bj = 0; bj < 2; ++bj)
#pragma unroll
                    for (int n = 0; n < 2; ++n) { const f32x4 bs = *(const f32x4*)(base + off + bj * HALF + n * 16); acc[ai][bj][m][n] = bs + (acc[ai][bj][m][n] - sr.x) * sr.y; }
                asm volatile("" : "+v"(acc[ai][0][m][0]), "+v"(acc[ai][0][m][1]), "+v"(acc[ai][1][m][0]), "+v"(acc[ai][1][m][1]));
                if (m & 1) asm volatile("" ::: "memory"); }
        const bool bad1 = bad;
        bad = st2.run(acc, u, wr, wc, fr, fq, lds, wid, lane) || bad;
#pragma unroll
        for (int ai = 0; ai < 2; ++ai)
#pragma unroll
            for (int m = 0; m < 4; ++m) { const int r = ai * HALF + wr * 64 + m * 16 + fr; const f32x2v sr = S[r]; const size_t off = (size_t)(u.pm * BM + r) * ldc + col0;
#pragma unroll
                for (int bj = 0; bj < 2; ++bj)
#pragma unroll
                    for (int n = 0; n < 2; ++n) { const f32x4 x1 = acc[ai][bj][m][n]; *(f32x4*)(out + off + bj * HALF + n * 16) = bad1 ? (f32x4){qnan, qnan, qnan, qnan} : x1;
                        const f32x4 o = (x1 - sr.x) * sr.y; u32x2v w; w.x = cvt_pk_bf16(o[0], o[1]); w.y = cvt_pk_bf16(o[2], o[3]);
                        if (bad) { w.x = 0x7fc07fc0u; w.y = 0x7fc07fc0u; } *(u32x2v*)(xn + off + bj * HALF + n * 16) = w; }
                asm volatile("" ::: "memory"); }
    }
};

template <class Epi, class Sched, bool ALIGN_EPI = false, bool SP2 = false>
__device__ __forceinline__ void gemm_phase(PG8_LAS unsigned char* lds, const Gemm g, const Sched& S, const Epi& E) {
    const int tid = threadIdx.x, wid = __builtin_amdgcn_readfirstlane(tid >> 6), lane = tid & 63, wr = wid >> 2, wc = wid & 3, fr = lane & 15, fq = lane >> 4;
    const int K = g.K, nt = K / BK;
    unsigned voffA[2], voffB[2];
#pragma unroll
    for (int i = 0; i < 2; ++i) { int R, C; stage_rc(tid * 16 + i * 8192, R, C); const int Rb = Epi::PERM ? ((R & ~31) + perm32(R & 31)) : R;
        voffA[i] = (unsigned)(R * K + C) * 2u; voffB[i] = (unsigned)(Rb * K + C) * 2u; }
    const size_t kstep = (size_t)(BK * 2);
    const size_t hstep = (size_t)HALF * K * 2;
    const size_t tstep = 2 * hstep;
    const unsigned ldsw = (unsigned)wid * 1024u;
    const int aoff = lds_byte(wr * 64 + fr, fq * 8), boff = lds_byte(wc * 32 + fr, fq * 8);
#define PG8_SA(b, h) (((b) * 2 + (h)) * HTB)
#define PG8_SB(b, h) ((4 + (b) * 2 + (h)) * HTB)
#define PG8_STAGE(bufoff, gbase, voff) do { _Pragma("unroll") for (int _i = 0; _i < 2; ++_i) \
        __builtin_amdgcn_global_load_lds((const unsigned*)((const char*)(gbase) + (voff)[_i]), (PG8_LAS unsigned*)(lds + (bufoff) + ldsw + _i * 8192), 16, 0, 0); } while (0)
#define PG8_LDA(dst, b, h) do { _Pragma("unroll") for (int m = 0; m < 4; ++m) _Pragma("unroll") for (int k = 0; k < 2; ++k) dst[m][k] = *(const PG8_LAS bf16x8*)(lds + PG8_SA(b, h) + aoff + m * 2048 + k * 1024); } while (0)
#define PG8_LDB(dst, b, h) do { _Pragma("unroll") for (int n = 0; n < 2; ++n) _Pragma("unroll") for (int k = 0; k < 2; ++k) dst[n][k] = *(const PG8_LAS bf16x8*)(lds + PG8_SB(b, h) + boff + n * 2048 + k * 1024); } while (0)
#define PG8_MMA(ai, bj, At, Bt) do { __builtin_amdgcn_s_setprio(1); _Pragma("unroll") for (int m = 0; m < 4; ++m) _Pragma("unroll") for (int n = 0; n < 2; ++n) _Pragma("unroll") for (int k = 0; k < 2; ++k) \
        acc[ai][bj][m][n] = __builtin_amdgcn_mfma_f32_16x16x32_bf16(Bt[n][k], At[m][k], acc[ai][bj][m][n], 0, 0, 0); __builtin_amdgcn_s_setprio(0); } while (0)
#define PG8_WAIT_V(n) asm volatile("s_waitcnt vmcnt(" #n ")" ::: "memory")
#define PG8_WAIT_L(n) asm volatile("s_waitcnt lgkmcnt(" #n ")" ::: "memory")
#define PG8_BAR __builtin_amdgcn_s_barrier()
#define PG8_SCHED __builtin_amdgcn_sched_barrier(0)
    Unit cur, nxt; int ui = 0;
    if (!S.next(0, cur)) return;
    f32x4 acc[2][2][4][2];
#pragma unroll
    for (int a = 0; a < 2; ++a)
#pragma unroll
        for (int b = 0; b < 2; ++b)
#pragma unroll
            for (int m = 0; m < 4; ++m)
#pragma unroll
                for (int n = 0; n < 2; ++n) acc[a][b][m][n] = (f32x4){0.f, 0.f, 0.f, 0.f};
    bf16x8 At[4][2], B0[2][2], B1[2][2];
    const char* cA = (const char*)g.A + (size_t)cur.pm * tstep; const char* cB = (const char*)g.Bt + (size_t)cur.pn * tstep;
    S.a_ready(cur);
    if constexpr (SP2) {
        PG8_STAGE(PG8_SB(0, 0), cB, voffB); PG8_STAGE(PG8_SB(0, 1), cB + hstep, voffB); PG8_STAGE(PG8_SA(0, 0), cA, voffA); PG8_STAGE(PG8_SA(0, 1), cA + hstep, voffA);
        if (wr == 1) PG8_BAR;
        PG8_WAIT_V(2); PG8_BAR;
        PG8_STAGE(PG8_SB(1, 0), cB + kstep, voffB); PG8_STAGE(PG8_SA(1, 0), cA + kstep, voffA); PG8_STAGE(PG8_SB(1, 1), cB + hstep + kstep, voffB);
        PG8_WAIT_V(6); PG8_BAR;
    } else {
        PG8_STAGE(PG8_SB(0, 0), cB, voffB); PG8_STAGE(PG8_SA(0, 0), cA, voffA); PG8_STAGE(PG8_SB(0, 1), cB + hstep, voffB); PG8_STAGE(PG8_SA(0, 1), cA + hstep, voffA);
        if (wr == 1) PG8_BAR;
        PG8_WAIT_V(4); PG8_BAR;
        PG8_STAGE(PG8_SB(1, 0), cB + kstep, voffB); PG8_STAGE(PG8_SA(1, 0), cA + kstep, voffA); PG8_STAGE(PG8_SB(1, 1), cB + hstep + kstep, voffB);
        PG8_WAIT_V(6); PG8_BAR;
    }
    for (;;) {
        const bool has_next = S.next(ui + 1, nxt);
        const char* nA = has_next ? (const char*)g.A + (size_t)nxt.pm * tstep : cA; const char* nB = has_next ? (const char*)g.Bt + (size_t)nxt.pn * tstep : cB;
        for (int t = 0; t < nt; t += 2) {
            const bool last = (t == nt - 2);
            const char* a1 = cA + (size_t)(t + 1) * kstep;
            const char* a2 = last ? nA : cA + (size_t)(t + 2) * kstep; const char* b2 = last ? nB : cB + (size_t)(t + 2) * kstep;
            const char* a3 = a2 + kstep; const char* b3 = b2 + kstep;
            if (last && has_next) S.a_ready(nxt);
            if constexpr (SP2) {
            PG8_LDB(B0, 0, 0); PG8_LDB(B1, 0, 1); PG8_SCHED; PG8_LDA(At, 0, 0); PG8_STAGE(PG8_SA(1, 1), a1 + hstep, voffA);
            PG8_WAIT_V(8); PG8_WAIT_L(0); PG8_BAR; PG8_MMA(0, 0, At, B0); PG8_MMA(0, 1, At, B1); PG8_BAR; PG8_SCHED;
            PG8_LDA(At, 0, 1); PG8_STAGE(PG8_SB(0, 0), b2, voffB); PG8_STAGE(PG8_SB(0, 1), b2 + hstep, voffB); PG8_STAGE(PG8_SA(0, 0), a2, voffA);
            PG8_WAIT_V(8); PG8_WAIT_L(0); PG8_BAR; PG8_MMA(1, 0, At, B0); PG8_MMA(1, 1, At, B1); PG8_BAR; PG8_SCHED;
            PG8_LDB(B0, 1, 0); PG8_LDB(B1, 1, 1); PG8_SCHED; PG8_LDA(At, 1, 0); PG8_STAGE(PG8_SA(0, 1), a2 + hstep, voffA);
            PG8_WAIT_V(8); PG8_WAIT_L(0); PG8_BAR; PG8_MMA(0, 0, At, B0); PG8_MMA(0, 1, At, B1); PG8_BAR; PG8_SCHED;
            PG8_LDA(At, 1, 1); PG8_STAGE(PG8_SB(1, 0), b3, voffB); PG8_STAGE(PG8_SB(1, 1), b3 + hstep, voffB); PG8_STAGE(PG8_SA(1, 0), a3, voffA);
            PG8_WAIT_V(8); PG8_WAIT_L(0); PG8_BAR; PG8_MMA(1, 0, At, B0); PG8_MMA(1, 1, At, B1); PG8_BAR; PG8_SCHED;
            } else {
            PG8_LDB(B0, 0, 0); PG8_SCHED; PG8_LDA(At, 0, 0); PG8_STAGE(PG8_SA(1, 1), a1 + hstep, voffA);
            PG8_WAIT_L(8); PG8_BAR; PG8_WAIT_L(0); PG8_MMA(0, 0, At, B0); PG8_BAR; PG8_SCHED;
            PG8_LDB(B1, 0, 1); PG8_STAGE(PG8_SB(0, 0), b2, voffB);
            PG8_BAR; PG8_WAIT_L(0); PG8_MMA(0, 1, At, B1); PG8_BAR;
            PG8_LDA(At, 0, 1); PG8_STAGE(PG8_SA(0, 0), a2, voffA);
            PG8_BAR; PG8_WAIT_L(0); PG8_MMA(1, 0, At, B0); PG8_BAR; PG8_SCHED;
            PG8_STAGE(PG8_SB(0, 1), b2 + hstep, voffB);
            PG8_WAIT_V(6); PG8_BAR; PG8_MMA(1, 1, At, B1); PG8_BAR;
            PG8_LDB(B0, 1, 0); PG8_SCHED; PG8_LDA(At, 1, 0); PG8_STAGE(PG8_SA(0, 1), a2 + hstep, voffA);
            PG8_WAIT_L(8); PG8_BAR; PG8_WAIT_L(0); PG8_MMA(0, 0, At, B0); PG8_BAR; PG8_SCHED;
            PG8_LDB(B1, 1, 1); PG8_STAGE(PG8_SB(1, 0), b3, voffB);
            PG8_BAR; PG8_WAIT_L(0); PG8_MMA(0, 1, At, B1); PG8_BAR;
            PG8_LDA(At, 1, 1); PG8_STAGE(PG8_SA(1, 0), a3, voffA);
            PG8_BAR; PG8_WAIT_L(0); PG8_MMA(1, 0, At, B0); PG8_BAR; PG8_SCHED;
            PG8_STAGE(PG8_SB(1, 1), b3 + hstep, voffB);
            PG8_WAIT_V(6); PG8_BAR; PG8_MMA(1, 1, At, B1); PG8_BAR;
            }
        }
        if constexpr (ALIGN_EPI) { if (wr == 0) PG8_BAR; }
        if constexpr (!Epi::AFTER_DRAIN) { E(acc, cur, wr, wc, fr, fq); S.done(cur); }
        if (!has_next) break;
#pragma unroll
        for (int a = 0; a < 2; ++a)
#pragma unroll
            for (int b = 0; b < 2; ++b)
#pragma unroll
                for (int m = 0; m < 4; ++m)
#pragma unroll
                    for (int n = 0; n < 2; ++n) acc[a][b][m][n] = (f32x4){0.f, 0.f, 0.f, 0.f};
        cur = nxt; cA = nA; cB = nB; ++ui;
        if constexpr (ALIGN_EPI) { if (wr == 1) PG8_BAR; }
    }
    PG8_WAIT_V(0);
    if constexpr (!ALIGN_EPI) { if (wr == 0) PG8_BAR; }
    PG8_BAR;
    if constexpr (Epi::AFTER_DRAIN) { E.fused(acc, cur, wr, wc, fr, fq, lds, wid, lane); S.done(cur); }
#undef PG8_SA
#undef PG8_SB
#undef PG8_STAGE
#undef PG8_LDA
#undef PG8_LDB
#undef PG8_MMA
#undef PG8_WAIT_V
#undef PG8_WAIT_L
#undef PG8_BAR
#undef PG8_SCHED
}
}
namespace pg8 {
struct EpiF32 {
    static constexpr bool PERM = false, AFTER_DRAIN = false;
    float* C; int ldc; const float* bias;
    __device__ __forceinline__ void operator()(const f32x4 (&acc)[2][2][4][2], const Unit& u, int wr, int wc, int fr, int fq) const {
        const int row0 = u.pm * BM + wr * 64 + fr, col0 = u.pn * BM + wc * 32 + 4 * fq;
        f32x4 bv[2][2];
#pragma unroll
        for (int bj = 0; bj < 2; ++bj)
#pragma unroll
            for (int n = 0; n < 2; ++n) bv[bj][n] = bias ? *(const f32x4*)(bias + col0 + bj * HALF + n * 16) : (f32x4){0.f, 0.f, 0.f, 0.f};
#pragma unroll
        for (int ai = 0; ai < 2; ++ai)
#pragma unroll
            for (int m = 0; m < 4; ++m) { float* rowp = C + (size_t)(row0 + ai * HALF + m * 16) * ldc + col0;
#pragma unroll
                for (int bj = 0; bj < 2; ++bj)
#pragma unroll
                    for (int n = 0; n < 2; ++n) *(f32x4*)(rowp + bj * HALF + n * 16) = acc[ai][bj][m][n] + bv[bj][n]; }
    }
};

constexpr int MOE_CAP = 16384;
struct MUnit { int e, rt, pn, nvalid; };
struct MoeSched {
    const PG8_LAS int* tp; const PG8_LAS int* cnt; int NPn, G, c;
    __device__ __forceinline__ bool next(int i, MUnit& u) const {
        const int T = tp[32]; const long Lx = (long)i * G + c; if (Lx >= (long)T * NPn) return false;
        const int L = (int)Lx, tile = L / NPn; int e = 0;
#pragma unroll
        for (int k = 1; k < 32; ++k) e += (tp[k] <= tile) ? 1 : 0;
        const int rt = tile - tp[e]; int rem = cnt[e] - rt * 256; rem = rem < 256 ? rem : 256;
        u.e = __builtin_amdgcn_readfirstlane(e); u.rt = __builtin_amdgcn_readfirstlane(rt); u.pn = __builtin_amdgcn_readfirstlane(L % NPn); u.nvalid = __builtin_amdgcn_readfirstlane(rem);
        return true;
    }
};
__device__ __forceinline__ float sigmoid_fast(float z) { return __builtin_amdgcn_rcpf(1.0f + __builtin_amdgcn_exp2f(-1.4426950408889634f * z)); }
struct EpiSwiglu {
    static constexpr bool PERM = true;
    bf16_t* act; const float* b1;
    __device__ __forceinline__ void operator()(const f32x4 (&acc)[2][2][4][2], const MUnit& u, int wr, int wc, int fr, int fq) const {
        const int c0 = wc * 32 + 8 * fq; const float* bb = b1 + (size_t)u.e * 2048 + 128 * u.pn + c0;
        f32x4 bg[2], bl[2];
#pragma unroll
        for (int n = 0; n < 2; ++n) { bg[n] = *(const f32x4*)(bb + 4 * n); bl[n] = *(const f32x4*)(bb + 1024 + 4 * n); }
        bf16_t* base = act + ((size_t)u.e * MOE_CAP + (size_t)u.rt * 256 + wr * 64 + fr) * 1024 + 128 * u.pn + c0;
#pragma unroll
        for (int ai = 0; ai < 2; ++ai)
#pragma unroll
            for (int m = 0; m < 4; ++m) {
                unsigned w[4];
#pragma unroll
                for (int n = 0; n < 2; ++n) { const f32x4 g4 = acc[ai][0][m][n] + bg[n], l4 = acc[ai][1][m][n] + bl[n]; float a[4];
#pragma unroll
                    for (int j = 0; j < 4; ++j) { const float g = fminf(g4[j], 7.0f), li = fminf(fmaxf(l4[j], -7.0f), 7.0f); a[j] = g * sigmoid_fast(1.702f * g) * (li + 1.0f); }
                    w[2 * n] = cvt_pk_bf16(a[0], a[1]); w[2 * n + 1] = cvt_pk_bf16(a[2], a[3]); }
                u32x4 o; o.x = w[0]; o.y = w[1]; o.z = w[2]; o.w = w[3];
                *(u32x4*)(base + (size_t)(ai * HALF + m * 16) * 1024) = o; }
    }
};
struct EpiGateScatter {
    static constexpr bool PERM = true;
    bf16_t* y4; const float* b2; const int* tk; const float* gate;
    __device__ __forceinline__ void operator()(const f32x4 (&acc)[2][2][4][2], const MUnit& u, int wr, int wc, int fr, int fq) const {
        const int c0 = 256 * u.pn + wc * 32 + 8 * fq; const float* bb = b2 + (size_t)u.e * 1024 + c0;
        f32x4 bv[2][2];
#pragma unroll
        for (int bj = 0; bj < 2; ++bj)
#pragma unroll
            for (int n = 0; n < 2; ++n) bv[bj][n] = *(const f32x4*)(bb + bj * HALF + 4 * n);
        const size_t lbase = (size_t)u.e * MOE_CAP + (size_t)u.rt * 256;
#pragma unroll
        for (int ai = 0; ai < 2; ++ai)
#pragma unroll
            for (int m = 0; m < 4; ++m) { const int r = ai * HALF + wr * 64 + m * 16 + fr;
                if (r < u.nvalid) { const int t = tk[lbase + r]; const float g = gate[lbase + r]; bf16_t* dst = y4 + (size_t)t * 1024 + c0;
#pragma unroll
                    for (int bj = 0; bj < 2; ++bj) { const f32x4 v0 = (acc[ai][bj][m][0] + bv[bj][0]) * g, v1 = (acc[ai][bj][m][1] + bv[bj][1]) * g;
                        u32x4 o; o.x = cvt_pk_bf16(v0[0], v0[1]); o.y = cvt_pk_bf16(v0[2], v0[3]); o.z = cvt_pk_bf16(v1[0], v1[1]); o.w = cvt_pk_bf16(v1[2], v1[3]);
                        *(u32x4*)(dst + bj * HALF) = o; } } }
    }
};

template <class Epi, bool GATHER>
__device__ __forceinline__ void gemm_phase_moe(PG8_LAS unsigned char* lds, const bf16_t* A, const bf16_t* Bt, const int K, const int NB, const int* rowlist, const MoeSched& S, const Epi& E) {
    const int tid = threadIdx.x, wid = __builtin_amdgcn_readfirstlane(tid >> 6), lane = tid & 63, wr = wid >> 2, wc = wid & 3, fr = lane & 15, fq = lane >> 4;
    const int nt = K / BK;
    int RA[2]; unsigned cbA[2], voffB[2];
#pragma unroll
    for (int i = 0; i < 2; ++i) { int R, C; stage_rc(tid * 16 + i * 8192, R, C); const int Rb = Epi::PERM ? ((R & ~31) + perm32(R & 31)) : R;
        RA[i] = R; cbA[i] = (unsigned)C * 2u; voffB[i] = (unsigned)(Rb * K + C) * 2u; }
    const size_t kstep = (size_t)(BK * 2);
    const size_t hstep = (size_t)HALF * K * 2;
    const unsigned ldsw = (unsigned)wid * 1024u;
    const int aoff = lds_byte(wr * 64 + fr, fq * 8), boff = lds_byte(wc * 32 + fr, fq * 8);
#define PG8_SA(b, h) (((b) * 2 + (h)) * HTB)
#define PG8_SB(b, h) ((4 + (b) * 2 + (h)) * HTB)
#define PG8_STAGE(bufoff, gbase, voff) do { _Pragma("unroll") for (int _i = 0; _i < 2; ++_i) \
        __builtin_amdgcn_global_load_lds((const unsigned*)((const char*)(gbase) + (voff)[_i]), (PG8_LAS unsigned*)(lds + (bufoff) + ldsw + _i * 8192), 16, 0, 0); } while (0)
#define PG8_LDA(dst, b, h) do { _Pragma("unroll") for (int m = 0; m < 4; ++m) _Pragma("unroll") for (int k = 0; k < 2; ++k) dst[m][k] = *(const PG8_LAS bf16x8*)(lds + PG8_SA(b, h) + aoff + m * 2048 + k * 1024); } while (0)
#define PG8_LDB(dst, b, h) do { _Pragma("unroll") for (int n = 0; n < 2; ++n) _Pragma("unroll") for (int k = 0; k < 2; ++k) dst[n][k] = *(const PG8_LAS bf16x8*)(lds + PG8_SB(b, h) + boff + n * 2048 + k * 1024); } while (0)
#define PG8_MMA(ai, bj, At, Bt_) do { __builtin_amdgcn_s_setprio(1); _Pragma("unroll") for (int m = 0; m < 4; ++m) _Pragma("unroll") for (int n = 0; n < 2; ++n) _Pragma("unroll") for (int k = 0; k < 2; ++k) \
        acc[ai][bj][m][n] = __builtin_amdgcn_mfma_f32_16x16x32_bf16(Bt_[n][k], At[m][k], acc[ai][bj][m][n], 0, 0, 0); __builtin_amdgcn_s_setprio(0); } while (0)
#define PG8_WAIT_V(n) asm volatile("s_waitcnt vmcnt(" #n ")" ::: "memory")
#define PG8_WAIT_L(n) asm volatile("s_waitcnt lgkmcnt(" #n ")" ::: "memory")
#define PG8_BAR __builtin_amdgcn_s_barrier()
#define PG8_SCHED __builtin_amdgcn_sched_barrier(0)
#define PG8_AOFFS(dst, u) do { _Pragma("unroll") for (int _h = 0; _h < 2; ++_h) _Pragma("unroll") for (int _i = 0; _i < 2; ++_i) { \
        if constexpr (GATHER) { int _r = _h * HALF + RA[_i]; _r = _r < (u).nvalid ? _r : (u).nvalid - 1; \
            const int _tk = rowlist[(size_t)(u).e * MOE_CAP + (size_t)(u).rt * 256 + _r]; dst[_h][_i] = (unsigned)(_tk >> 2) * (unsigned)(K * 2) + cbA[_i]; } \
        else dst[_h][_i] = (unsigned)((_h * HALF + RA[_i]) * K) * 2u + cbA[_i]; } } while (0)
#define PG8_ABASE(u) (GATHER ? (const char*)A : (const char*)A + ((size_t)(u).e * MOE_CAP + (size_t)(u).rt * 256) * (size_t)K * 2)
#define PG8_BBASE(u) ((const char*)Bt + ((size_t)(u).e * NB + (size_t)(u).pn * 256) * (size_t)K * 2)
    MUnit cur, nxt; int ui = 0;
    if (!S.next(0, cur)) return;
    f32x4 acc[2][2][4][2];
#pragma unroll
    for (int a = 0; a < 2; ++a)
#pragma unroll
        for (int b = 0; b < 2; ++b)
#pragma unroll
            for (int m = 0; m < 4; ++m)
#pragma unroll
                for (int n = 0; n < 2; ++n) acc[a][b][m][n] = (f32x4){0.f, 0.f, 0.f, 0.f};
    bf16x8 At[4][2], B0[2][2], B1[2][2];
    unsigned ca[2][2], na[2][2];
    PG8_AOFFS(ca, cur);
    const char* cA = PG8_ABASE(cur); const char* cB = PG8_BBASE(cur);
    PG8_STAGE(PG8_SB(0, 0), cB, voffB); PG8_STAGE(PG8_SB(0, 1), cB + hstep, voffB); PG8_STAGE(PG8_SA(0, 0), cA, ca[0]); PG8_STAGE(PG8_SA(0, 1), cA, ca[1]);
    if (wr == 1) PG8_BAR;
    PG8_WAIT_V(2); PG8_BAR;
    PG8_STAGE(PG8_SB(1, 0), cB + kstep, voffB); PG8_STAGE(PG8_SA(1, 0), cA + kstep, ca[0]); PG8_STAGE(PG8_SB(1, 1), cB + hstep + kstep, voffB);
    PG8_WAIT_V(6); PG8_BAR;
    for (;;) {
        const bool has_next = S.next(ui + 1, nxt);
        const char* nA = has_next ? PG8_ABASE(nxt) : cA; const char* nB = has_next ? PG8_BBASE(nxt) : cB;
#pragma unroll
        for (int h = 0; h < 2; ++h)
#pragma unroll
            for (int i = 0; i < 2; ++i) na[h][i] = ca[h][i];
        for (int t = 0; t < nt; t += 2) {
            const bool last = (t == nt - 2);
            if constexpr (GATHER) { if (t == nt - 4 && has_next) PG8_AOFFS(na, nxt); }
            const char* a1 = cA + (size_t)(t + 1) * kstep;
            const char* a2 = last ? nA : cA + (size_t)(t + 2) * kstep; const char* b2 = last ? nB : cB + (size_t)(t + 2) * kstep;
            const char* a3 = a2 + kstep; const char* b3 = b2 + kstep;
            PG8_LDB(B0, 0, 0); PG8_LDB(B1, 0, 1); PG8_SCHED; PG8_LDA(At, 0, 0); PG8_STAGE(PG8_SA(1, 1), a1, ca[1]);
            if constexpr (GATHER) { if (last) {
#pragma unroll
                for (int h = 0; h < 2; ++h)
#pragma unroll
                    for (int i = 0; i < 2; ++i) ca[h][i] = na[h][i]; } }
            PG8_WAIT_V(8); PG8_WAIT_L(0); PG8_BAR; PG8_MMA(0, 0, At, B0); PG8_MMA(0, 1, At, B1); PG8_BAR; PG8_SCHED;
            PG8_LDA(At, 0, 1); PG8_STAGE(PG8_SB(0, 0), b2, voffB); PG8_STAGE(PG8_SB(0, 1), b2 + hstep, voffB); PG8_STAGE(PG8_SA(0, 0), a2, ca[0]);
            PG8_WAIT_V(8); PG8_WAIT_L(0); PG8_BAR; PG8_MMA(1, 0, At, B0); PG8_MMA(1, 1, At, B1); PG8_BAR; PG8_SCHED;
            PG8_LDB(B0, 1, 0); PG8_LDB(B1, 1, 1); PG8_SCHED; PG8_LDA(At, 1, 0); PG8_STAGE(PG8_SA(0, 1), a2, ca[1]);
            PG8_WAIT_V(8); PG8_WAIT_L(0); PG8_BAR; PG8_MMA(0, 0, At, B0); PG8_MMA(0, 1, At, B1); PG8_BAR; PG8_SCHED;
            PG8_LDA(At, 1, 1); PG8_STAGE(PG8_SB(1, 0), b3, voffB); PG8_STAGE(PG8_SB(1, 1), b3 + hstep, voffB); PG8_STAGE(PG8_SA(1, 0), a3, ca[0]);
            PG8_WAIT_V(8); PG8_WAIT_L(0); PG8_BAR; PG8_MMA(1, 0, At, B0); PG8_MMA(1, 1, At, B1); PG8_BAR; PG8_SCHED;
        }
        if (wr == 0) PG8_BAR;
        E(acc, cur, wr, wc, fr, fq);
        if (!has_next) break;
#pragma unroll
        for (int a = 0; a < 2; ++a)
#pragma unroll
            for (int b = 0; b < 2; ++b)
#pragma unroll
                for (int m = 0; m < 4; ++m)
#pragma unroll
                    for (int n = 0; n < 2; ++n) acc[a][b][m][n] = (f32x4){0.f, 0.f, 0.f, 0.f};
        cur = nxt; cA = nA; cB = nB; ++ui;
        if (wr == 1) PG8_BAR;
    }
    PG8_WAIT_V(0);
    PG8_BAR;
#undef PG8_SA
#undef PG8_SB
#undef PG8_STAGE
#undef PG8_LDA
#undef PG8_LDB
#undef PG8_MMA
#undef PG8_WAIT_V
#undef PG8_WAIT_L
#undef PG8_BAR
#undef PG8_SCHED
#undef PG8_AOFFS
#undef PG8_ABASE
#undef PG8_BBASE
}
}
#include <hip/hip_bf16.h>
namespace attn_body {
using bf16=__hip_bfloat16;
using bf16x8=__attribute__((ext_vector_type(8)))short;
using s16x4=__attribute__((ext_vector_type(4)))short;
using f32x16=__attribute__((ext_vector_type(16)))float;
using u32x4=__attribute__((ext_vector_type(4)))unsigned;
constexpr int BATCH=2,NHEAD=4,SEQ=8192,D=64,DM=2816,DO=1024;
constexpr int NW=8,QBLK=32,QB=QBLK*NW,KVBLK=64,NQB=SEQ/QB;
constexpr int ATTN_PITCH=DM, ATTN_UNIT_ROWS=QB;
constexpr float LOG2E_F=1.4426950408889634f;
__device__ __forceinline__ int crow(int r,int hi){return (r&3)+8*(r>>2)+4*hi;}
#define SBAR() __builtin_amdgcn_sched_barrier(0)
__device__ __forceinline__ void cmask(f32x16&p0,f32x16&p1,int jb,int qrel,int hi){
  const float NEG=-INFINITY; int kb=64*jb+4*hi;
  #pragma unroll
  for(int r=0;r<16;++r){int kv=kb+(r&3)+8*(r>>2); if(kv>qrel)p0[r]=NEG; if(kv+32>qrel)p1[r]=NEG;}
}

constexpr int NSLOT=3, SLOTB=8192;
constexpr int LDS_K=0, LDS_V=NSLOT*SLOTB, LDS_WS=2*NSLOT*SLOTB, LDS_OST=LDS_WS+NW*64*4, LDS_BYTES=LDS_OST+NW*4096, LDS_FB=86016, LDS_FB_BYTES=32768;
constexpr float C2=0.125f*1.4426950408889634f;
__device__ __forceinline__ void glds16(const void*gsrc,unsigned lds_dst){unsigned keep;
  asm volatile("s_mov_b32 %0, m0\n\ts_mov_b32 m0, %2\n\ts_nop 0\n\tglobal_load_lds_dwordx4 %1, off\n\ts_mov_b32 m0, %0":"=&s"(keep):"v"(gsrc),"s"(lds_dst):"memory");}
__device__ __forceinline__ float max3f(float a,float b,float c){float r;asm("v_max3_f32 %0, %1, %2, %3":"=v"(r):"v"(a),"v"(b),"v"(c));return r;}
__device__ __forceinline__ float max2f(float a,float b){float r;asm("v_max_f32_e32 %0, %1, %2":"=v"(r):"v"(a),"v"(b));return r;}
__device__ __forceinline__ float fadd_s(float a,float b){float r;asm("v_add_f32_e32 %0, %1, %2":"=v"(r):"v"(a),"v"(b));return r;}
__device__ __forceinline__ float fsub_s(float a,float b){float r;asm("v_sub_f32_e32 %0, %1, %2":"=v"(r):"v"(a),"v"(b));return r;}
typedef float f32x2_t __attribute__((ext_vector_type(2))); typedef __bf16 bf16x2_t __attribute__((ext_vector_type(2)));
__device__ __forceinline__ unsigned cvtpk_s(float lo,float hi){f32x2_t v={lo,hi};bf16x2_t b=__builtin_convertvector(v,bf16x2_t);return __builtin_bit_cast(unsigned,b);}
#define WAIT_BAR(N) asm volatile("s_waitcnt vmcnt(" #N ") lgkmcnt(0)\n\ts_barrier":::"memory")

__device__ __forceinline__ void qkt(f32x16&p0,f32x16&p1,const char*Kslot,const bf16x8*qr,int r32,int hi){
  const char*kb=Kslot+hi*1024+r32*16;
  #pragma unroll
  for(int d0=0;d0<4;++d0){
    const bf16x8 b0=*reinterpret_cast<const bf16x8*>(kb+d0*2048);
    const bf16x8 b1=*reinterpret_cast<const bf16x8*>(kb+d0*2048+512);
    {p0=__builtin_amdgcn_mfma_f32_32x32x16_bf16(b0,qr[d0],p0,0,0,0);p1=__builtin_amdgcn_mfma_f32_32x32x16_bf16(b1,qr[d0],p1,0,0,0);}}
}
typedef __attribute__((address_space(3))) const char* lds_cptr;
typedef short v4i16_t __attribute__((ext_vector_type(4)));
__device__ __forceinline__ void kload8(bf16x8*kf,lds_cptr kp){
  kf[0]=*(const __attribute__((address_space(3))) bf16x8*)(kp);      kf[1]=*(const __attribute__((address_space(3))) bf16x8*)(kp+512);
  kf[2]=*(const __attribute__((address_space(3))) bf16x8*)(kp+2048); kf[3]=*(const __attribute__((address_space(3))) bf16x8*)(kp+2560);
  kf[4]=*(const __attribute__((address_space(3))) bf16x8*)(kp+4096); kf[5]=*(const __attribute__((address_space(3))) bf16x8*)(kp+4608);
  kf[6]=*(const __attribute__((address_space(3))) bf16x8*)(kp+6144); kf[7]=*(const __attribute__((address_space(3))) bf16x8*)(kp+6656);
}
__device__ __forceinline__ void kload2(bf16x8*kf,lds_cptr kp,int j){ kf[2*j]=*(const __attribute__((address_space(3))) bf16x8*)(kp+j*2048); kf[2*j+1]=*(const __attribute__((address_space(3))) bf16x8*)(kp+j*2048+512); }
__device__ __forceinline__ s16x4 vtr(lds_cptr p){ return __builtin_bit_cast(s16x4,__builtin_amdgcn_ds_read_tr16_b64_v4i16((__attribute__((address_space(3))) v4i16_t*)p)); }
__device__ __forceinline__ float rowmax(const f32x16&p0,const f32x16&p1){
  float a=max3f(p0[0],p0[1],p1[0]),b=max3f(p0[2],p0[3],p1[1]);a=max3f(a,p1[2],p1[3]);
  #pragma unroll
  for(int r=4;r<16;r+=4){a=max3f(a,p0[r],p0[r+1]);b=max3f(b,p0[r+2],p0[r+3]);a=max3f(a,p1[r],p1[r+1]);b=max3f(b,p1[r+2],p1[r+3]);}
  const float m=max2f(a,b);
  auto rr=__builtin_amdgcn_permlane32_swap(__float_as_uint(m),__float_as_uint(m),false,false);
  return max2f(__uint_as_float(rr[0]),__uint_as_float(rr[1]));
}
__device__ __forceinline__ void pv(f32x16*o,int vb,bf16x8 pa0,bf16x8 pa1,bf16x8 pa2,bf16x8 pa3){
  #pragma unroll
  for(int d0=0;d0<2;++d0){s16x4 lo[4],hi[4];
    #pragma unroll
    for(int ks=0;ks<4;++ks){
      asm volatile("ds_read_b64_tr_b16 %0,%1 offset:%c2":"=&v"(lo[ks]):"v"(vb),"i"(d0*4096+ks*1024):"memory");
      asm volatile("ds_read_b64_tr_b16 %0,%1 offset:%c2":"=&v"(hi[ks]):"v"(vb),"i"(d0*4096+ks*1024+512):"memory");}
    asm volatile("s_waitcnt lgkmcnt(0)":::"memory");SBAR();
    #define PK(k) (bf16x8){lo[k][0],lo[k][1],lo[k][2],lo[k][3],hi[k][0],hi[k][1],hi[k][2],hi[k][3]}
    o[d0]=__builtin_amdgcn_mfma_f32_32x32x16_bf16(pa0,PK(0),o[d0],0,0,0);
    o[d0]=__builtin_amdgcn_mfma_f32_32x32x16_bf16(pa1,PK(1),o[d0],0,0,0);
    o[d0]=__builtin_amdgcn_mfma_f32_32x32x16_bf16(pa2,PK(2),o[d0],0,0,0);
    o[d0]=__builtin_amdgcn_mfma_f32_32x32x16_bf16(pa3,PK(3),o[d0],0,0,0);
    #undef PK
  }
}

#ifndef ATTN_STORE16
#define ATTN_STORE16(p,v) (*(u32x4*)(p)=(v))
#endif
template<int THRL> __device__ __forceinline__ void attn_unit(int b,int h,int qb,const bf16*Q,const bf16*__restrict__ K,const bf16*__restrict__ V,bf16*O,const float*__restrict__ Fg,char*shm){
  const int tid=threadIdx.x,lane=tid&63,r32=lane&31,hi=lane>>5; const int wid=__builtin_amdgcn_readfirstlane(tid>>6);
  const long rowbase=(long)b*SEQ; const int q0=qb*QB;
  const bf16*Qw=Q+(rowbase+q0+wid*QBLK)*DM+h*D;
  const bf16*Kh=K+rowbase*DM+h*D,*Vh=V+rowbase*DM+h*D;
  const unsigned lds0=(unsigned)(uintptr_t)shm;
  float*wsf=(float*)(shm+LDS_WS)+wid*64;
  const bf16*ksrc=Kh+(long)lane*DM+wid*8;
  const bf16*vsrc=Vh+(long)(16*(wid&3)+(lane>>2))*DM+(wid>>2)*32+(lane&3)*8;
  const unsigned kdst=lds0+LDS_K+wid*1024, vdst=lds0+LDS_V+wid*1024;
  #define DMA_K(t,slot) glds16(ksrc+(long)(t)*KVBLK*DM,(unsigned)__builtin_amdgcn_readfirstlane(kdst+(slot)))
  #define DMA_V(t,slot) glds16(vsrc+(long)(t)*KVBLK*DM,(unsigned)__builtin_amdgcn_readfirstlane(vdst+(slot)))
  const int vb0=(int)(lds0+LDS_V)+((lane>>4)&1)*32+(lane&3)*8+(4*hi+((lane&15)>>2))*64;
  const char*Kbase=shm+LDS_K; bf16x8 kf[8];
  const lds_cptr shm3=(lds_cptr)shm; const lds_cptr kp0=shm3+LDS_K+hi*1024+r32*16; const lds_cptr vp0=shm3+LDS_V+((lane>>4)&1)*32+(lane&3)*8+(4*hi+((lane&15)>>2))*64;
  const int NT=(q0+QB)/KVBLK;
  typedef __attribute__((address_space(3))) float lds_f; typedef float f32x4b __attribute__((ext_vector_type(4)));
  lds_f*const Fb3=(lds_f*)(shm3+LDS_FB);
  { for(int j=tid;j<NT*KVBLK;j+=NW*64) Fb3[j]=-Fg[j]*LOG2E_F; }
  #define INITB(P0,P1,t) do{ const lds_f*fb_=Fb3+(t)*KVBLK+4*hi; \
    _Pragma("unroll") for(int g_=0;g_<4;++g_){ const f32x4b b0_=*(const __attribute__((address_space(3))) f32x4b*)(fb_+8*g_), b1_=*(const __attribute__((address_space(3))) f32x4b*)(fb_+32+8*g_); \
      P0[4*g_]=b0_[0]-mhat;P0[4*g_+1]=b0_[1]-mhat;P0[4*g_+2]=b0_[2]-mhat;P0[4*g_+3]=b0_[3]-mhat; P1[4*g_]=b1_[0]-mhat;P1[4*g_+1]=b1_[1]-mhat;P1[4*g_+2]=b1_[2]-mhat;P1[4*g_+3]=b1_[3]-mhat; } }while(0)
  DMA_K(0,0);DMA_V(0,0);DMA_K(1,SLOTB);
  bf16x8 qr[4];
  #pragma unroll
  for(int d0=0;d0<4;++d0)qr[d0]=*reinterpret_cast<const bf16x8*>(&Qw[(long)r32*DM+d0*16+hi*8]);
  float mhat=0.f,l_reg=0.f;f32x16 o[2];o[0]=f32x16{};o[1]=f32x16{};
  const int qrel=wid*QBLK+r32;
  #define CMASK(P0,P1,t) do{int jb_=(t)-(NT-4); if(jb_>=0)cmask(P0,P1,jb_,qrel,hi);}while(0)
  bool resc=false;
  #define START(P0,P1) do{ const float rm=rowmax(P0,P1); resc=false; \
    { const float dl=rm; mhat=fadd_s(mhat,dl); \
      _Pragma("unroll") for(int r=0;r<16;++r){P0[r]=fsub_s(P0[r],dl);P1[r]=fsub_s(P1[r],dl);} } \
    _Pragma("unroll") for(int r=0;r<16;++r)P0[r]=__builtin_amdgcn_exp2f(P0[r]); }while(0)
  #define RESC() do{ if(resc){ asm volatile("s_waitcnt lgkmcnt(0)":::"memory"); \
      _Pragma("unroll") for(int d_=0;d_<2;++d_) _Pragma("unroll") for(int r=0;r<16;++r)o[d_][r]*=wsf[crow(r,hi)]; } }while(0)
  f32x16 pA0,pA1,pB0,pB1;
  int sl_prev=0,sl_cur=0,sl_next=SLOTB;
  #define ROT() do{sl_prev=sl_cur;sl_cur=sl_next;sl_next=(sl_next==(NSLOT-1)*SLOTB)?0:sl_next+SLOTB;}while(0)
  DMA_K(2,2*SLOTB);
  WAIT_BAR(3);
  asm volatile("s_waitcnt lgkmcnt(0)":::"memory"); INITB(pA0,pA1,0);
  qkt(pA0,pA1,Kbase,qr,r32,hi);asm volatile("s_nop 15\n\ts_nop 7":"+v"(pA0),"+v"(pA1));CMASK(pA0,pA1,0);
  START(pA0,pA1);
  _Pragma("unroll") for(int r=0;r<16;++r)pA1[r]=__builtin_amdgcn_exp2f(pA1[r]);
  WAIT_BAR(0);
  DMA_K(3,0);DMA_V(1,SLOTB);
  ROT();
  kload8(kf,kp0+sl_cur);
  INITB(pB0,pB1,1);
  WAIT_BAR(2);
  s16x4 vlo[8],vhi[8]; u32x4 pw0,pw1,pw2,pw3;
  #define PKW(P,B) cvtpk_s(P[B],P[B+1])
  #define PAF(k) __builtin_bit_cast(bf16x8,pw##k)
  #define VFR(i) (bf16x8){vlo[i][0],vlo[i][1],vlo[i][2],vlo[i][3],vhi[i][0],vhi[i][1],vhi[i][2],vhi[i][3]}
  #define PIN(x) asm volatile("":"+v"(x))
  #define MX3(a,b,c) __builtin_fmaxf(__builtin_fmaxf((a),(b)),(c))
  #define GAPA(MF,A0,A1,A2,A3,W0,W1,PW) do{ MF; sacc+=A0; sacc+=A1; sacc+=A2; sacc+=A3; PIN(sacc); W0; W1; PIN(PW); SBAR(); }while(0)
  #define EX(v) __builtin_amdgcn_exp2f(v)
  #define GAPB(MF,X,B) do{ MF; X[B]=EX(X[B]); X[B+1]=EX(X[B+1]); X[B+2]=EX(X[B+2]); X[B+3]=EX(X[B+3]); PIN(X); SBAR(); }while(0)
  #define VRD(i) do{ vlo[i]=vtr(vp_+(((i)>>2)*4096+((i)&3)*1024)); vhi[i]=vtr(vp_+(((i)>>2)*4096+((i)&3)*1024+512)); }while(0)
  #define KRD(G,j) do{ if(G){ kload2(kf,kp0+sl_next,j); SBAR(); } }while(0)
  #define STEP(C0,C1,P0,P1,t,GK,GV,GL) do{ SBAR(); \
    const lds_cptr vp_=vp0+sl_prev; \
    VRD(0); SBAR(); float sacc=(P0[0]+P0[1]); \
    GAPA(C0=__builtin_amdgcn_mfma_f32_32x32x16_bf16(kf[0],qr[0],C0,0,0,0), P0[2],P0[3],P0[4],P0[5],     pw0[0]=PKW(P0,0), pw0[1]=PKW(P0,2), pw0); \
    VRD(4); SBAR(); GAPA(C1=__builtin_amdgcn_mfma_f32_32x32x16_bf16(kf[1],qr[0],C1,0,0,0), P0[6],P0[7],P0[8],P0[9],     pw0[2]=PKW(P0,4), pw0[3]=PKW(P0,6), pw0); \
    VRD(1); SBAR(); GAPA(C0=__builtin_amdgcn_mfma_f32_32x32x16_bf16(kf[2],qr[1],C0,0,0,0),   P0[10],P0[11],P0[12],P0[13], pw1[0]=PKW(P0,8), pw1[1]=PKW(P0,10), pw1); \
    VRD(5); SBAR(); GAPA(C1=__builtin_amdgcn_mfma_f32_32x32x16_bf16(kf[3],qr[1],C1,0,0,0),   P0[14],P0[15],P1[0],P1[1],   pw1[2]=PKW(P0,12),pw1[3]=PKW(P0,14), pw1); \
    VRD(2); SBAR(); GAPA(C0=__builtin_amdgcn_mfma_f32_32x32x16_bf16(kf[4],qr[2],C0,0,0,0),   P1[2],P1[3],P1[4],P1[5],     pw2[0]=PKW(P1,0), pw2[1]=PKW(P1,2), pw2); \
    VRD(6); SBAR(); GAPA(C1=__builtin_amdgcn_mfma_f32_32x32x16_bf16(kf[5],qr[2],C1,0,0,0),   P1[6],P1[7],P1[8],P1[9],     pw2[2]=PKW(P1,4), pw2[3]=PKW(P1,6), pw2); \
    VRD(3); SBAR(); GAPA(C0=__builtin_amdgcn_mfma_f32_32x32x16_bf16(kf[6],qr[3],C0,0,0,0),   P1[10],P1[11],P1[12],P1[13], pw3[0]=PKW(P1,8), pw3[1]=PKW(P1,10), pw3); \
    VRD(7); SBAR(); GAPA(C1=__builtin_amdgcn_mfma_f32_32x32x16_bf16(kf[7],qr[3],C1,0,0,0),   P1[14],P1[15],0.f,0.f,       pw3[2]=PKW(P1,12),pw3[3]=PKW(P1,14), pw3); \
    l_reg+=sacc; \
    if(GK){DMA_K((t)+3,sl_cur);} if(GV){DMA_V((t)+1,sl_next);} \
    CMASK(C0,C1,t); \
    { float a=MX3(C0[0],C0[1],C1[0]),b=MX3(C0[2],C0[3],C1[1]); a=MX3(a,C1[2],C1[3]); \
      _Pragma("unroll") for(int r=4;r<16;r+=4){a=MX3(a,C0[r],C0[r+1]);b=MX3(b,C0[r+2],C0[r+3]);a=MX3(a,C1[r],C1[r+1]);b=MX3(b,C1[r+2],C1[r+3]);} \
      float rm=__builtin_fmaxf(a,b); { auto rr=__builtin_amdgcn_permlane32_swap(__float_as_uint(rm),__float_as_uint(rm),false,false); rm=__builtin_fmaxf(__uint_as_float(rr[0]),__uint_as_float(rr[1])); } \
      resc=false; \
      if(__builtin_expect(__any(rm>(float)THRL),0)){ const float dl=__builtin_fmaxf(rm,0.f); mhat+=dl; \
        _Pragma("unroll") for(int r=0;r<16;++r){C0[r]-=dl;C1[r]-=dl;} \
        const float f=__builtin_amdgcn_exp2f(-dl); l_reg*=f; if(hi==0)wsf[r32]=f; resc=true; } } \
    SBAR(); \
    GAPB(o[0]=__builtin_amdgcn_mfma_f32_32x32x16_bf16(PAF(0),VFR(0),o[0],0,0,0), C0,0); \
    GAPB(o[1]=__builtin_amdgcn_mfma_f32_32x32x16_bf16(PAF(0),VFR(4),o[1],0,0,0), C0,4); \
    KRD(GL,0); GAPB(o[0]=__builtin_amdgcn_mfma_f32_32x32x16_bf16(PAF(1),VFR(1),o[0],0,0,0), C0,8); \
    KRD(GL,1); GAPB(o[1]=__builtin_amdgcn_mfma_f32_32x32x16_bf16(PAF(1),VFR(5),o[1],0,0,0), C0,12); \
    KRD(GL,2); GAPB(o[0]=__builtin_amdgcn_mfma_f32_32x32x16_bf16(PAF(2),VFR(2),o[0],0,0,0), C1,0); \
    KRD(GL,3); GAPB(o[1]=__builtin_amdgcn_mfma_f32_32x32x16_bf16(PAF(2),VFR(6),o[1],0,0,0), C1,4); \
    GAPB(o[0]=__builtin_amdgcn_mfma_f32_32x32x16_bf16(PAF(3),VFR(3),o[0],0,0,0), C1,8); \
    GAPB(o[1]=__builtin_amdgcn_mfma_f32_32x32x16_bf16(PAF(3),VFR(7),o[1],0,0,0), C1,12); \
    if((t)+1<NT){ INITB(P0,P1,(t)+1); } \
    }while(0)
  int t=1;
  #undef CMASK
  #define CMASK(P0,P1,t) do{}while(0)
  for(;t+5<NT;t+=2){
    STEP(pB0,pB1,pA0,pA1,t,true,true,true);     WAIT_BAR(2); RESC(); ROT();
    STEP(pA0,pA1,pB0,pB1,t+1,true,true,true);   WAIT_BAR(2); RESC(); ROT();
  }
  #undef CMASK
  #define CMASK(P0,P1,t) do{int jb_=(t)-(NT-4); if(jb_>=0)cmask(P0,P1,jb_,qrel,hi);}while(0)
  #define ENDW(tt) do{ if((tt)+3<NT){WAIT_BAR(2);} else if((tt)+2<NT){WAIT_BAR(1);} else {WAIT_BAR(0);} }while(0)
  for(;t+1<NT;t+=2){
    STEP(pB0,pB1,pA0,pA1,t,(t+3<NT),(t+1<NT),(t+1<NT));       ENDW(t);   RESC(); ROT();
    STEP(pA0,pA1,pB0,pB1,t+1,(t+4<NT),(t+2<NT),(t+2<NT));     ENDW(t+1); RESC(); ROT();
  }
  STEP(pB0,pB1,pA0,pA1,NT-1,false,false,false); RESC();
  { float sacc=pB0[0]+pB0[1]; _Pragma("unroll") for(int r=2;r<16;++r)sacc+=pB0[r]; _Pragma("unroll") for(int r=0;r<16;++r)sacc+=pB1[r]; l_reg+=sacc;
    pw0=(u32x4){PKW(pB0,0),PKW(pB0,2),PKW(pB0,4),PKW(pB0,6)};pw1=(u32x4){PKW(pB0,8),PKW(pB0,10),PKW(pB0,12),PKW(pB0,14)};pw2=(u32x4){PKW(pB1,0),PKW(pB1,2),PKW(pB1,4),PKW(pB1,6)};pw3=(u32x4){PKW(pB1,8),PKW(pB1,10),PKW(pB1,12),PKW(pB1,14)};
    SBAR(); pv(o,vb0+sl_cur,PAF(0),PAF(1),PAF(2),PAF(3)); }
  #undef PKW
  #undef PAF
  #undef VFR
  #undef PIN
  #undef MX3
  #undef GAPA
  #undef GAPB
  #undef EX
  #undef VRD
  #undef KRD
  #undef STEP
  #undef ENDW
  {auto rr=__builtin_amdgcn_permlane32_swap(__float_as_uint(l_reg),__float_as_uint(l_reg),false,false);l_reg=__uint_as_float(rr[0])+__uint_as_float(rr[1]);}
  if(hi==0)wsf[32+r32]=l_reg;asm volatile("s_waitcnt lgkmcnt(0)":::"memory");
  float rli[16];
  #pragma unroll
  for(int r=0;r<16;++r)rli[r]=__builtin_amdgcn_rcpf(wsf[32+crow(r,hi)]);
  bf16*Ow=O+(rowbase+q0+wid*QBLK)*DO+h*D;
  { bf16*stg=(bf16*)(shm+LDS_OST)+wid*2048;
    #pragma unroll
    for(int r=0;r<16;++r){const int orow=crow(r,hi);
      #pragma unroll
      for(int d0=0;d0<2;++d0)stg[orow*64+d0*32+r32]=__float2bfloat16(o[d0][r]*rli[r]);}
    asm volatile("s_waitcnt lgkmcnt(0)":::"memory");
    #pragma unroll
    for(int i=0;i<4;++i){const int row=i*8+(lane>>3),ch=lane&7; const u32x4 v=*(const u32x4*)(stg+row*64+ch*8); ATTN_STORE16(Ow+(long)row*DO+ch*8,v);} }
  asm volatile("s_waitcnt lgkmcnt(0)\n\ts_barrier":::"memory");
  #undef INITB
  #undef DMA_K
  #undef DMA_V
  #undef CMASK
  #undef START
  #undef RESC
  #undef ROT
}
constexpr int ATTN_LDS_BYTES=LDS_BYTES;
struct AttnTensors { const bf16* Q; const bf16* K; const bf16* V; bf16* O; const float* F; };
struct AttnUnit { int bh; int qb; };
struct StaticOrder {
  int vcu,G;
  __device__ __forceinline__ explicit StaticOrder(int grid,int block):vcu((grid%8==0)?(block%8)*(grid/8)+block/8:block),G(grid){}
  __device__ __forceinline__ bool next(int i,AttnUnit&u)const{ const int idx=vcu+i*G; if(idx>=BATCH*NHEAD*NQB)return false; u.bh=idx>>5; u.qb=idx&31; return true; }
  __device__ __forceinline__ void a_ready(const AttnUnit&)const{}
  __device__ __forceinline__ void done(const AttnUnit&)const{}
};
template<class Sched,int THRL=8> __device__ __forceinline__ void attn_phase(char*lds,const AttnTensors&T,const Sched&S){
  AttnUnit u;
  for(int i=0;S.next(i,u);++i){ S.a_ready(u); attn_unit<THRL>(u.bh/NHEAD,u.bh%NHEAD,u.qb,T.Q,T.K,T.V,T.O,T.F+(size_t)u.bh*SEQ,lds); S.done(u); }
}
#undef SBAR
#undef WAIT_BAR
}

#define LAS __attribute__((address_space(3)))
#define GAS __attribute__((address_space(1)))
typedef unsigned short bf16;
typedef float f32x4 __attribute__((ext_vector_type(4)));
typedef unsigned v4u __attribute__((ext_vector_type(4)));
typedef unsigned v2u __attribute__((ext_vector_type(2)));
constexpr int NB_ = 2, SEQ = 8192, M = NB_ * SEQ, D = 1024, DIN = 2820, NPJ = 2816, NL = 4, NE = 32, TOPK = 4, CAP = pg8::MOE_CAP;
constexpr float LN_EPS = 1e-5f, ALPHA = 1.6817928305074290f  , LOG2E = 1.4426950408889634f;
constexpr int NWAVES = 8, NTHR = 512, LDS_BYTES = 147456, RING_BYTES = 131072, LDSCTL_OFF = RING_BYTES;
constexpr int C_RQ = 0, C_RK = 128, C_RV = 256, C_RG = 512, C_CA = 768, C_CB = 1024, C_SB = 1280, C_SC = 1536, C_SH = 1792, C_FQ = 2048, C_FK = 2304, C_FV = 2560, C_FF = 2816;

constexpr size_t MiB = 1u << 20;
constexpr size_t WS_CTL = 0, CTL_ZERO_BYTES = 1 * MiB;
constexpr size_t WS_ROPE = 1 * MiB;
constexpr size_t WS_LOGF = 2 * MiB;
constexpr size_t WS_F = 3 * MiB;
constexpr size_t WS_TK = 4 * MiB;
constexpr size_t WS_GATE = 6 * MiB;
constexpr size_t WS_WIN = 8 * MiB;
constexpr size_t WS_WO = 32 * MiB;
constexpr size_t WS_KV = 40 * MiB;
constexpr size_t WS_PREV = 48 * MiB;
constexpr size_t WS_XB = 64 * MiB;
constexpr size_t WS_X1B = 96 * MiB;
constexpr size_t WS_MIXED = 128 * MiB;
constexpr size_t WS_XF = 160 * MiB;
constexpr size_t WS_X1 = 224 * MiB;
constexpr size_t WS_MIX = 288 * MiB;
constexpr size_t WS_PROJ = 352 * MiB;
constexpr size_t WS_Y4 = 448 * MiB;
constexpr size_t WS_W1 = 576 * MiB;
constexpr size_t WS_W2 = 1088 * MiB;
constexpr size_t WS_ACT = 1344 * MiB;
constexpr size_t WS_END = 2368 * MiB;
constexpr int CW_CURSOR = 1024;

__device__ __forceinline__ float bf2f(unsigned v) { return __uint_as_float(v << 16); }
__device__ __forceinline__ unsigned f2bf(float f) { unsigned u = __float_as_uint(f); return (u + 0x7fffu + ((u >> 16) & 1u)) >> 16; }
__device__ __forceinline__ unsigned pk2(float lo, float hi) { return f2bf(lo) | (f2bf(hi) << 16); }
#define LDS_WAIT() asm volatile("s_waitcnt lgkmcnt(0)" ::: "memory")
__device__ __forceinline__ float wave_sum(float v) {
#pragma unroll
    for (int o = 1; o < 64; o <<= 1) v += __shfl_xor(v, o);
    return v;
}
__device__ __forceinline__ float wave_max(float v) {
#pragma unroll
    for (int o = 1; o < 64; o <<= 1) v = fmaxf(v, __shfl_xor(v, o));
    return v;
}

struct Params {
    const float* in[20]; float* out; unsigned char* ws;
};

__device__ __forceinline__ void transpose_item(const float* W, size_t ldw, bf16* WT, int Kd, int k0, int n0, int drow0, LAS float* scr, int lane) {
#pragma unroll 8
    for (int i = 0; i < 32; ++i) { const int kk = 2 * i + (lane >> 5); scr[kk * 33 + (lane & 31)] = W[(size_t)(k0 + kk) * ldw + n0 + (lane & 31)]; }
    LDS_WAIT(); asm volatile("" ::: "memory");
    const int c = lane & 7;
#pragma unroll
    for (int j = 0; j < 4; ++j) { const int n = (lane >> 3) + 8 * j; const LAS float* s = scr + (8 * c) * 33 + n;
        v4u o; o.x = pk2(s[0 * 33], s[1 * 33]); o.y = pk2(s[2 * 33], s[3 * 33]); o.z = pk2(s[4 * 33], s[5 * 33]); o.w = pk2(s[6 * 33], s[7 * 33]);
        *(GAS v4u*)(WT + (size_t)(drow0 + n) * Kd + k0 + 8 * c) = o; }
    LDS_WAIT(); asm volatile("" ::: "memory");
}
__device__ __forceinline__ float log_sigmoid(float z) { return fminf(z, 0.f) - log1pf(expf(-fabsf(z))); }
__device__ __forceinline__ void row_logf(const f32x4 (&v)[4], const float* w_in_l, const float* fox_b_l, float* logf_row, int lane) {
    float a0 = 0.f, a1 = 0.f, a2 = 0.f, a3 = 0.f;
#pragma unroll
    for (int j = 0; j < 4; ++j)
#pragma unroll
        for (int q = 0; q < 4; ++q) { const int k = 256 * j + 4 * lane + q; const f32x4 w = *(const f32x4*)(w_in_l + (size_t)k * DIN + C_FF); const float xv = v[j][q];
            a0 += xv * w[0]; a1 += xv * w[1]; a2 += xv * w[2]; a3 += xv * w[3]; }
    a0 = wave_sum(a0); a1 = wave_sum(a1); a2 = wave_sum(a2); a3 = wave_sum(a3);
    if (lane == 0) { f32x4 o; o[0] = log_sigmoid(a0 + fox_b_l[0]); o[1] = log_sigmoid(a1 + fox_b_l[1]); o[2] = log_sigmoid(a2 + fox_b_l[2]); o[3] = log_sigmoid(a3 + fox_b_l[3]); *(f32x4*)logf_row = o; }
}
__global__ void __launch_bounds__(NTHR, 2) k_prologue(Params p) {
    extern __shared__ __attribute__((aligned(16))) unsigned char lds[];
    const int tid = threadIdx.x, lane = tid & 63, wave = tid >> 6;
    LAS float* scr = (LAS float*)((LAS unsigned char*)lds + wave * 16384);
    const int gw = blockIdx.x * NWAVES + wave, NGW = gridDim.x * NWAVES;
    unsigned char* ws = p.ws;
    constexpr int I_IN = 16 * 88, I_O = 16 * 32, I_W1 = 32 * 16 * 64, I_W2 = 32 * 16 * 32, I_L = I_IN + I_O + I_W1 + I_W2;
    for (int it = gw; it < NL * I_L; it += NGW) {
        const int l = it / I_L; int r = it % I_L;
        if (r < I_IN) { const int kb = r / 88, nb = r % 88; transpose_item(p.in[1] + (size_t)l * D * DIN, DIN, (bf16*)(ws + WS_WIN) + (size_t)l * NPJ * D, D, 64 * kb, 32 * nb, 32 * nb, scr, lane); continue; } r -= I_IN;
        if (r < I_O) { const int kb = r / 32, nb = r % 32; transpose_item(p.in[9] + (size_t)l * D * D, D, (bf16*)(ws + WS_WO) + (size_t)l * D * D, D, 64 * kb, 32 * nb, 32 * nb, scr, lane); continue; } r -= I_O;
        if (r < I_W1) { const int e = r / 1024, q = r % 1024, kb = q / 64, nb = q % 64, n0 = 32 * nb, s = n0 >> 10, c0 = n0 & 1023, drow0 = 256 * (c0 >> 7) + 128 * s + (c0 & 127);
            transpose_item(p.in[14] + ((size_t)l * NE + e) * D * 2048, 2048, (bf16*)(ws + WS_W1) + ((size_t)l * NE + e) * 2048 * D, D, 64 * kb, n0, drow0, scr, lane); continue; } r -= I_W1;
        { const int e = r / 512, q = r % 512, kb = q / 32, nb = q % 32;
            transpose_item(p.in[16] + ((size_t)l * NE + e) * D * D, D, (bf16*)(ws + WS_W2) + ((size_t)l * NE + e) * D * D, D, 64 * kb, 32 * nb, 32 * nb, scr, lane); }
    }
    for (int idx = blockIdx.x * NTHR + tid; idx < SEQ * 16; idx += gridDim.x * NTHR) { const int pos = idx >> 4, i = idx & 15;
        const float freq = powf(10000.0f, -(float)i / 16.0f); const float ang = (float)pos * freq; const double a = (double)ang;
        float* cs = (float*)(ws + WS_ROPE) + 2 * idx; cs[0] = (float)cos(a); cs[1] = (float)sin(a); }
    for (int m = gw; m < M; m += NGW) {
        const GAS f32x4* xr = (const GAS f32x4*)(p.in[0] + (size_t)m * D) + lane; f32x4 v[4];
#pragma unroll
        for (int j = 0; j < 4; ++j) v[j] = xr[64 * j];
        GAS v2u* o8 = (GAS v2u*)((bf16*)(ws + WS_XB) + (size_t)m * D) + lane;
#pragma unroll
        for (int j = 0; j < 4; ++j) { v2u w; w.x = pk2(v[j][0], v[j][1]); w.y = pk2(v[j][2], v[j][3]); o8[64 * j] = w; }
        row_logf(v, p.in[1], p.in[2], (float*)(ws + WS_LOGF) + (size_t)m * 4, lane);
    }
}

struct EpiProj {
    static constexpr bool PERM = true, AFTER_DRAIN = false;
    bf16* O;
    __device__ __forceinline__ void operator()(const pg8::f32x4 (&acc)[2][2][4][2], const pg8::Unit& u, int wr, int wc, int fr, int fq) const {
        const float sc = (u.pn == 8) ? attn_body::C2 : 1.0f;
        bf16* base = O + (size_t)(u.pm * 256 + wr * 64 + fr) * NPJ + u.pn * 256 + wc * 32 + 8 * fq;
#pragma unroll
        for (int ai = 0; ai < 2; ++ai)
#pragma unroll
            for (int m = 0; m < 4; ++m)
#pragma unroll
                for (int bj = 0; bj < 2; ++bj) { const pg8::f32x4 v0 = acc[ai][bj][m][0] * sc, v1 = acc[ai][bj][m][1] * sc;
                    pg8::u32x4 w; w.x = pg8::cvt_pk_bf16(v0[0], v0[1]); w.y = pg8::cvt_pk_bf16(v0[2], v0[3]); w.z = pg8::cvt_pk_bf16(v1[0], v1[1]); w.w = pg8::cvt_pk_bf16(v1[2], v1[3]);
                    *(pg8::u32x4*)(base + (size_t)(ai * 128 + m * 16) * NPJ + bj * 128) = w; }
    }
};
__global__ void __launch_bounds__(NTHR, 2) k_attn(Params p) {
    extern __shared__ __attribute__((aligned(16))) unsigned char lds[];
    const bf16* proj = (const bf16*)(p.ws + WS_PROJ);
    const attn_body::AttnTensors AT{(const attn_body::bf16*)(proj + C_FQ), (const attn_body::bf16*)(proj + C_FK), (const attn_body::bf16*)(proj + C_FV), (attn_body::bf16*)((bf16*)(p.ws + WS_MIXED) + 768), (const float*)(p.ws + WS_F)};
    const attn_body::StaticOrder S((int)gridDim.x, (int)blockIdx.x);
    attn_body::attn_phase<attn_body::StaticOrder>((char*)lds, AT, S);
}
__global__ void __launch_bounds__(NTHR, 2) k_inproj(Params p, int l) {
    extern __shared__ __attribute__((aligned(16))) unsigned char lds[];
    pg8::Gemm g{(const bf16*)(p.ws + WS_XB), (const bf16*)(p.ws + WS_WIN) + (size_t)l * NPJ * D, M, NPJ, D}; pg8::StaticOrder S; S.init(M, NPJ, gridDim.x, (int)blockIdx.x);
    EpiProj E{(bf16*)(p.ws + WS_PROJ)};
    pg8::gemm_phase<EpiProj, pg8::StaticOrder, true, true>((LAS unsigned char*)lds, g, S, E);
}
__global__ void __launch_bounds__(NTHR, 2) k_outproj(Params p, int l) {
    extern __shared__ __attribute__((aligned(16))) unsigned char lds[];
    pg8::Gemm g{(const bf16*)(p.ws + WS_MIXED), (const bf16*)(p.ws + WS_WO) + (size_t)l * D * D, M, D, D}; pg8::StaticOrder S; S.init(M, D, gridDim.x, (int)blockIdx.x);
    pg8::EpiF32 E{(float*)(p.ws + WS_MIX), D, nullptr};
    pg8::gemm_phase<pg8::EpiF32, pg8::StaticOrder, true, true>((LAS unsigned char*)lds, g, S, E);
}
__device__ __forceinline__ void moe_table(LAS int* tp, LAS int* cnt, const unsigned* cursor) {
    if (threadIdx.x < 32) cnt[threadIdx.x] = (int)__hip_atomic_load(cursor + threadIdx.x, __ATOMIC_RELAXED, __HIP_MEMORY_SCOPE_AGENT);
    __syncthreads();
    if (threadIdx.x == 0) { int s = 0; for (int e = 0; e < 32; ++e) { tp[e] = s; s += (cnt[e] + 255) >> 8; } tp[32] = s; }
    __syncthreads();
}
__global__ void __launch_bounds__(NTHR, 2) k_gemm1(Params p, int l) {
    extern __shared__ __attribute__((aligned(16))) unsigned char lds[];
    LAS int* tp = (LAS int*)((LAS unsigned char*)lds + LDSCTL_OFF + 1024); LAS int* cnt = tp + 64;
    moe_table(tp, cnt, (const unsigned*)(p.ws + WS_CTL) + CW_CURSOR + 32 * l);
    pg8::MoeSched S{tp, cnt, 8, (int)gridDim.x, (int)blockIdx.x};
    pg8::EpiSwiglu E{(bf16*)(p.ws + WS_ACT), p.in[15] + (size_t)l * NE * 2048};
    pg8::gemm_phase_moe<pg8::EpiSwiglu, true>((LAS unsigned char*)lds, (const bf16*)(p.ws + WS_X1B), (const bf16*)(p.ws + WS_W1) + (size_t)l * NE * 2048 * D, D, 2048, (const int*)(p.ws + WS_TK), S, E);
}
__global__ void __launch_bounds__(NTHR, 2) k_gemm2(Params p, int l) {
    extern __shared__ __attribute__((aligned(16))) unsigned char lds[];
    LAS int* tp = (LAS int*)((LAS unsigned char*)lds + LDSCTL_OFF + 1024); LAS int* cnt = tp + 64;
    moe_table(tp, cnt, (const unsigned*)(p.ws + WS_CTL) + CW_CURSOR + 32 * l);
    pg8::MoeSched S{tp, cnt, 4, (int)gridDim.x, (int)blockIdx.x};
    pg8::EpiGateScatter E{(bf16*)(p.ws + WS_Y4), p.in[17] + (size_t)l * NE * D, (const int*)(p.ws + WS_TK), (const float*)(p.ws + WS_GATE)};
    pg8::gemm_phase_moe<pg8::EpiGateScatter, false>((LAS unsigned char*)lds, (const bf16*)(p.ws + WS_ACT), (const bf16*)(p.ws + WS_W2) + (size_t)l * NE * D * D, D, 1024, nullptr, S, E);
}

__global__ void __launch_bounds__(NTHR) k_fscan(Params p) {
    __shared__ float wtot[NWAVES];
    const int bh = blockIdx.x, b = bh >> 2, h = bh & 3, tid = threadIdx.x, lane = tid & 63, wave = tid >> 6;
    const float* lf = (const float*)(p.ws + WS_LOGF) + ((size_t)b * SEQ + 16 * tid) * 4 + h;
    float v[16]; float s = 0.f;
#pragma unroll
    for (int j = 0; j < 16; ++j) { s += lf[4 * j]; v[j] = s; }
    float inc = s;
#pragma unroll
    for (int o = 1; o < 64; o <<= 1) { const float t = __shfl_up(inc, o); if (lane >= o) inc += t; }
    if (lane == 63) wtot[wave] = inc;
    __syncthreads();
    float base = inc - s;
    for (int w = 0; w < wave; ++w) base += wtot[w];
    float* F = (float*)(p.ws + WS_F) + (size_t)bh * SEQ + 16 * tid;
#pragma unroll
    for (int j = 0; j < 16; ++j) F[j] = base + v[j];
}
__global__ void __launch_bounds__(NTHR) k_conv(Params p, int l) {
    __shared__ float red[NWAVES][2];
    const int tid = threadIdx.x, lane = tid & 63, wave = tid >> 6, c = tid & 255, sub = tid >> 8;
    const bf16* proj = (const bf16*)(p.ws + WS_PROJ); bf16* mixed = (bf16*)(p.ws + WS_MIXED);
    const float* dw = p.in[3] + (size_t)l * 31 * 256; const float dwb = p.in[4][l * 256 + c], lg = p.in[5][l * 256 + c], lb = p.in[6][l * 256 + c];
    const float* sw = p.in[7] + (size_t)l * 3 * 256;
    for (int tp = blockIdx.x * 2; tp < M; tp += gridDim.x * 2) {
        const int t = tp + sub, pos = t & (SEQ - 1);
        float acc = dwb;
        for (int j = 0; j < 31; ++j) { const int sp = pos - 30 + j; if (sp >= 0) { const size_t r = (size_t)(t - 30 + j) * NPJ;
            const float a = bf2f(proj[r + C_CA + c]), bg = bf2f(proj[r + C_CB + c]); acc += dw[j * 256 + c] * (a / (1.0f + expf(-bg))); } }
        float s1 = wave_sum(acc); if (lane == 0) red[wave][0] = s1;
        __syncthreads();
        const int w0 = sub * 4; const float mean = (red[w0][0] + red[w0 + 1][0] + red[w0 + 2][0] + red[w0 + 3][0]) * (1.0f / 256.0f);
        const float d = acc - mean; float s2 = wave_sum(d * d); if (lane == 0) red[wave][1] = s2;
        __syncthreads();
        const float var = (red[w0][1] + red[w0 + 1][1] + red[w0 + 2][1] + red[w0 + 3][1]) * (1.0f / 256.0f);
        const float y = d * rsqrtf(var + LN_EPS) * lg + lb;
        mixed[(size_t)t * D + 256 + c] = (bf16)f2bf(y / (1.0f + expf(-y)));
        float sacc = 0.f;
        for (int j = 0; j < 3; ++j) { const int sp = pos - 2 + j; if (sp >= 0) { const size_t r = (size_t)(t - 2 + j) * NPJ; sacc += sw[j * 256 + c] * (bf2f(proj[r + C_SC + c]) * bf2f(proj[r + C_SH + c])); } }
        mixed[(size_t)t * D + 512 + c] = (bf16)f2bf(bf2f(proj[(size_t)t * NPJ + C_SB + c]) * sacc);
    }
}
template <bool FOX>
__global__ void __launch_bounds__(256) k_naive_mix(Params p, int l) {
    constexpr int DK = FOX ? 64 : 32;
    __shared__ float Ks[64][DK]; __shared__ float Vs[64][64]; __shared__ float Fs[64];
    const int unit = blockIdx.x, bh = unit >> 5, qb = unit & 31, b = bh >> 2, h = bh & 3, tid = threadIdx.x;
    const int i = qb * 256 + tid; const size_t row = (size_t)b * SEQ + i;
    const bf16* proj = (const bf16*)(p.ws + WS_PROJ); bf16* mixed = (bf16*)(p.ws + WS_MIXED);
    const float* cs = (const float*)(p.ws + WS_ROPE); const float* F = (const float*)(p.ws + WS_F) + (size_t)bh * SEQ;
    const int qcol = FOX ? C_FQ + h * 64 : C_RQ + h * 32, kcol = FOX ? C_FK + h * 64 : C_RK + h * 32, vcol = FOX ? C_FV + h * 64 : C_RV + h * 64;
    float q[DK];
#pragma unroll
    for (int d = 0; d < DK; ++d) q[d] = bf2f(proj[row * NPJ + qcol + d]);
    if (!FOX) {
#pragma unroll
        for (int d = 0; d < 16; ++d) { const float c = cs[(i * 16 + d) * 2], s = cs[(i * 16 + d) * 2 + 1], x1 = q[d], x2 = q[d + 16]; q[d] = x1 * c - x2 * s; q[d + 16] = x1 * s + x2 * c; }
    } else {
    }
    const float Fi = FOX ? F[i] : 0.f;
    const float lg2 = FOX ? 0.f : log2f(1.0f - exp2f(-5.0f - (float)h));
    const float kscale = 0.17677669529663687f;
    float o[64];
#pragma unroll
    for (int e = 0; e < 64; ++e) o[e] = 0.f;
    float mx = -INFINITY, lsum = 0.f;
    const int ntile = 4 * qb + 4;
    for (int t = 0; t < ntile; ++t) {
        __syncthreads();
        for (int e = tid; e < 64 * DK; e += 256) { const int j = e / DK, d = e % DK; Ks[j][d] = bf2f(proj[((size_t)b * SEQ + 64 * t + j) * NPJ + kcol + d]); }
        for (int e = tid; e < 4096; e += 256) { const int j = e >> 6, d = e & 63; Vs[j][d] = bf2f(proj[((size_t)b * SEQ + 64 * t + j) * NPJ + vcol + d]); }
        if (FOX && tid < 64) Fs[tid] = F[64 * t + tid];
        __syncthreads();
        if (!FOX) {
            for (int e = tid; e < 64 * 16; e += 256) { const int j = e >> 4, d = e & 15, pos = 64 * t + j; const float c = cs[(pos * 16 + d) * 2], s = cs[(pos * 16 + d) * 2 + 1], x1 = Ks[j][d], x2 = Ks[j][d + 16];
                Ks[j][d] = (x1 * c - x2 * s) * kscale; Ks[j][d + 16] = (x1 * s + x2 * c) * kscale; }
            __syncthreads();
        }
        if (!FOX && t > (i >> 6)) continue;
        for (int j0 = 0; j0 < 64; j0 += 8) {
            float sc[8];
#pragma unroll
            for (int jj = 0; jj < 8; ++jj) { const int j = j0 + jj; float dot = 0.f;
#pragma unroll
                for (int d = 0; d < DK; d += 4) { const f32x4 kk = *(const f32x4*)&Ks[j][d]; dot += q[d] * kk[0] + q[d + 1] * kk[1] + q[d + 2] * kk[2] + q[d + 3] * kk[3]; }
                const int pos = 64 * t + j;
                if (FOX) sc[jj] = (pos <= i) ? (dot + (Fi - Fs[j]) * LOG2E) : -INFINITY;
                else { const int dist = pos > i ? pos - i : i - pos; sc[jj] = dot * exp2f(lg2 * (float)dist); } }
            if (FOX) {
                float gm = sc[0];
#pragma unroll
                for (int jj = 1; jj < 8; ++jj) gm = fmaxf(gm, sc[jj]);
                if (gm > mx) { const float r = exp2f(mx - gm); lsum *= r;
#pragma unroll
                    for (int e = 0; e < 64; ++e) o[e] *= r;
                    mx = gm; }
#pragma unroll
                for (int jj = 0; jj < 8; ++jj) { sc[jj] = exp2f(sc[jj] - mx); lsum += sc[jj]; }
            }
#pragma unroll
            for (int jj = 0; jj < 8; ++jj) { const int j = j0 + jj; const float pj = sc[jj];
#pragma unroll
                for (int e = 0; e < 64; e += 4) { const f32x4 vv = *(const f32x4*)&Vs[j][e]; o[e] += pj * vv[0]; o[e + 1] += pj * vv[1]; o[e + 2] += pj * vv[2]; o[e + 3] += pj * vv[3]; } }
        }
    }
    if (FOX) {
        const float inv = 1.0f / lsum;
#pragma unroll
        for (int e = 0; e < 64; e += 2) *(unsigned*)(mixed + row * D + 768 + h * 64 + e) = pk2(o[e] * inv, o[e + 1] * inv);
    } else {
        float mean = 0.f;
#pragma unroll
        for (int e = 0; e < 64; ++e) mean += o[e];
        mean *= (1.0f / 64.0f); float var = 0.f;
#pragma unroll
        for (int e = 0; e < 64; ++e) { const float d = o[e] - mean; var += d * d; }
        const float rstd = rsqrtf(var * (1.0f / 64.0f) + LN_EPS);
        const float* gg = p.in[8] + l * 256 + h * 64;
#pragma unroll
        for (int e = 0; e < 64; e += 2) { float y0 = (o[e] - mean) * rstd * gg[e], y1 = (o[e + 1] - mean) * rstd * gg[e + 1];
            const float g0 = bf2f(proj[row * NPJ + C_RG + h * 64 + e]), g1 = bf2f(proj[row * NPJ + C_RG + h * 64 + e + 1]);
            y0 *= g0 / (1.0f + expf(-g0)); y1 *= g1 / (1.0f + expf(-g1));
            *(unsigned*)(mixed + row * D + h * 64 + e) = pk2(y0, y1); }
    }
}


namespace ret {
typedef short bf16x8 __attribute__((ext_vector_type(8)));
typedef short bf16x4 __attribute__((ext_vector_type(4)));
typedef float f32x16 __attribute__((ext_vector_type(16)));
constexpr int QP = 40, VP = 68, KTP = 72;
constexpr int PAIR_BYTES = 24576;
constexpr int OFF_Q = 0, OFF_K = 5120, OFF_V = 10240, OFF_P = 18944, OFF_KT = 0;
constexpr int WS_KV_FLOATS = NB_ * 128 * 4 * 2048;
__device__ __forceinline__ int crow(int r, int hi) { return (r & 3) + 8 * (r >> 2) + 4 * hi; }
__device__ __forceinline__ float lg2_gamma(int h) { return log2f(1.0f - exp2f(-5.0f - (float)h)); }
__device__ __forceinline__ void rope8(const bf16* src, const float* cs, int dd0, float sc, float (&o1)[8], float (&o2)[8]) {
    const v4u lo = *(const v4u*)(src + dd0), hi = *(const v4u*)(src + 16 + dd0);
    const f32x4 c0 = *(const f32x4*)(cs), c1 = *(const f32x4*)(cs + 4), c2 = *(const f32x4*)(cs + 8), c3 = *(const f32x4*)(cs + 12);
    const float cv[16] = {c0[0], c0[1], c0[2], c0[3], c1[0], c1[1], c1[2], c1[3], c2[0], c2[1], c2[2], c2[3], c3[0], c3[1], c3[2], c3[3]};
    const unsigned lw[4] = {lo.x, lo.y, lo.z, lo.w}, hw[4] = {hi.x, hi.y, hi.z, hi.w};
#pragma unroll
    for (int i = 0; i < 8; ++i) { const float x1 = (i & 1) ? bf2f(lw[i >> 1] >> 16) : bf2f(lw[i >> 1] & 0xffffu), x2 = (i & 1) ? bf2f(hw[i >> 1] >> 16) : bf2f(hw[i >> 1] & 0xffffu);
        const float c = cv[2 * i], s = cv[2 * i + 1]; o1[i] = (x1 * c - x2 * s) * sc; o2[i] = (x1 * s + x2 * c) * sc; }
}
__device__ __forceinline__ void stage_vt(const bf16* proj, size_t row0, int h, LAS bf16* Vt, int tp) {
    const int m = tp >> 1, e0 = (tp & 1) * 32; const bf16* src = proj + (row0 + m) * NPJ + C_RV + h * 64 + e0;
#pragma unroll
    for (int q = 0; q < 4; ++q) { const v4u w = *(const v4u*)(src + 8 * q); const unsigned ww[4] = {w.x, w.y, w.z, w.w};
#pragma unroll
        for (int i = 0; i < 8; ++i) Vt[(e0 + 8 * q + i) * VP + m] = (bf16)((i & 1) ? (ww[i >> 1] >> 16) : (ww[i >> 1] & 0xffffu)); }
}
__device__ __forceinline__ bf16x8 ld_vt8(const LAS bf16* p) {
    const bf16x4 a = *(const LAS bf16x4*)p, b = *(const LAS bf16x4*)(p + 4); return (bf16x8){a[0], a[1], a[2], a[3], b[0], b[1], b[2], b[3]};
}
__device__ __forceinline__ void phase_kv(const Params& p, LAS unsigned char* lds, int nblk, int blk) {
    const int tid = threadIdx.x, lane = tid & 63, wave = tid >> 6, pw = wave >> 1, sw = wave & 1, tp = tid & 127, r32 = lane & 31, hi = lane >> 5;
    const bf16* proj = (const bf16*)(p.ws + WS_PROJ); const float* rope = (const float*)(p.ws + WS_ROPE); float* kvT = (float*)(p.ws + WS_KV);
    LAS unsigned char* base = lds + pw * PAIR_BYTES; LAS bf16* KdT = (LAS bf16*)(base + OFF_KT); LAS bf16* Vt = (LAS bf16*)(base + OFF_V);
    for (int u0 = blk * 4; u0 < NB_ * 128 * 4; u0 += nblk * 4) {
        const int unit = u0 + pw, h = unit & 3, bc = unit >> 2, c = bc & 127, b = bc >> 7; const size_t row0 = (size_t)b * SEQ + 64 * c;
        const float lg = lg2_gamma(h);
        { const int m = tp >> 1, dd0 = (tp & 1) * 8; float o1[8], o2[8];
          rope8(proj + (row0 + m) * NPJ + C_RK + h * 32, rope + ((size_t)(64 * c + m) * 16 + dd0) * 2, dd0, 0.17677669529663687f * exp2f(lg * (float)(63 - m)), o1, o2);
#pragma unroll
          for (int i = 0; i < 8; ++i) { KdT[(dd0 + i) * KTP + m] = (bf16)f2bf(o1[i]); KdT[(16 + dd0 + i) * KTP + m] = (bf16)f2bf(o2[i]); } }
        stage_vt(proj, row0, h, Vt, tp);
        __syncthreads();
        f32x16 acc = {};
#pragma unroll
        for (int ks = 0; ks < 4; ++ks) { const bf16x8 a = ld_vt8(Vt + (32 * sw + r32) * VP + 16 * ks + 8 * hi); const bf16x8 bq = *(const LAS bf16x8*)(KdT + r32 * KTP + 16 * ks + 8 * hi);
            acc = __builtin_amdgcn_mfma_f32_32x32x16_bf16(a, bq, acc, 0, 0, 0); }
        float* dst = kvT + (size_t)unit * 2048 + r32;
#pragma unroll
        for (int r = 0; r < 16; ++r) dst[(32 * sw + crow(r, hi)) * 32] = acc[r];
        __syncthreads();
    }
}
__device__ __forceinline__ void phase_scan(const Params& p, LAS unsigned char* lds, int nblk, int blk) {
    const int tid = threadIdx.x, elem = tid & 63, seg = tid >> 6;
    const float* kvT = (const float*)(p.ws + WS_KV); bf16* prevT = (bf16*)(p.ws + WS_PREV); LAS float* agg = (LAS float*)lds;
    for (int blkid = blk; blkid < 256; blkid += nblk) {
        const int bh = blkid >> 5, b = bh >> 2, h = bh & 3, el = (blkid & 31) * 64 + elem;
        const float Dk = exp2f(64.0f * lg2_gamma(h));
        float kv[16];
#pragma unroll
        for (int j = 0; j < 16; ++j) kv[j] = kvT[((size_t)((b * 128 + 16 * seg + j) * 4 + h)) * 2048 + el];
        float loc[17]; loc[0] = 0.f;
#pragma unroll
        for (int j = 0; j < 16; ++j) loc[j + 1] = Dk * loc[j] + kv[j];
        agg[seg * 64 + elem] = loc[16];
        __syncthreads();
        const float D16 = exp2f(1024.0f * lg2_gamma(h)); float sin_ = 0.f;
        for (int s2 = 0; s2 < seg; ++s2) sin_ = D16 * sin_ + agg[s2 * 64 + elem];
        float dj = 1.0f;
#pragma unroll
        for (int j = 0; j < 16; ++j) { prevT[((size_t)((b * 128 + 16 * seg + j) * 4 + h)) * 2048 + el] = (bf16)f2bf(dj * sin_ + loc[j]); dj *= Dk; }
        __syncthreads();
    }
}
__device__ __forceinline__ void phase_out(const Params& p, int l, LAS unsigned char* lds, int nblk, int blk) {
    const int tid = threadIdx.x, lane = tid & 63, wave = tid >> 6, pw = wave >> 1, sw = wave & 1, tp = tid & 127, r32 = lane & 31, hi = lane >> 5;
    const bf16* proj = (const bf16*)(p.ws + WS_PROJ); const float* rope = (const float*)(p.ws + WS_ROPE); const bf16* prevT = (const bf16*)(p.ws + WS_PREV); bf16* mixed = (bf16*)(p.ws + WS_MIXED);
    const float* gng = p.in[8] + l * 256;
    LAS unsigned char* base = lds + pw * PAIR_BYTES; LAS bf16* Qs = (LAS bf16*)(base + OFF_Q); LAS bf16* Ks = (LAS bf16*)(base + OFF_K); LAS bf16* Vt = (LAS bf16*)(base + OFF_V); LAS bf16* Ps = (LAS bf16*)(base + OFF_P);
    for (int u0 = blk * 4; u0 < NB_ * 128 * 4; u0 += nblk * 4) {
        const int unit = u0 + pw, h = unit & 3, bc = unit >> 2, c = bc & 127, b = bc >> 7; const size_t row0 = (size_t)b * SEQ + 64 * c;
        const float lg = lg2_gamma(h);
        { const int m = tp >> 1, dd0 = (tp & 1) * 8; float o1[8], o2[8]; const float* cs = rope + ((size_t)(64 * c + m) * 16 + dd0) * 2;
          rope8(proj + (row0 + m) * NPJ + C_RQ + h * 32, cs, dd0, 1.0f, o1, o2);
          v4u w; w.x = pk2(o1[0], o1[1]); w.y = pk2(o1[2], o1[3]); w.z = pk2(o1[4], o1[5]); w.w = pk2(o1[6], o1[7]); *(LAS v4u*)(Qs + m * QP + dd0) = w;
          w.x = pk2(o2[0], o2[1]); w.y = pk2(o2[2], o2[3]); w.z = pk2(o2[4], o2[5]); w.w = pk2(o2[6], o2[7]); *(LAS v4u*)(Qs + m * QP + 16 + dd0) = w;
          rope8(proj + (row0 + m) * NPJ + C_RK + h * 32, cs, dd0, 0.17677669529663687f, o1, o2);
          w.x = pk2(o1[0], o1[1]); w.y = pk2(o1[2], o1[3]); w.z = pk2(o1[4], o1[5]); w.w = pk2(o1[6], o1[7]); *(LAS v4u*)(Ks + m * QP + dd0) = w;
          w.x = pk2(o2[0], o2[1]); w.y = pk2(o2[2], o2[3]); w.z = pk2(o2[4], o2[5]); w.w = pk2(o2[6], o2[7]); *(LAS v4u*)(Ks + m * QP + 16 + dd0) = w;
          const bf16* ps = prevT + (size_t)unit * 2048 + (tp >> 1) * 32 + (tp & 1) * 16; const v4u p0 = *(const v4u*)ps, p1 = *(const v4u*)(ps + 8);
          *(LAS v4u*)(Ps + (tp >> 1) * QP + (tp & 1) * 16) = p0; *(LAS v4u*)(Ps + (tp >> 1) * QP + (tp & 1) * 16 + 8) = p1; }
        stage_vt(proj, row0, h, Vt, tp);
        __syncthreads();
        const int n = 32 * sw + r32;
        bf16x8 qf[2];
#pragma unroll
        for (int s = 0; s < 2; ++s) qf[s] = *(const LAS bf16x8*)(Qs + n * QP + 16 * s + 8 * hi);
        f32x16 acc[2];
#pragma unroll
        for (int eb = 0; eb < 2; ++eb) { acc[eb] = (f32x16){};
#pragma unroll
            for (int s = 0; s < 2; ++s) { const bf16x8 a = *(const LAS bf16x8*)(Ps + (32 * eb + r32) * QP + 16 * s + 8 * hi); acc[eb] = __builtin_amdgcn_mfma_f32_32x32x16_bf16(a, qf[s], acc[eb], 0, 0, 0); } }
        const float qd = exp2f(lg * (float)(n + 1));
#pragma unroll
        for (int eb = 0; eb < 2; ++eb)
#pragma unroll
            for (int r = 0; r < 16; ++r) acc[eb][r] *= qd;
#pragma unroll
        for (int mb = 0; mb < 2; ++mb) {
            f32x16 st = {};
#pragma unroll
            for (int s = 0; s < 2; ++s) { const bf16x8 a = *(const LAS bf16x8*)(Ks + (32 * mb + r32) * QP + 16 * s + 8 * hi); st = __builtin_amdgcn_mfma_f32_32x32x16_bf16(a, qf[s], st, 0, 0, 0); }
#pragma unroll
            for (int r = 0; r < 16; ++r) { const int m = 32 * mb + crow(r, hi); const int dist = n > m ? n - m : m - n; st[r] *= exp2f(lg * (float)dist); }
#pragma unroll
            for (int pp = 0; pp < 2; ++pp) {
                v4u pk; pk.x = pk2(st[8 * pp + 0], st[8 * pp + 1]); pk.y = pk2(st[8 * pp + 2], st[8 * pp + 3]); pk.z = pk2(st[8 * pp + 4], st[8 * pp + 5]); pk.w = pk2(st[8 * pp + 6], st[8 * pp + 7]);
                const bf16x8 pf = __builtin_bit_cast(bf16x8, pk);
#pragma unroll
                for (int eb = 0; eb < 2; ++eb) { const LAS bf16* vp = Vt + (32 * eb + r32) * VP + 32 * mb + 16 * pp + 4 * hi;
                    const bf16x4 a0 = *(const LAS bf16x4*)vp, a1 = *(const LAS bf16x4*)(vp + 8); const bf16x8 af = (bf16x8){a0[0], a0[1], a0[2], a0[3], a1[0], a1[1], a1[2], a1[3]};
                    acc[eb] = __builtin_amdgcn_mfma_f32_32x32x16_bf16(af, pf, acc[eb], 0, 0, 0); } }
        }
        float s1 = 0.f;
#pragma unroll
        for (int eb = 0; eb < 2; ++eb)
#pragma unroll
            for (int r = 0; r < 16; ++r) s1 += acc[eb][r];
        s1 += __shfl_xor(s1, 32); const float mean = s1 * (1.0f / 64.0f); float s2 = 0.f;
#pragma unroll
        for (int eb = 0; eb < 2; ++eb)
#pragma unroll
            for (int r = 0; r < 16; ++r) { const float d = acc[eb][r] - mean; s2 += d * d; }
        s2 += __shfl_xor(s2, 32); const float rstd = rsqrtf(s2 * (1.0f / 64.0f) + LN_EPS);
        const size_t trow = row0 + n;
#pragma unroll
        for (int eb = 0; eb < 2; ++eb)
#pragma unroll
            for (int g = 0; g < 4; ++g) { const int e0 = 32 * eb + 8 * g + 4 * hi; const f32x4 gn = *(const f32x4*)(gng + h * 64 + e0);
                const v2u gw = *(const v2u*)(proj + trow * NPJ + C_RG + h * 64 + e0); const float gt[4] = {bf2f(gw.x & 0xffffu), bf2f(gw.x >> 16), bf2f(gw.y & 0xffffu), bf2f(gw.y >> 16)}; float y[4];
#pragma unroll
                for (int q = 0; q < 4; ++q) { const float sg = gt[q] / (1.0f + __expf(-gt[q])); y[q] = (acc[eb][4 * g + q] - mean) * rstd * gn[q] * sg; }
                v2u o; o.x = pk2(y[0], y[1]); o.y = pk2(y[2], y[3]); *(v2u*)(mixed + trow * D + h * 64 + e0) = o; }
        __syncthreads();
    }
}
}
__global__ void __launch_bounds__(NTHR, 2) k_ret_kv(Params p) { extern __shared__ __attribute__((aligned(16))) unsigned char lds[]; ret::phase_kv(p, (LAS unsigned char*)lds, gridDim.x, blockIdx.x); }
__global__ void __launch_bounds__(NTHR, 2) k_ret_scan(Params p) { extern __shared__ __attribute__((aligned(16))) unsigned char lds[]; ret::phase_scan(p, (LAS unsigned char*)lds, gridDim.x, blockIdx.x); }
__global__ void __launch_bounds__(NTHR, 2) k_ret_out(Params p, int l) { extern __shared__ __attribute__((aligned(16))) unsigned char lds[]; ret::phase_out(p, l, (LAS unsigned char*)lds, gridDim.x, blockIdx.x); }

__global__ void __launch_bounds__(NTHR, 2) k_ln1_router(Params p, int l) {
    extern __shared__ __attribute__((aligned(16))) unsigned char lds[];
    const int tid = threadIdx.x, lane = tid & 63, wave = tid >> 6;
    LAS float* yrow = (LAS float*)((LAS unsigned char*)lds + wave * 8192);
    LAS int* sel_e = (LAS int*)((LAS unsigned char*)lds + 65536); LAS float* sel_g = (LAS float*)((LAS unsigned char*)lds + 65536 + 1024);
    LAS int* wcnt = (LAS int*)((LAS unsigned char*)lds + 65536 + 2048);
    LAS int* ebase = (LAS int*)((LAS unsigned char*)lds + 65536 + 2048 + 512);
    const float* xin = (l == 0) ? p.in[0] : (const float*)(p.ws + WS_XF);
    const float* mix = (const float*)(p.ws + WS_MIX);
    float* x1 = (float*)(p.ws + WS_X1); bf16* x1b = (bf16*)(p.ws + WS_X1B);
    const float* g1 = p.in[10] + l * D; const float* b1 = p.in[11] + l * D;
    const float* Wr = p.in[12] + (size_t)l * D * NE; const float* rb = p.in[13] + l * NE;
    unsigned* cursor = (unsigned*)(p.ws + WS_CTL) + CW_CURSOR + 32 * l;
    for (int t0 = blockIdx.x * 64; t0 < M; t0 += gridDim.x * 64) {
        for (int pair = 0; pair < 4; ++pair) {
#pragma unroll
            for (int r2 = 0; r2 < 2; ++r2) { const int t = t0 + wave * 8 + pair * 2 + r2;
                const GAS f32x4* xr = (const GAS f32x4*)(xin + (size_t)t * D) + lane; const GAS f32x4* mr = (const GAS f32x4*)(mix + (size_t)t * D) + lane;
                f32x4 v[4]; float s = 0.f;
#pragma unroll
                for (int j = 0; j < 4; ++j) { v[j] = xr[64 * j] * ALPHA + mr[64 * j]; s += (v[j][0] + v[j][1]) + (v[j][2] + v[j][3]); }
                const float mean = wave_sum(s) * (1.0f / D); float s2 = 0.f;
#pragma unroll
                for (int j = 0; j < 4; ++j) { v[j] = v[j] - mean; s2 += (v[j][0] * v[j][0] + v[j][1] * v[j][1]) + (v[j][2] * v[j][2] + v[j][3] * v[j][3]); }
                const float rstd = rsqrtf(wave_sum(s2) * (1.0f / D) + LN_EPS);
#pragma unroll
                for (int j = 0; j < 4; ++j) { const f32x4 gg = *(const f32x4*)(g1 + 256 * j + 4 * lane), bb = *(const f32x4*)(b1 + 256 * j + 4 * lane); const f32x4 y = v[j] * rstd * gg + bb;
                    ((GAS f32x4*)(x1 + (size_t)t * D))[64 * j + lane] = y; v2u w; w.x = pk2(y[0], y[1]); w.y = pk2(y[2], y[3]); ((GAS v2u*)(x1b + (size_t)t * D))[64 * j + lane] = w;
                    *(LAS f32x4*)(yrow + r2 * 1024 + 256 * j + 4 * lane) = y; } }
            LDS_WAIT(); asm volatile("" ::: "memory");
            const int e = lane & 31, kh = lane >> 5; float a0 = 0.f, a1 = 0.f;
            for (int k = kh * 512; k < kh * 512 + 512; ++k) { const float w = Wr[(size_t)k * NE + e]; a0 += yrow[k] * w; a1 += yrow[1024 + k] * w; }
            a0 += __shfl_xor(a0, 32); a1 += __shfl_xor(a1, 32);
            a0 += rb[e]; a1 += rb[e];
#pragma unroll
            for (int r2 = 0; r2 < 2; ++r2) { float val = (lane < 32) ? (r2 ? a1 : a0) : -INFINITY; float tv[4]; int ti[4];
#pragma unroll
                for (int r = 0; r < 4; ++r) { const float mxv = wave_max(val); const unsigned long long bal = __ballot(val == mxv); const int who = __ffsll((long long)bal) - 1; tv[r] = mxv; ti[r] = who; if (lane == who) val = -INFINITY; }
                const float e1 = expf(tv[1] - tv[0]), e2 = expf(tv[2] - tv[0]), e3 = expf(tv[3] - tv[0]); const float inv = 1.0f / (1.0f + e1 + e2 + e3);
                const int tl = wave * 8 + pair * 2 + r2;
                if (lane == 0) { sel_e[tl * 4 + 0] = ti[0]; sel_e[tl * 4 + 1] = ti[1]; sel_e[tl * 4 + 2] = ti[2]; sel_e[tl * 4 + 3] = ti[3];
                    sel_g[tl * 4 + 0] = inv; sel_g[tl * 4 + 1] = e1 * inv; sel_g[tl * 4 + 2] = e2 * inv; sel_g[tl * 4 + 3] = e3 * inv; } }
            LDS_WAIT(); asm volatile("" ::: "memory");
        }
        __syncthreads();
        int mye = 0, myrank = 0;
        if (wave < 4) { mye = sel_e[tid];
            for (int e2 = 0; e2 < 32; ++e2) { const unsigned long long bal = __ballot(mye == e2); if (mye == e2) myrank = __popcll(bal & ((1ull << lane) - 1ull)); if (lane == 0) wcnt[wave * 32 + e2] = __popcll(bal); } }
        __syncthreads();
        if (tid < 32) { const int tot = wcnt[tid] + wcnt[32 + tid] + wcnt[64 + tid] + wcnt[96 + tid]; ebase[tid] = tot ? (int)atomicAdd(cursor + tid, (unsigned)tot) : 0; }
        __syncthreads();
        if (wave < 4) { int pos = ebase[mye] + myrank; for (int w = 0; w < wave; ++w) pos += wcnt[w * 32 + mye];
            ((int*)(p.ws + WS_TK))[(size_t)mye * CAP + pos] = t0 * 4 + tid; ((float*)(p.ws + WS_GATE))[(size_t)mye * CAP + pos] = sel_g[tid]; }
        __syncthreads();
    }
}
__global__ void __launch_bounds__(NTHR, 2) k_ln2(Params p, int l) {
    const int tid = threadIdx.x, lane = tid & 63, wave = tid >> 6;
    const int gw = blockIdx.x * NWAVES + wave, NGW = gridDim.x * NWAVES;
    const float* x1 = (const float*)(p.ws + WS_X1); const bf16* y4 = (const bf16*)(p.ws + WS_Y4);
    float* xo = (l == NL - 1) ? p.out : (float*)(p.ws + WS_XF); bf16* xb = (bf16*)(p.ws + WS_XB);
    const float* g2 = p.in[18] + l * D; const float* b2 = p.in[19] + l * D;
    for (int t = gw; t < M; t += NGW) {
        f32x4 v[4]; float s = 0.f;
#pragma unroll
        for (int j = 0; j < 4; ++j) { v[j] = ((const GAS f32x4*)(x1 + (size_t)t * D))[64 * j + lane] * ALPHA;
#pragma unroll
            for (int k = 0; k < 4; ++k) { const v2u w = ((const GAS v2u*)(y4 + ((size_t)t * 4 + k) * D))[64 * j + lane];
                v[j][0] += bf2f(w.x & 0xffffu); v[j][1] += bf2f(w.x >> 16); v[j][2] += bf2f(w.y & 0xffffu); v[j][3] += bf2f(w.y >> 16); }
            s += (v[j][0] + v[j][1]) + (v[j][2] + v[j][3]); }
        const float mean = wave_sum(s) * (1.0f / D); float s2 = 0.f;
#pragma unroll
        for (int j = 0; j < 4; ++j) { v[j] = v[j] - mean; s2 += (v[j][0] * v[j][0] + v[j][1] * v[j][1]) + (v[j][2] * v[j][2] + v[j][3] * v[j][3]); }
        const float rstd = rsqrtf(wave_sum(s2) * (1.0f / D) + LN_EPS);
#pragma unroll
        for (int j = 0; j < 4; ++j) { const f32x4 gg = *(const f32x4*)(g2 + 256 * j + 4 * lane), bb = *(const f32x4*)(b2 + 256 * j + 4 * lane); v[j] = v[j] * rstd * gg + bb;
            ((GAS f32x4*)(xo + (size_t)t * D))[64 * j + lane] = v[j]; }
        if (l < NL - 1) {
#pragma unroll
            for (int j = 0; j < 4; ++j) { v2u w; w.x = pk2(v[j][0], v[j][1]); w.y = pk2(v[j][2], v[j][3]); ((GAS v2u*)(xb + (size_t)t * D))[64 * j + lane] = w; }
            row_logf(v, p.in[1] + (size_t)(l + 1) * D * DIN, p.in[2] + (l + 1) * 4, (float*)(p.ws + WS_LOGF) + (size_t)t * 4, lane);
        }
    }
}

extern "C" void kernel_launch(void* const* d_in, const int* in_sizes, int n_in, void* d_out, int out_size, void* d_ws, size_t ws_size, hipStream_t stream) {
    static int grid = 0;
    if (grid == 0) {
        if (n_in != 20 || in_sizes[0] != M * D || out_size != M * D || ws_size < WS_END) { fprintf(stderr, "kernel_launch: unexpected shapes / workspace (n_in %d, in0 %d, out %d, ws %zu, need %zu)\n", n_in, n_in > 0 ? in_sizes[0] : -1, out_size, ws_size, (size_t)WS_END); grid = -1; return; }
        int dev = 0, cus = 0;
        if (hipGetDevice(&dev) != hipSuccess || hipDeviceGetAttribute(&cus, hipDeviceAttributeMultiprocessorCount, dev) != hipSuccess) { grid = -1; return; }
        (void)hipFuncSetAttribute((const void*)k_prologue, hipFuncAttributeMaxDynamicSharedMemorySize, LDS_BYTES);
        (void)hipFuncSetAttribute((const void*)k_inproj, hipFuncAttributeMaxDynamicSharedMemorySize, LDS_BYTES);
        (void)hipFuncSetAttribute((const void*)k_outproj, hipFuncAttributeMaxDynamicSharedMemorySize, LDS_BYTES);
        (void)hipFuncSetAttribute((const void*)k_gemm1, hipFuncAttributeMaxDynamicSharedMemorySize, LDS_BYTES);
        (void)hipFuncSetAttribute((const void*)k_gemm2, hipFuncAttributeMaxDynamicSharedMemorySize, LDS_BYTES);
        (void)hipFuncSetAttribute((const void*)k_ln1_router, hipFuncAttributeMaxDynamicSharedMemorySize, LDS_BYTES);
        (void)hipFuncSetAttribute((const void*)k_attn, hipFuncAttributeMaxDynamicSharedMemorySize, LDS_BYTES);
        (void)hipFuncSetAttribute((const void*)k_ret_kv, hipFuncAttributeMaxDynamicSharedMemorySize, LDS_BYTES);
        (void)hipFuncSetAttribute((const void*)k_ret_scan, hipFuncAttributeMaxDynamicSharedMemorySize, LDS_BYTES);
        (void)hipFuncSetAttribute((const void*)k_ret_out, hipFuncAttributeMaxDynamicSharedMemorySize, LDS_BYTES);
        grid = cus > 0 ? cus : 256;
    }
    if (grid < 0) return;
    (void)hipMemsetAsync((char*)d_ws + WS_CTL, 0, CTL_ZERO_BYTES, stream);
    Params p{};
    for (int i = 0; i < 20; ++i) p.in[i] = (const float*)d_in[i];
    p.out = (float*)d_out; p.ws = (unsigned char*)d_ws;
    hipLaunchKernelGGL(k_prologue, dim3(grid), dim3(NTHR), LDS_BYTES, stream, p);
    for (int l = 0; l < NL; ++l) {
        hipLaunchKernelGGL(k_inproj, dim3(grid), dim3(NTHR), LDS_BYTES, stream, p, l);
        hipLaunchKernelGGL(k_fscan, dim3(8), dim3(NTHR), 0, stream, p);
        hipLaunchKernelGGL(k_conv, dim3(grid), dim3(NTHR), 0, stream, p, l);
#if defined(V_NAIVE_RET)
        hipLaunchKernelGGL(k_naive_mix<false>, dim3(256), dim3(256), 0, stream, p, l);
#else
        hipLaunchKernelGGL(k_ret_kv, dim3(grid), dim3(NTHR), LDS_BYTES, stream, p);
        hipLaunchKernelGGL(k_ret_scan, dim3(grid), dim3(NTHR), LDS_BYTES, stream, p);
        hipLaunchKernelGGL(k_ret_out, dim3(grid), dim3(NTHR), LDS_BYTES, stream, p, l);
#endif
#if defined(V_NAIVE_FOX)
        hipLaunchKernelGGL(k_naive_mix<true>, dim3(256), dim3(256), 0, stream, p, l);
#else
        hipLaunchKernelGGL(k_attn, dim3(grid), dim3(NTHR), LDS_BYTES, stream, p);
#endif
        hipLaunchKernelGGL(k_outproj, dim3(grid), dim3(NTHR), LDS_BYTES, stream, p, l);
        hipLaunchKernelGGL(k_ln1_router, dim3(grid), dim3(NTHR), LDS_BYTES, stream, p, l);
        hipLaunchKernelGGL(k_gemm1, dim3(grid), dim3(NTHR), LDS_BYTES, stream, p, l);
        hipLaunchKernelGGL(k_gemm2, dim3(grid), dim3(NTHR), LDS_BYTES, stream, p, l);
        hipLaunchKernelGGL(k_ln2, dim3(grid), dim3(NTHR), 0, stream, p, l);
    }
}
```

```cpp
#include <hip/hip_runtime.h>
#include <cstdio>
#include <cstdint>
#include <cmath>
__device__ __forceinline__ int tid_fresh() { int t = (int)threadIdx.x; asm volatile("" : "+v"(t)); return t; }
namespace pg8 {
#define PG8_LAS __attribute__((address_space(3)))
typedef unsigned short bf16_t;
typedef short bf16x8 __attribute__((ext_vector_type(8)));
typedef float f32x4 __attribute__((ext_vector_type(4)));
typedef unsigned u32x4 __attribute__((ext_vector_type(4)));
constexpr int BM = 256, BK = 64, HALF = 128, HTB = HALF * BK * 2  , STAGE_BYTES = 8 * HTB, NXCD = 8, WGM = 8;

__host__ __device__ __forceinline__ int lds_byte(int r, int c) { const int st = (r >> 4) * 2 + (c >> 5), rr = r & 15, cc = c & 31, ob = rr * 64 + cc * 2; return st * 1024 + (ob ^ (((ob >> 9) & 1) << 5)); }
__host__ __device__ __forceinline__ void stage_rc(int b, int& R, int& C) { const int st = b / 1024, sb = b % 1024, swz = sb ^ (((sb >> 9) & 1) << 5); R = (st >> 1) * 16 + swz / 64; C = (st & 1) * 32 + (swz % 64) / 2; }
__host__ __device__ __forceinline__ int perm32(int rho) { const int n = rho >> 4, i = rho & 15; return 8 * (i >> 2) + 4 * n + (i & 3); }

struct Unit { int pm, pn; };
struct Gemm { const bf16_t* A; const bf16_t* Bt; int M, N, K; };

struct StaticOrder {
    int nM, nN, nwg, G, c;
    __host__ __device__ void init(int M, int N, int G_, int c_) { nM = M / BM; nN = N / BM; nwg = nM * nN; G = G_; c = c_; }
    __host__ __device__ bool next(int i, Unit& u) const {
        const long L = (long)i * G + c; if (L >= nwg) return false;
        int wgid = (int)L; { const int q = nwg / NXCD, r = nwg % NXCD, xcd = wgid % NXCD, off = wgid / NXCD; wgid = (xcd < r ? xcd * (q + 1) : r * (q + 1) + (xcd - r) * q) + off; }
        const int nig = WGM * nN, gid = wgid / nig, fm = gid * WGM, gsz = (nM - fm) < WGM ? (nM - fm) : WGM;
        u.pm = fm + ((wgid % nig) % gsz); u.pn = (wgid % nig) / gsz; return true;
    }
    __device__ __forceinline__ void a_ready(const Unit&) const {}
    __device__ __forceinline__ void done(const Unit&) const {}
};

__device__ __forceinline__ unsigned cvt_pk_bf16(float lo, float hi) { unsigned r; asm volatile("v_cvt_pk_bf16_f32 %0, %1, %2" : "=v"(r) : "v"(lo), "v"(hi)); return r; }
typedef float f32x2 __attribute__((ext_vector_type(2)));
__device__ __forceinline__ f32x2 gelu_pk(f32x2 v) {
    const f32x2 av = __builtin_elementwise_abs(v), d = av * 0.2316418882f + 1.0f;
    f32x2 t; t.x = __builtin_amdgcn_rcpf(d.x); t.y = __builtin_amdgcn_rcpf(d.y);
    f32x2 q = t * 0.5307027145f + (-0.7265760135f); q = q * t + 0.7107068705f; q = q * t + (-0.142248368f); q = q * t + 0.127414796f; q = q * t;
    const f32x2 s = (v * v) * (-0.72134752044f);
    f32x2 e; e.x = __builtin_amdgcn_exp2f(s.x); e.y = __builtin_amdgcn_exp2f(s.y);
    const f32x2 m = v * (q * e), r = v - m;
    f32x2 o; o.x = v.x < 0.f ? m.x : r.x; o.y = v.y < 0.f ? m.y : r.y; return o;
}

template <int ACT  > struct EpiBf16 {
    static constexpr bool PERM = true, AFTER_DRAIN = false; static_assert(ACT == 0 || ACT == 1, "EpiBf16: ACT is 0 (none) or 1 (gelu_pk)");
    bf16_t* O; int ldc; const float* bias; int split_cols; size_t split_stride; float scale0;
    __device__ __forceinline__ void operator()(const f32x4 (&acc)[2][2][4][2], const Unit& u, int wr, int wc, int fr, int fq) const {
        const int row0 = u.pm * BM + wr * 64 + fr; int colt = u.pn * BM; bf16_t* base = O;
        float sc = 1.f; if (split_cols) { const int t = colt / split_cols; base += (size_t)t * split_stride; colt -= t * split_cols; if (t == 0) sc = scale0; }
        const int col0 = colt + wc * 32 + 8 * fq, bcol0 = u.pn * BM + wc * 32 + 8 * fq;
        f32x4 bv[2][2];
#pragma unroll
        for (int bj = 0; bj < 2; ++bj)
#pragma unroll
            for (int n = 0; n < 2; ++n) bv[bj][n] = bias ? *(const f32x4*)(bias + bcol0 + bj * HALF + 4 * n) : (f32x4){0.f, 0.f, 0.f, 0.f};
#pragma unroll
        for (int ai = 0; ai < 2; ++ai)
#pragma unroll
            for (int m = 0; m < 4; ++m) { bf16_t* rowp = base + (size_t)(row0 + ai * HALF + m * 16) * ldc + col0;
#pragma unroll
                for (int bj = 0; bj < 2; ++bj) { f32x4 v0 = acc[ai][bj][m][0] + bv[bj][0], v1 = acc[ai][bj][m][1] + bv[bj][1];
                    if (ACT == 1) { f32x2 a = gelu_pk((f32x2){v0[0], v0[1]}), b = gelu_pk((f32x2){v0[2], v0[3]}), c = gelu_pk((f32x2){v1[0], v1[1]}), d = gelu_pk((f32x2){v1[2], v1[3]});
                        v0 = (f32x4){a.x, a.y, b.x, b.y}; v1 = (f32x4){c.x, c.y, d.x, d.y}; }
                    v0 = v0 * sc; v1 = v1 * sc; u32x4 w; w.x = cvt_pk_bf16(v0[0], v0[1]); w.y = cvt_pk_bf16(v0[2], v0[3]); w.z = cvt_pk_bf16(v1[0], v1[1]); w.w = cvt_pk_bf16(v1[2], v1[3]);
                    *(u32x4*)(rowp + bj * HALF) = w; } }
    }
};

struct PanelStats {
    unsigned* xbuf;
    unsigned* cnt;
    unsigned* tmo;
    int ntn; float eps;
    unsigned code;
    __device__ __forceinline__ bool run(const f32x4 (&v)[2][2][4][2], const Unit& u, int wr, int wc, int fr, int fq, PG8_LAS unsigned char* lds, int wid, int lane) const {
        typedef float f32x2v __attribute__((ext_vector_type(2)));
        PG8_LAS f32x2v* P = (PG8_LAS f32x2v*)lds;
        PG8_LAS f32x2v* S = (PG8_LAS f32x2v*)(lds + 8192);
        PG8_LAS unsigned* flag = (PG8_LAS unsigned*)(lds + 8192 + 2048);
#pragma unroll
        for (int ai = 0; ai < 2; ++ai)
#pragma unroll
            for (int m = 0; m < 4; ++m) {
                float s = 0.f;
#pragma unroll
                for (int bj = 0; bj < 2; ++bj)
#pragma unroll
                    for (int n = 0; n < 2; ++n) { const f32x4 x = v[ai][bj][m][n]; s += (x[0] + x[1]) + (x[2] + x[3]); }
                s += __shfl_xor(s, 16); s += __shfl_xor(s, 32);
                const float mw = s * (1.0f / 64.0f); float q = 0.f;
#pragma unroll
                for (int bj = 0; bj < 2; ++bj)
#pragma unroll
                    for (int n = 0; n < 2; ++n) { const f32x4 d = v[ai][bj][m][n] - mw; q += (d[0] * d[0] + d[1] * d[1]) + (d[2] * d[2] + d[3] * d[3]); }
                q += __shfl_xor(q, 16); q += __shfl_xor(q, 32);
                if (fq == 0) P[(ai * HALF + wr * 64 + m * 16 + fr) * 4 + wc] = (f32x2v){mw, q};
            }
        asm volatile("s_waitcnt lgkmcnt(0)" ::: "memory"); __builtin_amdgcn_s_barrier(); asm volatile("" ::: "memory");
#if defined(BROKEN_EXCHANGE_NO_WAIT)
#warning BROKEN CONTROL BUILD: the row-statistics exchange does not wait; results are wrong by design
        if (blockIdx.x >= 64) { const long long t0_ = clock64(); while (clock64() - t0_ < 60000) __builtin_amdgcn_s_sleep(8); }
#endif
        const int row = wid * 32 + (lane & 31);
        if (lane < 32) {
            const f32x2v a = P[row * 4 + 0], b = P[row * 4 + 1], c = P[row * 4 + 2], d = P[row * 4 + 3];
            const float mt = (a.x + b.x + c.x + d.x) * 0.25f;
            const float da = a.x - mt, db = b.x - mt, dc = c.x - mt, dd = d.x - mt;
            const float m2 = (a.y + b.y) + (c.y + d.y) + 64.0f * ((da * da + db * db) + (dc * dc + dd * dd));
            unsigned long long* slot = (unsigned long long*)xbuf + ((size_t)(u.pm * BM + row) * 4 + u.pn);
            __hip_atomic_store(slot, ((unsigned long long)__float_as_uint(m2) << 32) | __float_as_uint(mt), __ATOMIC_RELAXED, __HIP_MEMORY_SCOPE_AGENT);
        }
        asm volatile("s_waitcnt vmcnt(0)" ::: "memory");
        if (lane == 0) __hip_atomic_fetch_add(cnt + 64 * u.pm, 1u, __ATOMIC_RELAXED, __HIP_MEMORY_SCOPE_AGENT);
        if (wid == 0) {
            bool dead = false; const unsigned long long t0 = __builtin_amdgcn_s_memrealtime(); const unsigned want = 8u * (unsigned)ntn;
            for (;;) {
#if defined(BROKEN_EXCHANGE_NO_WAIT)
                break;
#endif
                if ((unsigned)__builtin_amdgcn_readfirstlane(__hip_atomic_load(cnt + 64 * u.pm, __ATOMIC_RELAXED, __HIP_MEMORY_SCOPE_AGENT)) >= want) break;
                if (__builtin_amdgcn_s_memrealtime() - t0 > 2000000ull) {
                    if (lane == 0) { unsigned expect = 0u; __hip_atomic_compare_exchange_strong(tmo + 1, &expect, code | (unsigned)(u.pm & 0xff), __ATOMIC_RELAXED, __ATOMIC_RELAXED, __HIP_MEMORY_SCOPE_AGENT);
                                     __hip_atomic_store(tmo, 1u, __ATOMIC_RELAXED, __HIP_MEMORY_SCOPE_AGENT); }
                    dead = true; break; }
                __builtin_amdgcn_s_sleep(2);
            }
            __builtin_amdgcn_fence(__ATOMIC_ACQUIRE, "agent");
            if (lane == 0) flag[0] = dead ? 1u : 0u;
        }
        asm volatile("s_waitcnt vmcnt(0) lgkmcnt(0)" ::: "memory"); __builtin_amdgcn_s_barrier(); asm volatile("" ::: "memory");
        const bool bad = flag[0] != 0u;
        if (lane < 32) {
            const unsigned long long* slot = (const unsigned long long*)xbuf + (size_t)(u.pm * BM + row) * 4; float mt[4], m2[4]; float ms = 0.f;
#pragma unroll
            for (int t = 0; t < 4; ++t) { if (t < ntn) { const unsigned long long w = __hip_atomic_load(slot + t, __ATOMIC_RELAXED, __HIP_MEMORY_SCOPE_AGENT); mt[t] = __uint_as_float((unsigned)w); m2[t] = __uint_as_float((unsigned)(w >> 32)); } else { mt[t] = 0.f; m2[t] = 0.f; } ms += mt[t]; }
            const float mean = ms / (float)ntn; float q = 0.f;
#pragma unroll
            for (int t = 0; t < 4; ++t) if (t < ntn) { const float dm = mt[t] - mean; q += m2[t] + 256.0f * dm * dm; }
            S[row] = (f32x2v){mean, 1.0f / sqrtf(q / (256.0f * (float)ntn) + eps)};
        }
        asm volatile("s_waitcnt lgkmcnt(0)" ::: "memory"); __builtin_amdgcn_s_barrier(); asm volatile("" ::: "memory");
        return bad;
    }
};
struct EpiLnRes {
    static constexpr bool PERM = false, AFTER_DRAIN = true;
    const float* base; float* out; int ldc; const float* bias; PanelStats st; unsigned poison;
    __device__ __forceinline__ void fused(f32x4 (&acc)[2][2][4][2], const Unit& u, int wr, int wc, int fr, int fq, PG8_LAS unsigned char* lds, int wid, int lane) const {
        typedef float f32x2v __attribute__((ext_vector_type(2)));
        const PG8_LAS f32x2v* S = (const PG8_LAS f32x2v*)(lds + 8192);
        const int col0 = u.pn * BM + wc * 32 + 4 * fq;
#pragma unroll
        for (int bj = 0; bj < 2; ++bj)
#pragma unroll
            for (int n = 0; n < 2; ++n) { const f32x4 bv = bias ? *(const f32x4*)(bias + col0 + bj * HALF + n * 16) : (f32x4){0.f, 0.f, 0.f, 0.f};
#pragma unroll
                for (int ai = 0; ai < 2; ++ai)
#pragma unroll
                    for (int m = 0; m < 4; ++m) acc[ai][bj][m][n] += bv; }
        f32x4 pre[4][2][2];
#pragma unroll
        for (int m = 0; m < 4; ++m) { const size_t off = (size_t)(u.pm * BM + wr * 64 + m * 16 + fr) * ldc + col0;
#pragma unroll
            for (int bj = 0; bj < 2; ++bj)
#pragma unroll
                for (int n = 0; n < 2; ++n) pre[m][bj][n] = *(const f32x4*)(base + off + bj * HALF + n * 16); }
        const bool bad = st.run(acc, u, wr, wc, fr, fq, lds, wid, lane) || poison != 0u;
        const float qnan = __builtin_nanf("");
#pragma unroll
        for (int ai = 0; ai < 2; ++ai)
#pragma unroll
            for (int m = 0; m < 4; ++m) { const int r = ai * HALF + wr * 64 + m * 16 + fr; const f32x2v sr = S[r]; const size_t off = (size_t)(u.pm * BM + r) * ldc + col0;
#pragma unroll
                for (int bj = 0; bj < 2; ++bj)
#pragma unroll
                    for (int n = 0; n < 2; ++n) { const f32x4 bs = ai == 0 ? pre[m][bj][n] : *(const f32x4*)(base + off + bj * HALF + n * 16); f32x4 o = bs + (acc[ai][bj][m][n] - sr.x) * sr.y;
                        if (bad) o = (f32x4){qnan, qnan, qnan, qnan}; *(f32x4*)(out + off + bj * HALF + n * 16) = o; }
                if (m & 1) asm volatile("" ::: "memory"); }
    }
};
struct EpiLnResLn {
    static constexpr bool PERM = false, AFTER_DRAIN = true;
    const float* base; float* out; bf16_t* xn; int ldc; const float* bias; PanelStats st1, st2; unsigned poison;
    __device__ __forceinline__ void fused(f32x4 (&acc)[2][2][4][2], const Unit& u, int wr, int wc, int fr, int fq, PG8_LAS unsigned char* lds, int wid, int lane) const {
        typedef float f32x2v __attribute__((ext_vector_type(2))); typedef unsigned u32x2v __attribute__((ext_vector_type(2)));
        const PG8_LAS f32x2v* S = (const PG8_LAS f32x2v*)(lds + 8192);
        const int col0 = u.pn * BM + wc * 32 + 4 * fq;
#pragma unroll
        for (int bj = 0; bj < 2; ++bj)
#pragma unroll
            for (int n = 0; n < 2; ++n) { const f32x4 bv = bias ? *(const f32x4*)(bias + col0 + bj * HALF + n * 16) : (f32x4){0.f, 0.f, 0.f, 0.f};
#pragma unroll
                for (int ai = 0; ai < 2; ++ai)
#pragma unroll
                    for (int m = 0; m < 4; ++m) acc[ai][bj][m][n] += bv; }
        bool bad = st1.run(acc, u, wr, wc, fr, fq, lds, wid, lane) || poison != 0u;
        const float qnan = __builtin_nanf("");
#pragma unroll
        for (int ai = 0; ai < 2; ++ai)
#pragma unroll
            for (int m = 0; m < 4; ++m) { const int r = ai * HALF + wr * 64 + m * 16 + fr; const f32x2v sr = S[r]; const size_t off = (size_t)(u.pm * BM + r) * ldc + col0;
#pragma unroll
                for (int bj = 0; bj < 2; ++bj)
#pragma unroll
                    for (int n = 0; n < 2; ++n) { const f32x4 bs = *(const f32x4*)(base + off + bj * HALF + n * 16); acc[ai][bj][m][n] = bs + (acc[ai][bj][m][n] - sr.x) * sr.y; }
                asm volatile("" : "+v"(acc[ai][0][m][0]), "+v"(acc[ai][0][m][1]), "+v"(acc[ai][1][m][0]), "+v"(acc[ai][1][m][1]));
                if (m & 1) asm volatile("" ::: "memory"); }
        const bool bad1 = bad;
        bad = st2.run(acc, u, wr, wc, fr, fq, lds, wid, lane) || bad;
#pragma unroll
        for (int ai = 0; ai < 2; ++ai)
#pragma unroll
            for (int m = 0; m < 4; ++m) { const int r = ai * HALF + wr * 64 + m * 16 + fr; const f32x2v sr = S[r]; const size_t off = (size_t)(u.pm * BM + r) * ldc + col0;
#pragma unroll
                for (int bj = 0; bj < 2; ++bj)
#pragma unroll
                    for (int n = 0; n < 2; ++n) { const f32x4 x1 = acc[ai][bj][m][n]; *(f32x4*)(out + off + bj * HALF + n * 16) = bad1 ? (f32x4){qnan, qnan, qnan, qnan} : x1;
                        const f32x4 o = (x1 - sr.x) * sr.y; u32x2v w; w.x = cvt_pk_bf16(o[0], o[1]); w.y = cvt_pk_bf16(o[2], o[3]);
                        if (bad) { w.x = 0x7fc07fc0u; w.y = 0x7fc07fc0u; } *(u32x2v*)(xn + off + bj * HALF + n * 16) = w; }
                asm volatile("" ::: "memory"); }
    }
};

template <class Epi, class Sched, bool ALIGN_EPI = false, bool SP2 = false>
__device__ __forceinline__ void gemm_phase(PG8_LAS unsigned char* lds, const Gemm g, const Sched& S, const Epi& E) {
    const int tid = tid_fresh(), wid = __builtin_amdgcn_readfirstlane(tid >> 6), lane = tid & 63, wr = wid >> 2, wc = wid & 3, fr = lane & 15, fq = lane >> 4;
    const int K = g.K, nt = K / BK;
    unsigned voffA[2], voffB[2];
#pragma unroll
    for (int i = 0; i < 2; ++i) { int R, C; stage_rc(tid * 16 + i * 8192, R, C); const int Rb = Epi::PERM ? ((R & ~31) + perm32(R & 31)) : R;
        voffA[i] = (unsigned)(R * K + C) * 2u; voffB[i] = (unsigned)(Rb * K + C) * 2u; }
    const size_t kstep = (size_t)(BK * 2);
    const size_t hstep = (size_t)HALF * K * 2;
    const size_t tstep = 2 * hstep;
    const unsigned ldsw = (unsigned)wid * 1024u;
    const int aoff = lds_byte(wr * 64 + fr, fq * 8), boff = lds_byte(wc * 32 + fr, fq * 8);
#define PG8_SA(b, h) (((b) * 2 + (h)) * HTB)
#define PG8_SB(b, h) ((4 + (b) * 2 + (h)) * HTB)
#define PG8_STAGE(bufoff, gbase, voff) do { _Pragma("unroll") for (int _i = 0; _i < 2; ++_i) \
        __builtin_amdgcn_global_load_lds((const unsigned*)((const char*)(gbase) + (voff)[_i]), (PG8_LAS unsigned*)(lds + (bufoff) + ldsw + _i * 8192), 16, 0, 0); } while (0)
#define PG8_LDA(dst, b, h) do { _Pragma("unroll") for (int m = 0; m < 4; ++m) _Pragma("unroll") for (int k = 0; k < 2; ++k) dst[m][k] = *(const PG8_LAS bf16x8*)(lds + PG8_SA(b, h) + aoff + m * 2048 + k * 1024); } while (0)
#define PG8_LDB(dst, b, h) do { _Pragma("unroll") for (int n = 0; n < 2; ++n) _Pragma("unroll") for (int k = 0; k < 2; ++k) dst[n][k] = *(const PG8_LAS bf16x8*)(lds + PG8_SB(b, h) + boff + n * 2048 + k * 1024); } while (0)
#define PG8_MMA(ai, bj, At, Bt) do { __builtin_amdgcn_s_setprio(1); _Pragma("unroll") for (int m = 0; m < 4; ++m) _Pragma("unroll") for (int n = 0; n < 2; ++n) _Pragma("unroll") for (int k = 0; k < 2; ++k) \
        acc[ai][bj][m][n] = __builtin_amdgcn_mfma_f32_16x16x32_bf16(Bt[n][k], At[m][k], acc[ai][bj][m][n], 0, 0, 0); __builtin_amdgcn_s_setprio(0); } while (0)
#define PG8_WAIT_V(n) asm volatile("s_waitcnt vmcnt(" #n ")" ::: "memory")
#define PG8_WAIT_L(n) asm volatile("s_waitcnt lgkmcnt(" #n ")" ::: "memory")
#define PG8_BAR __builtin_amdgcn_s_barrier()
#define PG8_SCHED __builtin_amdgcn_sched_barrier(0)
    Unit cur, nxt; int ui = 0;
    if (!S.next(0, cur)) return;
    f32x4 acc[2][2][4][2];
#pragma unroll
    for (int a = 0; a < 2; ++a)
#pragma unroll
        for (int b = 0; b < 2; ++b)
#pragma unroll
            for (int m = 0; m < 4; ++m)
#pragma unroll
                for (int n = 0; n < 2; ++n) acc[a][b][m][n] = (f32x4){0.f, 0.f, 0.f, 0.f};
    bf16x8 At[4][2], B0[2][2], B1[2][2];
    const char* cA = (const char*)g.A + (size_t)cur.pm * tstep; const char* cB = (const char*)g.Bt + (size_t)cur.pn * tstep;
    S.a_ready(cur);
    if constexpr (SP2) {
        PG8_STAGE(PG8_SB(0, 0), cB, voffB); PG8_STAGE(PG8_SB(0, 1), cB + hstep, voffB); PG8_STAGE(PG8_SA(0, 0), cA, voffA); PG8_STAGE(PG8_SA(0, 1), cA + hstep, voffA);
        if (wr == 1) PG8_BAR;
        PG8_WAIT_V(2); PG8_BAR;
        PG8_STAGE(PG8_SB(1, 0), cB + kstep, voffB); PG8_STAGE(PG8_SA(1, 0), cA + kstep, voffA); PG8_STAGE(PG8_SB(1, 1), cB + hstep + kstep, voffB);
        PG8_WAIT_V(6); PG8_BAR;
    } else {
        PG8_STAGE(PG8_SB(0, 0), cB, voffB); PG8_STAGE(PG8_SA(0, 0), cA, voffA); PG8_STAGE(PG8_SB(0, 1), cB + hstep, voffB); PG8_STAGE(PG8_SA(0, 1), cA + hstep, voffA);
        if (wr == 1) PG8_BAR;
        PG8_WAIT_V(4); PG8_BAR;
        PG8_STAGE(PG8_SB(1, 0), cB + kstep, voffB); PG8_STAGE(PG8_SA(1, 0), cA + kstep, voffA); PG8_STAGE(PG8_SB(1, 1), cB + hstep + kstep, voffB);
        PG8_WAIT_V(6); PG8_BAR;
    }
    for (;;) {
        const bool has_next = S.next(ui + 1, nxt);
        const char* nA = has_next ? (const char*)g.A + (size_t)nxt.pm * tstep : cA; const char* nB = has_next ? (const char*)g.Bt + (size_t)nxt.pn * tstep : cB;
        for (int t = 0; t < nt; t += 2) {
            const bool last = (t == nt - 2);
            const char* a1 = cA + (size_t)(t + 1) * kstep;
            const char* a2 = last ? nA : cA + (size_t)(t + 2) * kstep; const char* b2 = last ? nB : cB + (size_t)(t + 2) * kstep;
            const char* a3 = a2 + kstep; const char* b3 = b2 + kstep;
            if (last && has_next) S.a_ready(nxt);
            if constexpr (SP2) {
            PG8_LDB(B0, 0, 0); PG8_LDB(B1, 0, 1); PG8_SCHED; PG8_LDA(At, 0, 0); PG8_STAGE(PG8_SA(1, 1), a1 + hstep, voffA);
            PG8_WAIT_V(8); PG8_WAIT_L(0); PG8_BAR; PG8_MMA(0, 0, At, B0); PG8_MMA(0, 1, At, B1); PG8_BAR; PG8_SCHED;
            PG8_LDA(At, 0, 1); PG8_STAGE(PG8_SB(0, 0), b2, voffB); PG8_STAGE(PG8_SB(0, 1), b2 + hstep, voffB); PG8_STAGE(PG8_SA(0, 0), a2, voffA);
            PG8_WAIT_V(8); PG8_WAIT_L(0); PG8_BAR; PG8_MMA(1, 0, At, B0); PG8_MMA(1, 1, At, B1); PG8_BAR; PG8_SCHED;
            PG8_LDB(B0, 1, 0); PG8_LDB(B1, 1, 1); PG8_SCHED; PG8_LDA(At, 1, 0); PG8_STAGE(PG8_SA(0, 1), a2 + hstep, voffA);
            PG8_WAIT_V(8); PG8_WAIT_L(0); PG8_BAR; PG8_MMA(0, 0, At, B0); PG8_MMA(0, 1, At, B1); PG8_BAR; PG8_SCHED;
            PG8_LDA(At, 1, 1); PG8_STAGE(PG8_SB(1, 0), b3, voffB); PG8_STAGE(PG8_SB(1, 1), b3 + hstep, voffB); PG8_STAGE(PG8_SA(1, 0), a3, voffA);
            PG8_WAIT_V(8); PG8_WAIT_L(0); PG8_BAR; PG8_MMA(1, 0, At, B0); PG8_MMA(1, 1, At, B1); PG8_BAR; PG8_SCHED;
            } else {
            PG8_LDB(B0, 0, 0); PG8_SCHED; PG8_LDA(At, 0, 0); PG8_STAGE(PG8_SA(1, 1), a1 + hstep, voffA);
            PG8_WAIT_L(8); PG8_BAR; PG8_WAIT_L(0); PG8_MMA(0, 0, At, B0); PG8_BAR; PG8_SCHED;
            PG8_LDB(B1, 0, 1); PG8_STAGE(PG8_SB(0, 0), b2, voffB);
            PG8_BAR; PG8_WAIT_L(0); PG8_MMA(0, 1, At, B1); PG8_BAR;
            PG8_LDA(At, 0, 1); PG8_STAGE(PG8_SA(0, 0), a2, voffA);
            PG8_BAR; PG8_WAIT_L(0); PG8_MMA(1, 0, At, B0); PG8_BAR; PG8_SCHED;
            PG8_STAGE(PG8_SB(0, 1), b2 + hstep, voffB);
            PG8_WAIT_V(6); PG8_BAR; PG8_MMA(1, 1, At, B1); PG8_BAR;
            PG8_LDB(B0, 1, 0); PG8_SCHED; PG8_LDA(At, 1, 0); PG8_STAGE(PG8_SA(0, 1), a2 + hstep, voffA);
            PG8_WAIT_L(8); PG8_BAR; PG8_WAIT_L(0); PG8_MMA(0, 0, At, B0); PG8_BAR; PG8_SCHED;
            PG8_LDB(B1, 1, 1); PG8_STAGE(PG8_SB(1, 0), b3, voffB);
            PG8_BAR; PG8_WAIT_L(0); PG8_MMA(0, 1, At, B1); PG8_BAR;
            PG8_LDA(At, 1, 1); PG8_STAGE(PG8_SA(1, 0), a3, voffA);
            PG8_BAR; PG8_WAIT_L(0); PG8_MMA(1, 0, At, B0); PG8_BAR; PG8_SCHED;
            PG8_STAGE(PG8_SB(1, 1), b3 + hstep, voffB);
            PG8_WAIT_V(6); PG8_BAR; PG8_MMA(1, 1, At, B1); PG8_BAR;
            }
        }
        if constexpr (ALIGN_EPI) { if (wr == 0) PG8_BAR; }
        if constexpr (!Epi::AFTER_DRAIN) { E(acc, cur, wr, wc, fr, fq); S.done(cur); }
        if (!has_next) break;
#pragma unroll
        for (int a = 0; a < 2; ++a)
#pragma unroll
            for (int b = 0; b < 2; ++b)
#pragma unroll
                for (int m = 0; m < 4; ++m)
#pragma unroll
                    for (int n = 0; n < 2; ++n) acc[a][b][m][n] = (f32x4){0.f, 0.f, 0.f, 0.f};
        cur = nxt; cA = nA; cB = nB; ++ui;
        if constexpr (ALIGN_EPI) { if (wr == 1) PG8_BAR; }
    }
    PG8_WAIT_V(0);
    if constexpr (!ALIGN_EPI) { if (wr == 0) PG8_BAR; }
    PG8_BAR;
    if constexpr (Epi::AFTER_DRAIN) { E.fused(acc, cur, wr, wc, fr, fq, lds, wid, lane); S.done(cur); }
#undef PG8_SA
#undef PG8_SB
#undef PG8_STAGE
#undef PG8_LDA
#undef PG8_LDB
#undef PG8_MMA
#undef PG8_WAIT_V
#undef PG8_WAIT_L
#undef PG8_BAR
#undef PG8_SCHED
}
}
namespace pg8 {
struct EpiF32 {
    static constexpr bool PERM = false, AFTER_DRAIN = false;
    float* C; int ldc; const float* bias;
    __device__ __forceinline__ void operator()(const f32x4 (&acc)[2][2][4][2], const Unit& u, int wr, int wc, int fr, int fq) const {
        const int row0 = u.pm * BM + wr * 64 + fr, col0 = u.pn * BM + wc * 32 + 4 * fq;
        f32x4 bv[2][2];
#pragma unroll
        for (int bj = 0; bj < 2; ++bj)
#pragma unroll
            for (int n = 0; n < 2; ++n) bv[bj][n] = bias ? *(const f32x4*)(bias + col0 + bj * HALF + n * 16) : (f32x4){0.f, 0.f, 0.f, 0.f};
#pragma unroll
        for (int ai = 0; ai < 2; ++ai)
#pragma unroll
            for (int m = 0; m < 4; ++m) { float* rowp = C + (size_t)(row0 + ai * HALF + m * 16) * ldc + col0;
#pragma unroll
                for (int bj = 0; bj < 2; ++bj)
#pragma unroll
                    for (int n = 0; n < 2; ++n) *(f32x4*)(rowp + bj * HALF + n * 16) = acc[ai][bj][m][n] + bv[bj][n]; }
    }
};

constexpr int MOE_CAP = 16384;
struct MUnit { int e, rt, pn, nvalid; };
struct MoeSched {
    const PG8_LAS int* tp; const PG8_LAS int* cnt; int NPn, G, c;
    __device__ __forceinline__ bool next(int i, MUnit& u) const {
        const int T = tp[32]; const long Lx = (long)i * G + c; if (Lx >= (long)T * NPn) return false;
        const int L = (int)Lx, tile = L / NPn; int e = 0;
#pragma unroll
        for (int k = 1; k < 32; ++k) e += (tp[k] <= tile) ? 1 : 0;
        const int rt = tile - tp[e]; int rem = cnt[e] - rt * 256; rem = rem < 256 ? rem : 256;
        u.e = __builtin_amdgcn_readfirstlane(e); u.rt = __builtin_amdgcn_readfirstlane(rt); u.pn = __builtin_amdgcn_readfirstlane(L % NPn); u.nvalid = __builtin_amdgcn_readfirstlane(rem);
        return true;
    }
};
__device__ __forceinline__ float sigmoid_fast(float z) { return __builtin_amdgcn_rcpf(1.0f + __builtin_amdgcn_exp2f(-1.4426950408889634f * z)); }
struct EpiSwiglu {
    static constexpr bool PERM = true;
    bf16_t* act; const float* b1;
    __device__ __forceinline__ void operator()(const f32x4 (&acc)[2][2][4][2], const MUnit& u, int wr, int wc, int fr, int fq) const {
        const int c0 = wc * 32 + 8 * fq; const float* bb = b1 + (size_t)u.e * 2048 + 128 * u.pn + c0;
        f32x4 bg[2], bl[2];
#pragma unroll
        for (int n = 0; n < 2; ++n) { bg[n] = *(const f32x4*)(bb + 4 * n); bl[n] = *(const f32x4*)(bb + 1024 + 4 * n); }
        bf16_t* base = act + ((size_t)u.e * MOE_CAP + (size_t)u.rt * 256 + wr * 64 + fr) * 1024 + 128 * u.pn + c0;
#pragma unroll
        for (int ai = 0; ai < 2; ++ai)
#pragma unroll
            for (int m = 0; m < 4; ++m) {
                unsigned w[4];
#pragma unroll
                for (int n = 0; n < 2; ++n) { const f32x4 g4 = acc[ai][0][m][n] + bg[n], l4 = acc[ai][1][m][n] + bl[n]; float a[4];
#pragma unroll
                    for (int j = 0; j < 4; ++j) { const float g = fminf(g4[j], 7.0f), li = fminf(fmaxf(l4[j], -7.0f), 7.0f); a[j] = g * sigmoid_fast(1.702f * g) * (li + 1.0f); }
                    w[2 * n] = cvt_pk_bf16(a[0], a[1]); w[2 * n + 1] = cvt_pk_bf16(a[2], a[3]); }
                u32x4 o; o.x = w[0]; o.y = w[1]; o.z = w[2]; o.w = w[3];
                *(u32x4*)(base + (size_t)(ai * HALF + m * 16) * 1024) = o; }
    }
};
struct EpiGateScatter {
    static constexpr bool PERM = true;
    bf16_t* y4; const float* b2; const int* tk; const float* gate;
    __device__ __forceinline__ void operator()(const f32x4 (&acc)[2][2][4][2], const MUnit& u, int wr, int wc, int fr, int fq) const {
        const int c0 = 256 * u.pn + wc * 32 + 8 * fq; const float* bb = b2 + (size_t)u.e * 1024 + c0;
        f32x4 bv[2][2];
#pragma unroll
        for (int bj = 0; bj < 2; ++bj)
#pragma unroll
            for (int n = 0; n < 2; ++n) bv[bj][n] = *(const f32x4*)(bb + bj * HALF + 4 * n);
        const size_t lbase = (size_t)u.e * MOE_CAP + (size_t)u.rt * 256;
#pragma unroll
        for (int ai = 0; ai < 2; ++ai)
#pragma unroll
            for (int m = 0; m < 4; ++m) { const int r = ai * HALF + wr * 64 + m * 16 + fr;
                if (r < u.nvalid) { const int t = tk[lbase + r]; const float g = gate[lbase + r]; bf16_t* dst = y4 + (size_t)t * 1024 + c0;
#pragma unroll
                    for (int bj = 0; bj < 2; ++bj) { const f32x4 v0 = (acc[ai][bj][m][0] + bv[bj][0]) * g, v1 = (acc[ai][bj][m][1] + bv[bj][1]) * g;
                        u32x4 o; o.x = cvt_pk_bf16(v0[0], v0[1]); o.y = cvt_pk_bf16(v0[2], v0[3]); o.z = cvt_pk_bf16(v1[0], v1[1]); o.w = cvt_pk_bf16(v1[2], v1[3]);
                        *(u32x4*)(dst + bj * HALF) = o; } } }
    }
};

template <class Epi, bool GATHER>
__device__ __forceinline__ void gemm_phase_moe(PG8_LAS unsigned char* lds, const bf16_t* A, const bf16_t* Bt, const int K, const int NB, const int* rowlist, const MoeSched& S, const Epi& E) {
    const int tid = tid_fresh(), wid = __builtin_amdgcn_readfirstlane(tid >> 6), lane = tid & 63, wr = wid >> 2, wc = wid & 3, fr = lane & 15, fq = lane >> 4;
    const int nt = K / BK;
    int RA[2]; unsigned cbA[2], voffB[2];
#pragma unroll
    for (int i = 0; i < 2; ++i) { int R, C; stage_rc(tid * 16 + i * 8192, R, C); const int Rb = Epi::PERM ? ((R & ~31) + perm32(R & 31)) : R;
        RA[i] = R; cbA[i] = (unsigned)C * 2u; voffB[i] = (unsigned)(Rb * K + C) * 2u; }
    const size_t kstep = (size_t)(BK * 2);
    const size_t hstep = (size_t)HALF * K * 2;
    const unsigned ldsw = (unsigned)wid * 1024u;
    const int aoff = lds_byte(wr * 64 + fr, fq * 8), boff = lds_byte(wc * 32 + fr, fq * 8);
#define PG8_SA(b, h) (((b) * 2 + (h)) * HTB)
#define PG8_SB(b, h) ((4 + (b) * 2 + (h)) * HTB)
#define PG8_STAGE(bufoff, gbase, voff) do { _Pragma("unroll") for (int _i = 0; _i < 2; ++_i) \
        __builtin_amdgcn_global_load_lds((const unsigned*)((const char*)(gbase) + (voff)[_i]), (PG8_LAS unsigned*)(lds + (bufoff) + ldsw + _i * 8192), 16, 0, 0); } while (0)
#define PG8_LDA(dst, b, h) do { _Pragma("unroll") for (int m = 0; m < 4; ++m) _Pragma("unroll") for (int k = 0; k < 2; ++k) dst[m][k] = *(const PG8_LAS bf16x8*)(lds + PG8_SA(b, h) + aoff + m * 2048 + k * 1024); } while (0)
#define PG8_LDB(dst, b, h) do { _Pragma("unroll") for (int n = 0; n < 2; ++n) _Pragma("unroll") for (int k = 0; k < 2; ++k) dst[n][k] = *(const PG8_LAS bf16x8*)(lds + PG8_SB(b, h) + boff + n * 2048 + k * 1024); } while (0)
#define PG8_MMA(ai, bj, At, Bt_) do { __builtin_amdgcn_s_setprio(1); _Pragma("unroll") for (int m = 0; m < 4; ++m) _Pragma("unroll") for (int n = 0; n < 2; ++n) _Pragma("unroll") for (int k = 0; k < 2; ++k) \
        acc[ai][bj][m][n] = __builtin_amdgcn_mfma_f32_16x16x32_bf16(Bt_[n][k], At[m][k], acc[ai][bj][m][n], 0, 0, 0); __builtin_amdgcn_s_setprio(0); } while (0)
#define PG8_WAIT_V(n) asm volatile("s_waitcnt vmcnt(" #n ")" ::: "memory")
#define PG8_WAIT_L(n) asm volatile("s_waitcnt lgkmcnt(" #n ")" ::: "memory")
#define PG8_BAR __builtin_amdgcn_s_barrier()
#define PG8_SCHED __builtin_amdgcn_sched_barrier(0)
#define PG8_AOFFS(dst, u) do { _Pragma("unroll") for (int _h = 0; _h < 2; ++_h) _Pragma("unroll") for (int _i = 0; _i < 2; ++_i) { \
        if constexpr (GATHER) { int _r = _h * HALF + RA[_i]; _r = _r < (u).nvalid ? _r : (u).nvalid - 1; \
            const int _tk = rowlist[(size_t)(u).e * MOE_CAP + (size_t)(u).rt * 256 + _r]; dst[_h][_i] = (unsigned)(_tk >> 2) * (unsigned)(K * 2) + cbA[_i]; } \
        else dst[_h][_i] = (unsigned)((_h * HALF + RA[_i]) * K) * 2u + cbA[_i]; } } while (0)
#define PG8_ABASE(u) (GATHER ? (const char*)A : (const char*)A + ((size_t)(u).e * MOE_CAP + (size_t)(u).rt * 256) * (size_t)K * 2)
#define PG8_BBASE(u) ((const char*)Bt + ((size_t)(u).e * NB + (size_t)(u).pn * 256) * (size_t)K * 2)
    MUnit cur, nxt; int ui = 0;
    if (!S.next(0, cur)) return;
    f32x4 acc[2][2][4][2];
#pragma unroll
    for (int a = 0; a < 2; ++a)
#pragma unroll
        for (int b = 0; b < 2; ++b)
#pragma unroll
            for (int m = 0; m < 4; ++m)
#pragma unroll
                for (int n = 0; n < 2; ++n) acc[a][b][m][n] = (f32x4){0.f, 0.f, 0.f, 0.f};
    bf16x8 At[4][2], B0[2][2], B1[2][2];
    unsigned ca[2][2], na[2][2];
    PG8_AOFFS(ca, cur);
    const char* cA = PG8_ABASE(cur); const char* cB = PG8_BBASE(cur);
    PG8_STAGE(PG8_SB(0, 0), cB, voffB); PG8_STAGE(PG8_SB(0, 1), cB + hstep, voffB); PG8_STAGE(PG8_SA(0, 0), cA, ca[0]); PG8_STAGE(PG8_SA(0, 1), cA, ca[1]);
    if (wr == 1) PG8_BAR;
    PG8_WAIT_V(2); PG8_BAR;
    PG8_STAGE(PG8_SB(1, 0), cB + kstep, voffB); PG8_STAGE(PG8_SA(1, 0), cA + kstep, ca[0]); PG8_STAGE(PG8_SB(1, 1), cB + hstep + kstep, voffB);
    PG8_WAIT_V(6); PG8_BAR;
    for (;;) {
        const bool has_next = S.next(ui + 1, nxt);
        const char* nA = has_next ? PG8_ABASE(nxt) : cA; const char* nB = has_next ? PG8_BBASE(nxt) : cB;
#pragma unroll
        for (int h = 0; h < 2; ++h)
#pragma unroll
            for (int i = 0; i < 2; ++i) na[h][i] = ca[h][i];
        for (int t = 0; t < nt; t += 2) {
            const bool last = (t == nt - 2);
            if constexpr (GATHER) { if (t == nt - 4 && has_next) PG8_AOFFS(na, nxt); }
            const char* a1 = cA + (size_t)(t + 1) * kstep;
            const char* a2 = last ? nA : cA + (size_t)(t + 2) * kstep; const char* b2 = last ? nB : cB + (size_t)(t + 2) * kstep;
            const char* a3 = a2 + kstep; const char* b3 = b2 + kstep;
            PG8_LDB(B0, 0, 0); PG8_LDB(B1, 0, 1); PG8_SCHED; PG8_LDA(At, 0, 0); PG8_STAGE(PG8_SA(1, 1), a1, ca[1]);
            if constexpr (GATHER) { if (last) {
#pragma unroll
                for (int h = 0; h < 2; ++h)
#pragma unroll
                    for (int i = 0; i < 2; ++i) ca[h][i] = na[h][i]; } }
            PG8_WAIT_V(8); PG8_WAIT_L(0); PG8_BAR; PG8_MMA(0, 0, At, B0); PG8_MMA(0, 1, At, B1); PG8_BAR; PG8_SCHED;
            PG8_LDA(At, 0, 1); PG8_STAGE(PG8_SB(0, 0), b2, voffB); PG8_STAGE(PG8_SB(0, 1), b2 + hstep, voffB); PG8_STAGE(PG8_SA(0, 0), a2, ca[0]);
            PG8_WAIT_V(8); PG8_WAIT_L(0); PG8_BAR; PG8_MMA(1, 0, At, B0); PG8_MMA(1, 1, At, B1); PG8_BAR; PG8_SCHED;
            PG8_LDB(B0, 1, 0); PG8_LDB(B1, 1, 1); PG8_SCHED; PG8_LDA(At, 1, 0); PG8_STAGE(PG8_SA(0, 1), a2, ca[1]);
            PG8_WAIT_V(8); PG8_WAIT_L(0); PG8_BAR; PG8_MMA(0, 0, At, B0); PG8_MMA(0, 1, At, B1); PG8_BAR; PG8_SCHED;
            PG8_LDA(At, 1, 1); PG8_STAGE(PG8_SB(1, 0), b3, voffB); PG8_STAGE(PG8_SB(1, 1), b3 + hstep, voffB); PG8_STAGE(PG8_SA(1, 0), a3, ca[0]);
            PG8_WAIT_V(8); PG8_WAIT_L(0); PG8_BAR; PG8_MMA(1, 0, At, B0); PG8_MMA(1, 1, At, B1); PG8_BAR; PG8_SCHED;
        }
        if (wr == 0) PG8_BAR;
        E(acc, cur, wr, wc, fr, fq);
        if (!has_next) break;
#pragma unroll
        for (int a = 0; a < 2; ++a)
#pragma unroll
            for (int b = 0; b < 2; ++b)
#pragma unroll
                for (int m = 0; m < 4; ++m)
#pragma unroll
                    for (int n = 0; n < 2; ++n) acc[a][b][m][n] = (f32x4){0.f, 0.f, 0.f, 0.f};
        cur = nxt; cA = nA; cB = nB; ++ui;
        if (wr == 1) PG8_BAR;
    }
    PG8_WAIT_V(0);
    PG8_BAR;
#undef PG8_SA
#undef PG8_SB
#undef PG8_STAGE
#undef PG8_LDA
#undef PG8_LDB
#undef PG8_MMA
#undef PG8_WAIT_V
#undef PG8_WAIT_L
#undef PG8_BAR
#undef PG8_SCHED
#undef PG8_AOFFS
#undef PG8_ABASE
#undef PG8_BBASE
}
}
#include <hip/hip_bf16.h>
namespace attn_body {
using bf16=__hip_bfloat16;
using bf16x8=__attribute__((ext_vector_type(8)))short;
using s16x4=__attribute__((ext_vector_type(4)))short;
using f32x16=__attribute__((ext_vector_type(16)))float;
using u32x4=__attribute__((ext_vector_type(4)))unsigned;
constexpr int BATCH=2,NHEAD=4,SEQ=8192,D=64,DM=2816,DO=1024;
constexpr int NW=8,QBLK=32,QB=QBLK*NW,KVBLK=64,NQB=SEQ/QB;
constexpr int ATTN_PITCH=DM, ATTN_UNIT_ROWS=QB;
constexpr float LOG2E_F=1.4426950408889634f;
__device__ __forceinline__ int crow(int r,int hi){return (r&3)+8*(r>>2)+4*hi;}
#define SBAR() __builtin_amdgcn_sched_barrier(0)
__device__ __forceinline__ void cmask(f32x16&p0,f32x16&p1,int jb,int qrel,int hi){
  const float NEG=-INFINITY; int kb=64*jb+4*hi;
  #pragma unroll
  for(int r=0;r<16;++r){int kv=kb+(r&3)+8*(r>>2); if(kv>qrel)p0[r]=NEG; if(kv+32>qrel)p1[r]=NEG;}
}

constexpr int NSLOT=3, SLOTB=8192;
constexpr int LDS_K=0, LDS_V=NSLOT*SLOTB, LDS_WS=2*NSLOT*SLOTB, LDS_OST=LDS_WS+NW*64*4, LDS_BYTES=LDS_OST+NW*4096, LDS_FB=86016, LDS_FB_BYTES=32768;
constexpr float C2=0.125f*1.4426950408889634f;
__device__ __forceinline__ void glds16(const void*gsrc,unsigned lds_dst){unsigned keep;
  asm volatile("s_mov_b32 %0, m0\n\ts_mov_b32 m0, %2\n\ts_nop 0\n\tglobal_load_lds_dwordx4 %1, off\n\ts_mov_b32 m0, %0":"=&s"(keep):"v"(gsrc),"s"(lds_dst):"memory");}
__device__ __forceinline__ float max3f(float a,float b,float c){float r;asm("v_max3_f32 %0, %1, %2, %3":"=v"(r):"v"(a),"v"(b),"v"(c));return r;}
__device__ __forceinline__ float max2f(float a,float b){float r;asm("v_max_f32_e32 %0, %1, %2":"=v"(r):"v"(a),"v"(b));return r;}
__device__ __forceinline__ float fadd_s(float a,float b){float r;asm("v_add_f32_e32 %0, %1, %2":"=v"(r):"v"(a),"v"(b));return r;}
__device__ __forceinline__ float fsub_s(float a,float b){float r;asm("v_sub_f32_e32 %0, %1, %2":"=v"(r):"v"(a),"v"(b));return r;}
typedef float f32x2_t __attribute__((ext_vector_type(2))); typedef __bf16 bf16x2_t __attribute__((ext_vector_type(2)));
__device__ __forceinline__ unsigned cvtpk_s(float lo,float hi){f32x2_t v={lo,hi};bf16x2_t b=__builtin_convertvector(v,bf16x2_t);return __builtin_bit_cast(unsigned,b);}
#define WAIT_BAR(N) asm volatile("s_waitcnt vmcnt(" #N ") lgkmcnt(0)\n\ts_barrier":::"memory")

__device__ __forceinline__ void qkt(f32x16&p0,f32x16&p1,const char*Kslot,const bf16x8*qr,int r32,int hi){
  const char*kb=Kslot+hi*1024+r32*16;
  #pragma unroll
  for(int d0=0;d0<4;++d0){
    const bf16x8 b0=*reinterpret_cast<const bf16x8*>(kb+d0*2048);
    const bf16x8 b1=*reinterpret_cast<const bf16x8*>(kb+d0*2048+512);
    {p0=__builtin_amdgcn_mfma_f32_32x32x16_bf16(b0,qr[d0],p0,0,0,0);p1=__builtin_amdgcn_mfma_f32_32x32x16_bf16(b1,qr[d0],p1,0,0,0);}}
}
typedef __attribute__((address_space(3))) const char* lds_cptr;
typedef short v4i16_t __attribute__((ext_vector_type(4)));
__device__ __forceinline__ void kload8(bf16x8*kf,lds_cptr kp){
  kf[0]=*(const __attribute__((address_space(3))) bf16x8*)(kp);      kf[1]=*(const __attribute__((address_space(3))) bf16x8*)(kp+512);
  kf[2]=*(const __attribute__((address_space(3))) bf16x8*)(kp+2048); kf[3]=*(const __attribute__((address_space(3))) bf16x8*)(kp+2560);
  kf[4]=*(const __attribute__((address_space(3))) bf16x8*)(kp+4096); kf[5]=*(const __attribute__((address_space(3))) bf16x8*)(kp+4608);
  kf[6]=*(const __attribute__((address_space(3))) bf16x8*)(kp+6144); kf[7]=*(const __attribute__((address_space(3))) bf16x8*)(kp+6656);
}
__device__ __forceinline__ void kload2(bf16x8*kf,lds_cptr kp,int j){ kf[2*j]=*(const __attribute__((address_space(3))) bf16x8*)(kp+j*2048); kf[2*j+1]=*(const __attribute__((address_space(3))) bf16x8*)(kp+j*2048+512); }
__device__ __forceinline__ s16x4 vtr(lds_cptr p){ return __builtin_bit_cast(s16x4,__builtin_amdgcn_ds_read_tr16_b64_v4i16((__attribute__((address_space(3))) v4i16_t*)p)); }
__device__ __forceinline__ float rowmax(const f32x16&p0,const f32x16&p1){
  float a=max3f(p0[0],p0[1],p1[0]),b=max3f(p0[2],p0[3],p1[1]);a=max3f(a,p1[2],p1[3]);
  #pragma unroll
  for(int r=4;r<16;r+=4){a=max3f(a,p0[r],p0[r+1]);b=max3f(b,p0[r+2],p0[r+3]);a=max3f(a,p1[r],p1[r+1]);b=max3f(b,p1[r+2],p1[r+3]);}
  const float m=max2f(a,b);
  auto rr=__builtin_amdgcn_permlane32_swap(__float_as_uint(m),__float_as_uint(m),false,false);
  return max2f(__uint_as_float(rr[0]),__uint_as_float(rr[1]));
}
__device__ __forceinline__ void pv(f32x16*o,int vb,bf16x8 pa0,bf16x8 pa1,bf16x8 pa2,bf16x8 pa3){
  #pragma unroll
  for(int d0=0;d0<2;++d0){s16x4 lo[4],hi[4];
    #pragma unroll
    for(int ks=0;ks<4;++ks){
      asm volatile("ds_read_b64_tr_b16 %0,%1 offset:%c2":"=&v"(lo[ks]):"v"(vb),"i"(d0*4096+ks*1024):"memory");
      asm volatile("ds_read_b64_tr_b16 %0,%1 offset:%c2":"=&v"(hi[ks]):"v"(vb),"i"(d0*4096+ks*1024+512):"memory");}
    asm volatile("s_waitcnt lgkmcnt(0)":::"memory");SBAR();
    #define PK(k) (bf16x8){lo[k][0],lo[k][1],lo[k][2],lo[k][3],hi[k][0],hi[k][1],hi[k][2],hi[k][3]}
    o[d0]=__builtin_amdgcn_mfma_f32_32x32x16_bf16(pa0,PK(0),o[d0],0,0,0);
    o[d0]=__builtin_amdgcn_mfma_f32_32x32x16_bf16(pa1,PK(1),o[d0],0,0,0);
    o[d0]=__builtin_amdgcn_mfma_f32_32x32x16_bf16(pa2,PK(2),o[d0],0,0,0);
    o[d0]=__builtin_amdgcn_mfma_f32_32x32x16_bf16(pa3,PK(3),o[d0],0,0,0);
    #undef PK
  }
}

#ifndef ATTN_STORE16
#define ATTN_STORE16(p,v) (*(u32x4*)(p)=(v))
#endif
template<int THRL> __device__ __forceinline__ void attn_unit(int b,int h,int qb,const bf16*Q,const bf16*__restrict__ K,const bf16*__restrict__ V,bf16*O,const float*__restrict__ Fg,char*shm){
  const int tid=tid_fresh(),lane=tid&63,r32=lane&31,hi=lane>>5; const int wid=__builtin_amdgcn_readfirstlane(tid>>6);
  const long rowbase=(long)b*SEQ; const int q0=qb*QB;
  const bf16*Qw=Q+(rowbase+q0+wid*QBLK)*DM+h*D;
  const bf16*Kh=K+rowbase*DM+h*D,*Vh=V+rowbase*DM+h*D;
  const unsigned lds0=(unsigned)(uintptr_t)shm;
  float*wsf=(float*)(shm+LDS_WS)+wid*64;
  const bf16*ksrc=Kh+(long)lane*DM+wid*8;
  const bf16*vsrc=Vh+(long)(16*(wid&3)+(lane>>2))*DM+(wid>>2)*32+(lane&3)*8;
  const unsigned kdst=lds0+LDS_K+wid*1024, vdst=lds0+LDS_V+wid*1024;
  #define DMA_K(t,slot) glds16(ksrc+(long)(t)*KVBLK*DM,(unsigned)__builtin_amdgcn_readfirstlane(kdst+(slot)))
  #define DMA_V(t,slot) glds16(vsrc+(long)(t)*KVBLK*DM,(unsigned)__builtin_amdgcn_readfirstlane(vdst+(slot)))
  const int vb0=(int)(lds0+LDS_V)+((lane>>4)&1)*32+(lane&3)*8+(4*hi+((lane&15)>>2))*64;
  const char*Kbase=shm+LDS_K; bf16x8 kf[8];
  const lds_cptr shm3=(lds_cptr)shm; const lds_cptr kp0=shm3+LDS_K+hi*1024+r32*16; const lds_cptr vp0=shm3+LDS_V+((lane>>4)&1)*32+(lane&3)*8+(4*hi+((lane&15)>>2))*64;
  const int NT=(q0+QB)/KVBLK;
  typedef __attribute__((address_space(3))) float lds_f; typedef float f32x4b __attribute__((ext_vector_type(4)));
  lds_f*const Fb3=(lds_f*)(shm3+LDS_FB);
  { for(int j=tid;j<NT*KVBLK;j+=NW*64) Fb3[j]=-Fg[j]*LOG2E_F; }
  #define INITB(P0,P1,t) do{ const lds_f*fb_=Fb3+(t)*KVBLK+4*hi; \
    _Pragma("unroll") for(int g_=0;g_<4;++g_){ const f32x4b b0_=*(const __attribute__((address_space(3))) f32x4b*)(fb_+8*g_), b1_=*(const __attribute__((address_space(3))) f32x4b*)(fb_+32+8*g_); \
      P0[4*g_]=b0_[0]-mhat;P0[4*g_+1]=b0_[1]-mhat;P0[4*g_+2]=b0_[2]-mhat;P0[4*g_+3]=b0_[3]-mhat; P1[4*g_]=b1_[0]-mhat;P1[4*g_+1]=b1_[1]-mhat;P1[4*g_+2]=b1_[2]-mhat;P1[4*g_+3]=b1_[3]-mhat; } }while(0)
  DMA_K(0,0);DMA_V(0,0);DMA_K(1,SLOTB);
  bf16x8 qr[4];
  #pragma unroll
  for(int d0=0;d0<4;++d0)qr[d0]=*reinterpret_cast<const bf16x8*>(&Qw[(long)r32*DM+d0*16+hi*8]);
  float mhat=0.f,l_reg=0.f;f32x16 o[2];o[0]=f32x16{};o[1]=f32x16{};
  const int qrel=wid*QBLK+r32;
  #define CMASK(P0,P1,t) do{int jb_=(t)-(NT-4); if(jb_>=0)cmask(P0,P1,jb_,qrel,hi);}while(0)
  bool resc=false;
  #define START(P0,P1) do{ const float rm=rowmax(P0,P1); resc=false; \
    { const float dl=rm; mhat=fadd_s(mhat,dl); \
      _Pragma("unroll") for(int r=0;r<16;++r){P0[r]=fsub_s(P0[r],dl);P1[r]=fsub_s(P1[r],dl);} } \
    _Pragma("unroll") for(int r=0;r<16;++r)P0[r]=__builtin_amdgcn_exp2f(P0[r]); }while(0)
  #define RESC() do{ if(resc){ asm volatile("s_waitcnt lgkmcnt(0)":::"memory"); \
      _Pragma("unroll") for(int d_=0;d_<2;++d_) _Pragma("unroll") for(int r=0;r<16;++r)o[d_][r]*=wsf[crow(r,hi)]; } }while(0)
  f32x16 pA0,pA1,pB0,pB1;
  int sl_prev=0,sl_cur=0,sl_next=SLOTB;
  #define ROT() do{sl_prev=sl_cur;sl_cur=sl_next;sl_next=(sl_next==(NSLOT-1)*SLOTB)?0:sl_next+SLOTB;}while(0)
  DMA_K(2,2*SLOTB);
  WAIT_BAR(3);
  asm volatile("s_waitcnt lgkmcnt(0)":::"memory"); INITB(pA0,pA1,0);
  qkt(pA0,pA1,Kbase,qr,r32,hi);asm volatile("s_nop 15\n\ts_nop 7":"+v"(pA0),"+v"(pA1));CMASK(pA0,pA1,0);
  START(pA0,pA1);
  _Pragma("unroll") for(int r=0;r<16;++r)pA1[r]=__builtin_amdgcn_exp2f(pA1[r]);
  WAIT_BAR(0);
  DMA_K(3,0);DMA_V(1,SLOTB);
  ROT();
  kload8(kf,kp0+sl_cur);
  INITB(pB0,pB1,1);
  WAIT_BAR(2);
  s16x4 vlo[8],vhi[8]; u32x4 pw0,pw1,pw2,pw3;
  #define PKW(P,B) cvtpk_s(P[B],P[B+1])
  #define PAF(k) __builtin_bit_cast(bf16x8,pw##k)
  #define VFR(i) (bf16x8){vlo[i][0],vlo[i][1],vlo[i][2],vlo[i][3],vhi[i][0],vhi[i][1],vhi[i][2],vhi[i][3]}
  #define PIN(x) asm volatile("":"+v"(x))
  #define MX3(a,b,c) __builtin_fmaxf(__builtin_fmaxf((a),(b)),(c))
  #define GAPA(MF,A0,A1,A2,A3,W0,W1,PW) do{ MF; sacc+=A0; sacc+=A1; sacc+=A2; sacc+=A3; PIN(sacc); W0; W1; PIN(PW); SBAR(); }while(0)
  #define EX(v) __builtin_amdgcn_exp2f(v)
  #define GAPB(MF,X,B) do{ MF; X[B]=EX(X[B]); X[B+1]=EX(X[B+1]); X[B+2]=EX(X[B+2]); X[B+3]=EX(X[B+3]); PIN(X); SBAR(); }while(0)
  #define VRD(i) do{ vlo[i]=vtr(vp_+(((i)>>2)*4096+((i)&3)*1024)); vhi[i]=vtr(vp_+(((i)>>2)*4096+((i)&3)*1024+512)); }while(0)
  #define KRD(G,j) do{ if(G){ kload2(kf,kp0+sl_next,j); SBAR(); } }while(0)
  #define STEP(C0,C1,P0,P1,t,GK,GV,GL) do{ SBAR(); \
    const lds_cptr vp_=vp0+sl_prev; \
    VRD(0); SBAR(); float sacc=(P0[0]+P0[1]); \
    GAPA(C0=__builtin_amdgcn_mfma_f32_32x32x16_bf16(kf[0],qr[0],C0,0,0,0), P0[2],P0[3],P0[4],P0[5],     pw0[0]=PKW(P0,0), pw0[1]=PKW(P0,2), pw0); \
    VRD(4); SBAR(); GAPA(C1=__builtin_amdgcn_mfma_f32_32x32x16_bf16(kf[1],qr[0],C1,0,0,0), P0[6],P0[7],P0[8],P0[9],     pw0[2]=PKW(P0,4), pw0[3]=PKW(P0,6), pw0); \
    VRD(1); SBAR(); GAPA(C0=__builtin_amdgcn_mfma_f32_32x32x16_bf16(kf[2],qr[1],C0,0,0,0),   P0[10],P0[11],P0[12],P0[13], pw1[0]=PKW(P0,8), pw1[1]=PKW(P0,10), pw1); \
    VRD(5); SBAR(); GAPA(C1=__builtin_amdgcn_mfma_f32_32x32x16_bf16(kf[3],qr[1],C1,0,0,0),   P0[14],P0[15],P1[0],P1[1],   pw1[2]=PKW(P0,12),pw1[3]=PKW(P0,14), pw1); \
    VRD(2); SBAR(); GAPA(C0=__builtin_amdgcn_mfma_f32_32x32x16_bf16(kf[4],qr[2],C0,0,0,0),   P1[2],P1[3],P1[4],P1[5],     pw2[0]=PKW(P1,0), pw2[1]=PKW(P1,2), pw2); \
    VRD(6); SBAR(); GAPA(C1=__builtin_amdgcn_mfma_f32_32x32x16_bf16(kf[5],qr[2],C1,0,0,0),   P1[6],P1[7],P1[8],P1[9],     pw2[2]=PKW(P1,4), pw2[3]=PKW(P1,6), pw2); \
    VRD(3); SBAR(); GAPA(C0=__builtin_amdgcn_mfma_f32_32x32x16_bf16(kf[6],qr[3],C0,0,0,0),   P1[10],P1[11],P1[12],P1[13], pw3[0]=PKW(P1,8), pw3[1]=PKW(P1,10), pw3); \
    VRD(7); SBAR(); GAPA(C1=__builtin_amdgcn_mfma_f32_32x32x16_bf16(kf[7],qr[3],C1,0,0,0),   P1[14],P1[15],0.f,0.f,       pw3[2]=PKW(P1,12),pw3[3]=PKW(P1,14), pw3); \
    l_reg+=sacc; \
    if(GK){DMA_K((t)+3,sl_cur);} if(GV){DMA_V((t)+1,sl_next);} \
    CMASK(C0,C1,t); \
    { float a=MX3(C0[0],C0[1],C1[0]),b=MX3(C0[2],C0[3],C1[1]); a=MX3(a,C1[2],C1[3]); \
      _Pragma("unroll") for(int r=4;r<16;r+=4){a=MX3(a,C0[r],C0[r+1]);b=MX3(b,C0[r+2],C0[r+3]);a=MX3(a,C1[r],C1[r+1]);b=MX3(b,C1[r+2],C1[r+3]);} \
      float rm=__builtin_fmaxf(a,b); { auto rr=__builtin_amdgcn_permlane32_swap(__float_as_uint(rm),__float_as_uint(rm),false,false); rm=__builtin_fmaxf(__uint_as_float(rr[0]),__uint_as_float(rr[1])); } \
      resc=false; \
      if(__builtin_expect(__any(rm>(float)THRL),0)){ const float dl=__builtin_fmaxf(rm,0.f); mhat+=dl; \
        _Pragma("unroll") for(int r=0;r<16;++r){C0[r]-=dl;C1[r]-=dl;} \
        const float f=__builtin_amdgcn_exp2f(-dl); l_reg*=f; if(hi==0)wsf[r32]=f; resc=true; } } \
    SBAR(); \
    GAPB(o[0]=__builtin_amdgcn_mfma_f32_32x32x16_bf16(PAF(0),VFR(0),o[0],0,0,0), C0,0); \
    GAPB(o[1]=__builtin_amdgcn_mfma_f32_32x32x16_bf16(PAF(0),VFR(4),o[1],0,0,0), C0,4); \
    KRD(GL,0); GAPB(o[0]=__builtin_amdgcn_mfma_f32_32x32x16_bf16(PAF(1),VFR(1),o[0],0,0,0), C0,8); \
    KRD(GL,1); GAPB(o[1]=__builtin_amdgcn_mfma_f32_32x32x16_bf16(PAF(1),VFR(5),o[1],0,0,0), C0,12); \
    KRD(GL,2); GAPB(o[0]=__builtin_amdgcn_mfma_f32_32x32x16_bf16(PAF(2),VFR(2),o[0],0,0,0), C1,0); \
    KRD(GL,3); GAPB(o[1]=__builtin_amdgcn_mfma_f32_32x32x16_bf16(PAF(2),VFR(6),o[1],0,0,0), C1,4); \
    GAPB(o[0]=__builtin_amdgcn_mfma_f32_32x32x16_bf16(PAF(3),VFR(3),o[0],0,0,0), C1,8); \
    GAPB(o[1]=__builtin_amdgcn_mfma_f32_32x32x16_bf16(PAF(3),VFR(7),o[1],0,0,0), C1,12); \
    if((t)+1<NT){ INITB(P0,P1,(t)+1); } \
    }while(0)
  int t=1;
  #undef CMASK
  #define CMASK(P0,P1,t) do{}while(0)
  for(;t+5<NT;t+=2){
    STEP(pB0,pB1,pA0,pA1,t,true,true,true);     WAIT_BAR(2); RESC(); ROT();
    STEP(pA0,pA1,pB0,pB1,t+1,true,true,true);   WAIT_BAR(2); RESC(); ROT();
  }
  #undef CMASK
  #define CMASK(P0,P1,t) do{int jb_=(t)-(NT-4); if(jb_>=0)cmask(P0,P1,jb_,qrel,hi);}while(0)
  #define ENDW(tt) do{ if((tt)+3<NT){WAIT_BAR(2);} else if((tt)+2<NT){WAIT_BAR(1);} else {WAIT_BAR(0);} }while(0)
  for(;t+1<NT;t+=2){
    STEP(pB0,pB1,pA0,pA1,t,(t+3<NT),(t+1<NT),(t+1<NT));       ENDW(t);   RESC(); ROT();
    STEP(pA0,pA1,pB0,pB1,t+1,(t+4<NT),(t+2<NT),(t+2<NT));     ENDW(t+1); RESC(); ROT();
  }
  STEP(pB0,pB1,pA0,pA1,NT-1,false,false,false); RESC();
  { float sacc=pB0[0]+pB0[1]; _Pragma("unroll") for(int r=2;r<16;++r)sacc+=pB0[r]; _Pragma("unroll") for(int r=0;r<16;++r)sacc+=pB1[r]; l_reg+=sacc;
    pw0=(u32x4){PKW(pB0,0),PKW(pB0,2),PKW(pB0,4),PKW(pB0,6)};pw1=(u32x4){PKW(pB0,8),PKW(pB0,10),PKW(pB0,12),PKW(pB0,14)};pw2=(u32x4){PKW(pB1,0),PKW(pB1,2),PKW(pB1,4),PKW(pB1,6)};pw3=(u32x4){PKW(pB1,8),PKW(pB1,10),PKW(pB1,12),PKW(pB1,14)};
    SBAR(); pv(o,vb0+sl_cur,PAF(0),PAF(1),PAF(2),PAF(3)); }
  #undef PKW
  #undef PAF
  #undef VFR
  #undef PIN
  #undef MX3
  #undef GAPA
  #undef GAPB
  #undef EX
  #undef VRD
  #undef KRD
  #undef STEP
  #undef ENDW
  {auto rr=__builtin_amdgcn_permlane32_swap(__float_as_uint(l_reg),__float_as_uint(l_reg),false,false);l_reg=__uint_as_float(rr[0])+__uint_as_float(rr[1]);}
  if(hi==0)wsf[32+r32]=l_reg;asm volatile("s_waitcnt lgkmcnt(0)":::"memory");
  float rli[16];
  #pragma unroll
  for(int r=0;r<16;++r)rli[r]=__builtin_amdgcn_rcpf(wsf[32+crow(r,hi)]);
  bf16*Ow=O+(rowbase+q0+wid*QBLK)*DO+h*D;
  { bf16*stg=(bf16*)(shm+LDS_OST)+wid*2048;
    #pragma unroll
    for(int r=0;r<16;++r){const int orow=crow(r,hi);
      #pragma unroll
      for(int d0=0;d0<2;++d0)stg[orow*64+d0*32+r32]=__float2bfloat16(o[d0][r]*rli[r]);}
    asm volatile("s_waitcnt lgkmcnt(0)":::"memory");
    #pragma unroll
    for(int i=0;i<4;++i){const int row=i*8+(lane>>3),ch=lane&7; const u32x4 v=*(const u32x4*)(stg+row*64+ch*8); ATTN_STORE16(Ow+(long)row*DO+ch*8,v);} }
  asm volatile("s_waitcnt lgkmcnt(0)\n\ts_barrier":::"memory");
  #undef INITB
  #undef DMA_K
  #undef DMA_V
  #undef CMASK
  #undef START
  #undef RESC
  #undef ROT
}
constexpr int ATTN_LDS_BYTES=LDS_BYTES;
struct AttnTensors { const bf16* Q; const bf16* K; const bf16* V; bf16* O; const float* F; };
struct AttnUnit { int bh; int qb; };
struct StaticOrder {
  int vcu,G;
  __device__ __forceinline__ explicit StaticOrder(int grid,int block):vcu((grid%8==0)?(block%8)*(grid/8)+block/8:block),G(grid){}
  __device__ __forceinline__ bool next(int i,AttnUnit&u)const{ const int idx=vcu+i*G; if(idx>=BATCH*NHEAD*NQB)return false; u.bh=idx>>5; u.qb=idx&31; return true; }
  __device__ __forceinline__ void a_ready(const AttnUnit&)const{}
  __device__ __forceinline__ void done(const AttnUnit&)const{}
};
template<class Sched,int THRL=8> __device__ __forceinline__ void attn_phase(char*lds,const AttnTensors&T,const Sched&S){
  AttnUnit u;
  for(int i=0;S.next(i,u);++i){ S.a_ready(u); attn_unit<THRL>(u.bh/NHEAD,u.bh%NHEAD,u.qb,T.Q,T.K,T.V,T.O,T.F+(size_t)u.bh*SEQ,lds); S.done(u); }
}
#undef SBAR
#undef WAIT_BAR
}

#define LAS __attribute__((address_space(3)))
#define GAS __attribute__((address_space(1)))
typedef unsigned short bf16;
typedef float f32x4 __attribute__((ext_vector_type(4)));
typedef unsigned v4u __attribute__((ext_vector_type(4)));
typedef unsigned v2u __attribute__((ext_vector_type(2)));
constexpr int NB_ = 2, SEQ = 8192, M = NB_ * SEQ, D = 1024, DIN = 2820, NPJ = 2816, NL = 4, NE = 32, TOPK = 4, CAP = pg8::MOE_CAP;
constexpr float LN_EPS = 1e-5f, ALPHA = 1.6817928305074290f  , LOG2E = 1.4426950408889634f;
constexpr int NWAVES = 8, NTHR = 512, LDS_BYTES = 147456, RING_BYTES = 131072, LDSCTL_OFF = RING_BYTES;
constexpr int C_RQ = 0, C_RK = 128, C_RV = 256, C_RG = 512, C_CA = 768, C_CB = 1024, C_SB = 1280, C_SC = 1536, C_SH = 1792, C_FQ = 2048, C_FK = 2304, C_FV = 2560, C_FF = 2816;

constexpr size_t MiB = 1u << 20;
constexpr size_t WS_CTL = 0, CTL_ZERO_BYTES = 1 * MiB;
constexpr size_t WS_ROPE = 1 * MiB;
constexpr size_t WS_LOGF = 2 * MiB;
constexpr size_t WS_F = 3 * MiB;
constexpr size_t WS_TK = 4 * MiB;
constexpr size_t WS_GATE = 6 * MiB;
constexpr size_t WS_WIN = 8 * MiB;
constexpr size_t WS_WO = 32 * MiB;
constexpr size_t WS_KV = 40 * MiB;
constexpr size_t WS_PREV = 48 * MiB;
constexpr size_t WS_XB = 64 * MiB;
constexpr size_t WS_X1B = 96 * MiB;
constexpr size_t WS_MIXED = 128 * MiB;
constexpr size_t WS_XF = 160 * MiB;
constexpr size_t WS_X1 = 224 * MiB;
constexpr size_t WS_MIX = 288 * MiB;
constexpr size_t WS_PROJ = 352 * MiB;
constexpr size_t WS_Y4 = 448 * MiB;
constexpr size_t WS_W1 = 576 * MiB;
constexpr size_t WS_W2 = 1088 * MiB;
constexpr size_t WS_ACT = 1344 * MiB;
constexpr size_t WS_END = 2368 * MiB;
constexpr int CW_CURSOR = 1024;
constexpr int CW_BAR = 4096;

__device__ __forceinline__ float bf2f(unsigned v) { return __uint_as_float(v << 16); }
__device__ __forceinline__ unsigned f2bf(float f) { unsigned u = __float_as_uint(f); return (u + 0x7fffu + ((u >> 16) & 1u)) >> 16; }
__device__ __forceinline__ unsigned pk2(float lo, float hi) { return f2bf(lo) | (f2bf(hi) << 16); }
#define LDS_WAIT() asm volatile("s_waitcnt lgkmcnt(0)" ::: "memory")
__device__ __forceinline__ float wave_sum(float v) {
#pragma unroll
    for (int o = 1; o < 64; o <<= 1) v += __shfl_xor(v, o);
    return v;
}
__device__ __forceinline__ float wave_max(float v) {
#pragma unroll
    for (int o = 1; o < 64; o <<= 1) v = fmaxf(v, __shfl_xor(v, o));
    return v;
}

struct Params {
    const float* in[20]; float* out; unsigned char* ws;
};

#define XB_TMO      128
#define XB_XCNT(j)  (256  + 64 * (j))
#define XB_XSUB(j)  (1280 + 64 * (j))
#define XB_XGEN(j)  (2304 + 64 * (j))
#define XB_TOP      3328
#define XB_TOPGEN   3392
#define XCD_BAR_WORDS 3456
#define XB_SPIN_CAP (1u << 18)

__device__ __forceinline__ unsigned xb_ld(unsigned* p)              { return __hip_atomic_load(p, __ATOMIC_RELAXED, __HIP_MEMORY_SCOPE_AGENT); }
__device__ __forceinline__ unsigned xb_add(unsigned* p, unsigned v) { return __hip_atomic_fetch_add(p, v, __ATOMIC_RELAXED, __HIP_MEMORY_SCOPE_AGENT); }
__device__ __forceinline__ unsigned xb_xcc_id() { return (unsigned)__builtin_amdgcn_s_getreg((3 << 11) | 20) & 0xFu; }
#define XB_SPIN(cond, bar) do { unsigned _sp = 0; while (cond) { __builtin_amdgcn_s_sleep(1); \
    if ((++_sp & 255u) == 0u) { if (xb_ld(&(bar)[XB_TMO])) break; if (_sp > XB_SPIN_CAP) { atomicAdd(&(bar)[XB_TMO], 1u); break; } } } } while (0)

struct XcdBarrier {
    unsigned* bar; unsigned x;
    volatile LAS unsigned* st;
};

__device__ __forceinline__ XcdBarrier xcd_barrier_post(unsigned* bar, volatile LAS unsigned* st) {
    XcdBarrier b; b.bar = bar; b.x = xb_xcc_id(); b.st = st;
    if (threadIdx.x == 0) (void)xb_add(&bar[XB_XCNT(b.x)], 1u);
    return b;
}
__device__ __forceinline__ void xcd_barrier_complete(unsigned* bar, unsigned x, unsigned& nloc, unsigned& nx) {
    const unsigned G = gridDim.x * gridDim.y * gridDim.z;
    unsigned sum, cnt, mine, sp = 0u;
    for (;;) {
        sum = 0u; cnt = 0u; mine = 0u;
#pragma unroll
        for (unsigned j = 0; j < 16; ++j) { const unsigned c = xb_ld(&bar[XB_XCNT(j)]); sum += c; cnt += (c > 0u) ? 1u : 0u; mine = (j == x) ? c : mine; }
        if (sum == G) break;
        __builtin_amdgcn_s_sleep(1);
        if ((++sp & 255u) == 0u) { if (xb_ld(&bar[XB_TMO])) break; if (sp > XB_SPIN_CAP) { atomicAdd(&bar[XB_TMO], 1u); break; } }
    }
    nloc = mine > 0u ? mine : 1u; nx = cnt > 0u ? cnt : 1u;
}

__device__ __forceinline__ void xcd_barrier(const XcdBarrier& b) {
    asm volatile("s_waitcnt vmcnt(0)" ::: "memory");
    __syncthreads();
    if (threadIdx.x == 0) {
        unsigned* bar = b.bar;
        __builtin_amdgcn_s_waitcnt(0);
        unsigned nloc = b.st[0], nx = b.st[1];
        if (nloc == 0u) { xcd_barrier_complete(bar, b.x, nloc, nx); b.st[0] = nloc; b.st[1] = nx; }
        const unsigned old = xb_add(&bar[XB_XSUB(b.x)], 1u);
        const unsigned gen = old / nloc;
        if (old + 1u == (gen + 1u) * nloc) {
            __builtin_amdgcn_fence(__ATOMIC_RELEASE, "agent");
            asm volatile("s_waitcnt vmcnt(0)" ::: "memory");
            const unsigned og = xb_add(&bar[XB_TOP], 1u);
            const unsigned tg = og / nx;
            if (og + 1u == (tg + 1u) * nx) xb_add(&bar[XB_TOPGEN], 1u);
            else XB_SPIN(xb_ld(&bar[XB_TOPGEN]) == tg, bar);
            __builtin_amdgcn_fence(__ATOMIC_ACQUIRE, "agent");
            xb_add(&bar[XB_XGEN(b.x)], 1u);
            asm volatile("s_waitcnt vmcnt(0)" ::: "memory");
        } else {
            XB_SPIN(xb_ld(&bar[XB_XGEN(b.x)]) == gen, bar);
            __builtin_amdgcn_fence(__ATOMIC_ACQUIRE, "agent");
            asm volatile("s_waitcnt vmcnt(0)" ::: "memory");
        }
    }
    __syncthreads();
}

__device__ __forceinline__ void transpose_item(const float* W, size_t ldw, bf16* WT, int Kd, int k0, int n0, int drow0, LAS float* scr, int lane) {
#pragma unroll 8
    for (int i = 0; i < 32; ++i) { const int kk = 2 * i + (lane >> 5); scr[kk * 33 + (lane & 31)] = W[(size_t)(k0 + kk) * ldw + n0 + (lane & 31)]; }
    LDS_WAIT(); asm volatile("" ::: "memory");
    const int c = lane & 7;
#pragma unroll
    for (int j = 0; j < 4; ++j) { const int n = (lane >> 3) + 8 * j; const LAS float* s = scr + (8 * c) * 33 + n;
        v4u o; o.x = pk2(s[0 * 33], s[1 * 33]); o.y = pk2(s[2 * 33], s[3 * 33]); o.z = pk2(s[4 * 33], s[5 * 33]); o.w = pk2(s[6 * 33], s[7 * 33]);
        *(GAS v4u*)(WT + (size_t)(drow0 + n) * Kd + k0 + 8 * c) = o; }
    LDS_WAIT(); asm volatile("" ::: "memory");
}
__device__ __forceinline__ float log_sigmoid(float z) { return fminf(z, 0.f) - log1pf(expf(-fabsf(z))); }
__device__ __forceinline__ void row_logf(const f32x4 (&v)[4], const float* w_in_l, const float* fox_b_l, float* logf_row, int lane) {
    float a0 = 0.f, a1 = 0.f, a2 = 0.f, a3 = 0.f;
#pragma unroll
    for (int j = 0; j < 4; ++j)
#pragma unroll
        for (int q = 0; q < 4; ++q) { const int k = 256 * j + 4 * lane + q; const f32x4 w = *(const f32x4*)(w_in_l + (size_t)k * DIN + C_FF); const float xv = v[j][q];
            a0 += xv * w[0]; a1 += xv * w[1]; a2 += xv * w[2]; a3 += xv * w[3]; }
    a0 = wave_sum(a0); a1 = wave_sum(a1); a2 = wave_sum(a2); a3 = wave_sum(a3);
    if (lane == 0) { f32x4 o; o[0] = log_sigmoid(a0 + fox_b_l[0]); o[1] = log_sigmoid(a1 + fox_b_l[1]); o[2] = log_sigmoid(a2 + fox_b_l[2]); o[3] = log_sigmoid(a3 + fox_b_l[3]); *(f32x4*)logf_row = o; }
}
__device__ __forceinline__ void phase_prologue(const Params& p, LAS unsigned char* lds, const int G, const int blk) {
    const int tid = tid_fresh(), lane = tid & 63, wave = tid >> 6;
    LAS float* scr = (LAS float*)((LAS unsigned char*)lds + wave * 16384);
    const int gw = blk * NWAVES + wave, NGW = G * NWAVES;
    unsigned char* ws = p.ws;
    constexpr int I_IN = 16 * 88, I_O = 16 * 32, I_W1 = 32 * 16 * 64, I_W2 = 32 * 16 * 32, I_L = I_IN + I_O + I_W1 + I_W2;
    for (int it = gw; it < NL * I_L; it += NGW) {
        const int l = it / I_L; int r = it % I_L;
        if (r < I_IN) { const int kb = r / 88, nb = r % 88; transpose_item(p.in[1] + (size_t)l * D * DIN, DIN, (bf16*)(ws + WS_WIN) + (size_t)l * NPJ * D, D, 64 * kb, 32 * nb, 32 * nb, scr, lane); continue; } r -= I_IN;
        if (r < I_O) { const int kb = r / 32, nb = r % 32; transpose_item(p.in[9] + (size_t)l * D * D, D, (bf16*)(ws + WS_WO) + (size_t)l * D * D, D, 64 * kb, 32 * nb, 32 * nb, scr, lane); continue; } r -= I_O;
        if (r < I_W1) { const int e = r / 1024, q = r % 1024, kb = q / 64, nb = q % 64, n0 = 32 * nb, s = n0 >> 10, c0 = n0 & 1023, drow0 = 256 * (c0 >> 7) + 128 * s + (c0 & 127);
            transpose_item(p.in[14] + ((size_t)l * NE + e) * D * 2048, 2048, (bf16*)(ws + WS_W1) + ((size_t)l * NE + e) * 2048 * D, D, 64 * kb, n0, drow0, scr, lane); continue; } r -= I_W1;
        { const int e = r / 512, q = r % 512, kb = q / 32, nb = q % 32;
            transpose_item(p.in[16] + ((size_t)l * NE + e) * D * D, D, (bf16*)(ws + WS_W2) + ((size_t)l * NE + e) * D * D, D, 64 * kb, 32 * nb, 32 * nb, scr, lane); }
    }
    for (int idx = blk * NTHR + tid; idx < SEQ * 16; idx += G * NTHR) { const int pos = idx >> 4, i = idx & 15;
        const float freq = powf(10000.0f, -(float)i / 16.0f); const float ang = (float)pos * freq; const double a = (double)ang;
        float* cs = (float*)(ws + WS_ROPE) + 2 * idx; cs[0] = (float)cos(a); cs[1] = (float)sin(a); }
    for (int m = gw; m < M; m += NGW) {
        const GAS f32x4* xr = (const GAS f32x4*)(p.in[0] + (size_t)m * D) + lane; f32x4 v[4];
#pragma unroll
        for (int j = 0; j < 4; ++j) v[j] = xr[64 * j];
        GAS v2u* o8 = (GAS v2u*)((bf16*)(ws + WS_XB) + (size_t)m * D) + lane;
#pragma unroll
        for (int j = 0; j < 4; ++j) { v2u w; w.x = pk2(v[j][0], v[j][1]); w.y = pk2(v[j][2], v[j][3]); o8[64 * j] = w; }
        row_logf(v, p.in[1], p.in[2], (float*)(ws + WS_LOGF) + (size_t)m * 4, lane);
    }
}

struct EpiProj {
    static constexpr bool PERM = true, AFTER_DRAIN = false;
    bf16* O;
    __device__ __forceinline__ void operator()(const pg8::f32x4 (&acc)[2][2][4][2], const pg8::Unit& u, int wr, int wc, int fr, int fq) const {
        const float sc = (u.pn == 8) ? attn_body::C2 : 1.0f;
        bf16* base = O + (size_t)(u.pm * 256 + wr * 64 + fr) * NPJ + u.pn * 256 + wc * 32 + 8 * fq;
#pragma unroll
        for (int ai = 0; ai < 2; ++ai)
#pragma unroll
            for (int m = 0; m < 4; ++m)
#pragma unroll
                for (int bj = 0; bj < 2; ++bj) { const pg8::f32x4 v0 = acc[ai][bj][m][0] * sc, v1 = acc[ai][bj][m][1] * sc;
                    pg8::u32x4 w; w.x = pg8::cvt_pk_bf16(v0[0], v0[1]); w.y = pg8::cvt_pk_bf16(v0[2], v0[3]); w.z = pg8::cvt_pk_bf16(v1[0], v1[1]); w.w = pg8::cvt_pk_bf16(v1[2], v1[3]);
                    *(pg8::u32x4*)(base + (size_t)(ai * 128 + m * 16) * NPJ + bj * 128) = w; }
    }
};
__device__ __forceinline__ void phase_attn(const Params& p, LAS unsigned char* lds, const int G, const int blk) {
    const bf16* proj = (const bf16*)(p.ws + WS_PROJ);
    const attn_body::AttnTensors AT{(const attn_body::bf16*)(proj + C_FQ), (const attn_body::bf16*)(proj + C_FK), (const attn_body::bf16*)(proj + C_FV), (attn_body::bf16*)((bf16*)(p.ws + WS_MIXED) + 768), (const float*)(p.ws + WS_F)};
    const attn_body::StaticOrder S(G, blk);
    attn_body::attn_phase<attn_body::StaticOrder>((char*)lds, AT, S);
}
__device__ __forceinline__ void phase_inproj(const Params& p, int l, LAS unsigned char* lds, const int G, const int blk) {
    pg8::Gemm g{(const bf16*)(p.ws + WS_XB), (const bf16*)(p.ws + WS_WIN) + (size_t)l * NPJ * D, M, NPJ, D}; pg8::StaticOrder S; S.init(M, NPJ, G, (int)blk);
    EpiProj E{(bf16*)(p.ws + WS_PROJ)};
    pg8::gemm_phase<EpiProj, pg8::StaticOrder, true, true>((LAS unsigned char*)lds, g, S, E);
}
__device__ __forceinline__ void phase_outproj(const Params& p, int l, LAS unsigned char* lds, const int G, const int blk) {
    pg8::Gemm g{(const bf16*)(p.ws + WS_MIXED), (const bf16*)(p.ws + WS_WO) + (size_t)l * D * D, M, D, D}; pg8::StaticOrder S; S.init(M, D, G, (int)blk);
    pg8::EpiF32 E{(float*)(p.ws + WS_MIX), D, nullptr};
    pg8::gemm_phase<pg8::EpiF32, pg8::StaticOrder, true, true>((LAS unsigned char*)lds, g, S, E);
}
__device__ __forceinline__ void moe_table(LAS int* tp, LAS int* cnt, const unsigned* cursor) {
    const int tidm = tid_fresh();
    if (tidm < 32) cnt[tidm] = (int)__hip_atomic_load(cursor + tidm, __ATOMIC_RELAXED, __HIP_MEMORY_SCOPE_AGENT);
    __syncthreads();
    if (tidm == 0) { int s = 0; for (int e = 0; e < 32; ++e) { tp[e] = s; s += (cnt[e] + 255) >> 8; } tp[32] = s; }
    __syncthreads();
}
__device__ __forceinline__ void phase_gemm1(const Params& p, int l, LAS unsigned char* lds, const int G, const int blk) {
    LAS int* tp = (LAS int*)((LAS unsigned char*)lds + LDSCTL_OFF + 1024); LAS int* cnt = tp + 64;
    moe_table(tp, cnt, (const unsigned*)(p.ws + WS_CTL) + CW_CURSOR + 32 * l);
    pg8::MoeSched S{tp, cnt, 8, G, blk};
    pg8::EpiSwiglu E{(bf16*)(p.ws + WS_ACT), p.in[15] + (size_t)l * NE * 2048};
    pg8::gemm_phase_moe<pg8::EpiSwiglu, true>((LAS unsigned char*)lds, (const bf16*)(p.ws + WS_X1B), (const bf16*)(p.ws + WS_W1) + (size_t)l * NE * 2048 * D, D, 2048, (const int*)(p.ws + WS_TK), S, E);
}
__device__ __forceinline__ void phase_gemm2(const Params& p, int l, LAS unsigned char* lds, const int G, const int blk) {
    LAS int* tp = (LAS int*)((LAS unsigned char*)lds + LDSCTL_OFF + 1024); LAS int* cnt = tp + 64;
    moe_table(tp, cnt, (const unsigned*)(p.ws + WS_CTL) + CW_CURSOR + 32 * l);
    pg8::MoeSched S{tp, cnt, 4, G, blk};
    pg8::EpiGateScatter E{(bf16*)(p.ws + WS_Y4), p.in[17] + (size_t)l * NE * D, (const int*)(p.ws + WS_TK), (const float*)(p.ws + WS_GATE)};
    pg8::gemm_phase_moe<pg8::EpiGateScatter, false>((LAS unsigned char*)lds, (const bf16*)(p.ws + WS_ACT), (const bf16*)(p.ws + WS_W2) + (size_t)l * NE * D * D, D, 1024, nullptr, S, E);
}

__device__ __forceinline__ void phase_fscan(const Params& p, LAS unsigned char* lds, const int G, const int blk) {
    LAS float* wtot = (LAS float*)lds;
    if (blk >= NB_ * 4) return;
    const int bh = blk, b = bh >> 2, h = bh & 3, tid = tid_fresh(), lane = tid & 63, wave = tid >> 6;
    const float* lf = (const float*)(p.ws + WS_LOGF) + ((size_t)b * SEQ + 16 * tid) * 4 + h;
    float v[16]; float s = 0.f;
#pragma unroll
    for (int j = 0; j < 16; ++j) { s += lf[4 * j]; v[j] = s; }
    float inc = s;
#pragma unroll
    for (int o = 1; o < 64; o <<= 1) { const float t = __shfl_up(inc, o); if (lane >= o) inc += t; }
    if (lane == 63) wtot[wave] = inc;
    __syncthreads();
    float base = inc - s;
    for (int w = 0; w < wave; ++w) base += wtot[w];
    float* F = (float*)(p.ws + WS_F) + (size_t)bh * SEQ + 16 * tid;
#pragma unroll
    for (int j = 0; j < 16; ++j) F[j] = base + v[j];
}
__device__ __forceinline__ void phase_conv(const Params& p, int l, LAS unsigned char* lds, const int G, const int blk) {
    LAS float (*red)[2] = (LAS float (*)[2])(lds + 256);
    const int tid = tid_fresh(), lane = tid & 63, wave = tid >> 6, c = tid & 255, sub = tid >> 8;
    const bf16* proj = (const bf16*)(p.ws + WS_PROJ); bf16* mixed = (bf16*)(p.ws + WS_MIXED);
    const float* dw = p.in[3] + (size_t)l * 31 * 256; const float dwb = p.in[4][l * 256 + c], lg = p.in[5][l * 256 + c], lb = p.in[6][l * 256 + c];
    const float* sw = p.in[7] + (size_t)l * 3 * 256;
    for (int tp = blk * 2; tp < M; tp += G * 2) {
        const int t = tp + sub, pos = t & (SEQ - 1);
        float acc = dwb;
        for (int j = 0; j < 31; ++j) { const int sp = pos - 30 + j; if (sp >= 0) { const size_t r = (size_t)(t - 30 + j) * NPJ;
            const float a = bf2f(proj[r + C_CA + c]), bg = bf2f(proj[r + C_CB + c]); acc += dw[j * 256 + c] * (a / (1.0f + expf(-bg))); } }
        float s1 = wave_sum(acc); if (lane == 0) red[wave][0] = s1;
        __syncthreads();
        const int w0 = sub * 4; const float mean = (red[w0][0] + red[w0 + 1][0] + red[w0 + 2][0] + red[w0 + 3][0]) * (1.0f / 256.0f);
        const float d = acc - mean; float s2 = wave_sum(d * d); if (lane == 0) red[wave][1] = s2;
        __syncthreads();
        const float var = (red[w0][1] + red[w0 + 1][1] + red[w0 + 2][1] + red[w0 + 3][1]) * (1.0f / 256.0f);
        const float y = d * rsqrtf(var + LN_EPS) * lg + lb;
        mixed[(size_t)t * D + 256 + c] = (bf16)f2bf(y / (1.0f + expf(-y)));
        float sacc = 0.f;
        for (int j = 0; j < 3; ++j) { const int sp = pos - 2 + j; if (sp >= 0) { const size_t r = (size_t)(t - 2 + j) * NPJ; sacc += sw[j * 256 + c] * (bf2f(proj[r + C_SC + c]) * bf2f(proj[r + C_SH + c])); } }
        mixed[(size_t)t * D + 512 + c] = (bf16)f2bf(bf2f(proj[(size_t)t * NPJ + C_SB + c]) * sacc);
    }
}
namespace ret {
typedef short bf16x8 __attribute__((ext_vector_type(8)));
typedef short bf16x4 __attribute__((ext_vector_type(4)));
typedef float f32x16 __attribute__((ext_vector_type(16)));
constexpr int QP = 40, VP = 68, KTP = 72;
constexpr int PAIR_BYTES = 24576;
constexpr int OFF_Q = 0, OFF_K = 5120, OFF_V = 10240, OFF_P = 18944, OFF_KT = 0;
constexpr int WS_KV_FLOATS = NB_ * 128 * 4 * 2048;
__device__ __forceinline__ int crow(int r, int hi) { return (r & 3) + 8 * (r >> 2) + 4 * hi; }
__device__ __forceinline__ float lg2_gamma(int h) { return log2f(1.0f - exp2f(-5.0f - (float)h)); }
__device__ __forceinline__ void rope8(const bf16* src, const float* cs, int dd0, float sc, float (&o1)[8], float (&o2)[8]) {
    const v4u lo = *(const v4u*)(src + dd0), hi = *(const v4u*)(src + 16 + dd0);
    const f32x4 c0 = *(const f32x4*)(cs), c1 = *(const f32x4*)(cs + 4), c2 = *(const f32x4*)(cs + 8), c3 = *(const f32x4*)(cs + 12);
    const float cv[16] = {c0[0], c0[1], c0[2], c0[3], c1[0], c1[1], c1[2], c1[3], c2[0], c2[1], c2[2], c2[3], c3[0], c3[1], c3[2], c3[3]};
    const unsigned lw[4] = {lo.x, lo.y, lo.z, lo.w}, hw[4] = {hi.x, hi.y, hi.z, hi.w};
#pragma unroll
    for (int i = 0; i < 8; ++i) { const float x1 = (i & 1) ? bf2f(lw[i >> 1] >> 16) : bf2f(lw[i >> 1] & 0xffffu), x2 = (i & 1) ? bf2f(hw[i >> 1] >> 16) : bf2f(hw[i >> 1] & 0xffffu);
        const float c = cv[2 * i], s = cv[2 * i + 1]; o1[i] = (x1 * c - x2 * s) * sc; o2[i] = (x1 * s + x2 * c) * sc; }
}
__device__ __forceinline__ void stage_vt(const bf16* proj, size_t row0, int h, LAS bf16* Vt, int tp) {
    const int m = tp >> 1, e0 = (tp & 1) * 32; const bf16* src = proj + (row0 + m) * NPJ + C_RV + h * 64 + e0;
#pragma unroll
    for (int q = 0; q < 4; ++q) { const v4u w = *(const v4u*)(src + 8 * q); const unsigned ww[4] = {w.x, w.y, w.z, w.w};
#pragma unroll
        for (int i = 0; i < 8; ++i) Vt[(e0 + 8 * q + i) * VP + m] = (bf16)((i & 1) ? (ww[i >> 1] >> 16) : (ww[i >> 1] & 0xffffu)); }
}
__device__ __forceinline__ bf16x8 ld_vt8(const LAS bf16* p) {
    const bf16x4 a = *(const LAS bf16x4*)p, b = *(const LAS bf16x4*)(p + 4); return (bf16x8){a[0], a[1], a[2], a[3], b[0], b[1], b[2], b[3]};
}
__device__ __forceinline__ void phase_kv(const Params& p, LAS unsigned char* lds, int nblk, int blk) {
    const int tid = tid_fresh(), lane = tid & 63, wave = tid >> 6, pw = wave >> 1, sw = wave & 1, tp = tid & 127, r32 = lane & 31, hi = lane >> 5;
    const bf16* proj = (const bf16*)(p.ws + WS_PROJ); const float* rope = (const float*)(p.ws + WS_ROPE); float* kvT = (float*)(p.ws + WS_KV);
    LAS unsigned char* base = lds + pw * PAIR_BYTES; LAS bf16* KdT = (LAS bf16*)(base + OFF_KT); LAS bf16* Vt = (LAS bf16*)(base + OFF_V);
    for (int u0 = blk * 4; u0 < NB_ * 128 * 4; u0 += nblk * 4) {
        const int unit = u0 + pw, h = unit & 3, bc = unit >> 2, c = bc & 127, b = bc >> 7; const size_t row0 = (size_t)b * SEQ + 64 * c;
        const float lg = lg2_gamma(h);
        { const int m = tp >> 1, dd0 = (tp & 1) * 8; float o1[8], o2[8];
          rope8(proj + (row0 + m) * NPJ + C_RK + h * 32, rope + ((size_t)(64 * c + m) * 16 + dd0) * 2, dd0, 0.17677669529663687f * exp2f(lg * (float)(63 - m)), o1, o2);
#pragma unroll
          for (int i = 0; i < 8; ++i) { KdT[(dd0 + i) * KTP + m] = (bf16)f2bf(o1[i]); KdT[(16 + dd0 + i) * KTP + m] = (bf16)f2bf(o2[i]); } }
        stage_vt(proj, row0, h, Vt, tp);
        __syncthreads();
        f32x16 acc = {};
#pragma unroll
        for (int ks = 0; ks < 4; ++ks) { const bf16x8 a = ld_vt8(Vt + (32 * sw + r32) * VP + 16 * ks + 8 * hi); const bf16x8 bq = *(const LAS bf16x8*)(KdT + r32 * KTP + 16 * ks + 8 * hi);
            acc = __builtin_amdgcn_mfma_f32_32x32x16_bf16(a, bq, acc, 0, 0, 0); }
        float* dst = kvT + (size_t)unit * 2048 + r32;
#pragma unroll
        for (int r = 0; r < 16; ++r) dst[(32 * sw + crow(r, hi)) * 32] = acc[r];
        __syncthreads();
    }
}
__device__ __forceinline__ void phase_scan(const Params& p, LAS unsigned char* lds, int nblk, int blk) {
    const int tid = tid_fresh(), elem = tid & 63, seg = tid >> 6;
    const float* kvT = (const float*)(p.ws + WS_KV); bf16* prevT = (bf16*)(p.ws + WS_PREV); LAS float* agg = (LAS float*)lds;
    for (int blkid = blk; blkid < 256; blkid += nblk) {
        const int bh = blkid >> 5, b = bh >> 2, h = bh & 3, el = (blkid & 31) * 64 + elem;
        const float Dk = exp2f(64.0f * lg2_gamma(h));
        float kv[16];
#pragma unroll
        for (int j = 0; j < 16; ++j) kv[j] = kvT[((size_t)((b * 128 + 16 * seg + j) * 4 + h)) * 2048 + el];
        float loc[17]; loc[0] = 0.f;
#pragma unroll
        for (int j = 0; j < 16; ++j) loc[j + 1] = Dk * loc[j] + kv[j];
        agg[seg * 64 + elem] = loc[16];
        __syncthreads();
        const float D16 = exp2f(1024.0f * lg2_gamma(h)); float sin_ = 0.f;
        for (int s2 = 0; s2 < seg; ++s2) sin_ = D16 * sin_ + agg[s2 * 64 + elem];
        float dj = 1.0f;
#pragma unroll
        for (int j = 0; j < 16; ++j) { prevT[((size_t)((b * 128 + 16 * seg + j) * 4 + h)) * 2048 + el] = (bf16)f2bf(dj * sin_ + loc[j]); dj *= Dk; }
        __syncthreads();
    }
}
__device__ __forceinline__ void phase_out(const Params& p, int l, LAS unsigned char* lds, int nblk, int blk) {
    const int tid = tid_fresh(), lane = tid & 63, wave = tid >> 6, pw = wave >> 1, sw = wave & 1, tp = tid & 127, r32 = lane & 31, hi = lane >> 5;
    const bf16* proj = (const bf16*)(p.ws + WS_PROJ); const float* rope = (const float*)(p.ws + WS_ROPE); const bf16* prevT = (const bf16*)(p.ws + WS_PREV); bf16* mixed = (bf16*)(p.ws + WS_MIXED);
    const float* gng = p.in[8] + l * 256;
    LAS unsigned char* base = lds + pw * PAIR_BYTES; LAS bf16* Qs = (LAS bf16*)(base + OFF_Q); LAS bf16* Ks = (LAS bf16*)(base + OFF_K); LAS bf16* Vt = (LAS bf16*)(base + OFF_V); LAS bf16* Ps = (LAS bf16*)(base + OFF_P);
    for (int u0 = blk * 4; u0 < NB_ * 128 * 4; u0 += nblk * 4) {
        const int unit = u0 + pw, h = unit & 3, bc = unit >> 2, c = bc & 127, b = bc >> 7; const size_t row0 = (size_t)b * SEQ + 64 * c;
        const float lg = lg2_gamma(h);
        { const int m = tp >> 1, dd0 = (tp & 1) * 8; float o1[8], o2[8]; const float* cs = rope + ((size_t)(64 * c + m) * 16 + dd0) * 2;
          rope8(proj + (row0 + m) * NPJ + C_RQ + h * 32, cs, dd0, 1.0f, o1, o2);
          v4u w; w.x = pk2(o1[0], o1[1]); w.y = pk2(o1[2], o1[3]); w.z = pk2(o1[4], o1[5]); w.w = pk2(o1[6], o1[7]); *(LAS v4u*)(Qs + m * QP + dd0) = w;
          w.x = pk2(o2[0], o2[1]); w.y = pk2(o2[2], o2[3]); w.z = pk2(o2[4], o2[5]); w.w = pk2(o2[6], o2[7]); *(LAS v4u*)(Qs + m * QP + 16 + dd0) = w;
          rope8(proj + (row0 + m) * NPJ + C_RK + h * 32, cs, dd0, 0.17677669529663687f, o1, o2);
          w.x = pk2(o1[0], o1[1]); w.y = pk2(o1[2], o1[3]); w.z = pk2(o1[4], o1[5]); w.w = pk2(o1[6], o1[7]); *(LAS v4u*)(Ks + m * QP + dd0) = w;
          w.x = pk2(o2[0], o2[1]); w.y = pk2(o2[2], o2[3]); w.z = pk2(o2[4], o2[5]); w.w = pk2(o2[6], o2[7]); *(LAS v4u*)(Ks + m * QP + 16 + dd0) = w;
          const bf16* ps = prevT + (size_t)unit * 2048 + (tp >> 1) * 32 + (tp & 1) * 16; const v4u p0 = *(const v4u*)ps, p1 = *(const v4u*)(ps + 8);
          *(LAS v4u*)(Ps + (tp >> 1) * QP + (tp & 1) * 16) = p0; *(LAS v4u*)(Ps + (tp >> 1) * QP + (tp & 1) * 16 + 8) = p1; }
        stage_vt(proj, row0, h, Vt, tp);
        __syncthreads();
        const int n = 32 * sw + r32;
        bf16x8 qf[2];
#pragma unroll
        for (int s = 0; s < 2; ++s) qf[s] = *(const LAS bf16x8*)(Qs + n * QP + 16 * s + 8 * hi);
        f32x16 acc[2];
#pragma unroll
        for (int eb = 0; eb < 2; ++eb) { acc[eb] = (f32x16){};
#pragma unroll
            for (int s = 0; s < 2; ++s) { const bf16x8 a = *(const LAS bf16x8*)(Ps + (32 * eb + r32) * QP + 16 * s + 8 * hi); acc[eb] = __builtin_amdgcn_mfma_f32_32x32x16_bf16(a, qf[s], acc[eb], 0, 0, 0); } }
        const float qd = exp2f(lg * (float)(n + 1));
#pragma unroll
        for (int eb = 0; eb < 2; ++eb)
#pragma unroll
            for (int r = 0; r < 16; ++r) acc[eb][r] *= qd;
#pragma unroll
        for (int mb = 0; mb < 2; ++mb) {
            f32x16 st = {};
#pragma unroll
            for (int s = 0; s < 2; ++s) { const bf16x8 a = *(const LAS bf16x8*)(Ks + (32 * mb + r32) * QP + 16 * s + 8 * hi); st = __builtin_amdgcn_mfma_f32_32x32x16_bf16(a, qf[s], st, 0, 0, 0); }
#pragma unroll
            for (int r = 0; r < 16; ++r) { const int m = 32 * mb + crow(r, hi); const int dist = n > m ? n - m : m - n; st[r] *= exp2f(lg * (float)dist); }
#pragma unroll
            for (int pp = 0; pp < 2; ++pp) {
                v4u pk; pk.x = pk2(st[8 * pp + 0], st[8 * pp + 1]); pk.y = pk2(st[8 * pp + 2], st[8 * pp + 3]); pk.z = pk2(st[8 * pp + 4], st[8 * pp + 5]); pk.w = pk2(st[8 * pp + 6], st[8 * pp + 7]);
                const bf16x8 pf = __builtin_bit_cast(bf16x8, pk);
#pragma unroll
                for (int eb = 0; eb < 2; ++eb) { const LAS bf16* vp = Vt + (32 * eb + r32) * VP + 32 * mb + 16 * pp + 4 * hi;
                    const bf16x4 a0 = *(const LAS bf16x4*)vp, a1 = *(const LAS bf16x4*)(vp + 8); const bf16x8 af = (bf16x8){a0[0], a0[1], a0[2], a0[3], a1[0], a1[1], a1[2], a1[3]};
                    acc[eb] = __builtin_amdgcn_mfma_f32_32x32x16_bf16(af, pf, acc[eb], 0, 0, 0); } }
        }
        float s1 = 0.f;
#pragma unroll
        for (int eb = 0; eb < 2; ++eb)
#pragma unroll
            for (int r = 0; r < 16; ++r) s1 += acc[eb][r];
        s1 += __shfl_xor(s1, 32); const float mean = s1 * (1.0f / 64.0f); float s2 = 0.f;
#pragma unroll
        for (int eb = 0; eb < 2; ++eb)
#pragma unroll
            for (int r = 0; r < 16; ++r) { const float d = acc[eb][r] - mean; s2 += d * d; }
        s2 += __shfl_xor(s2, 32); const float rstd = rsqrtf(s2 * (1.0f / 64.0f) + LN_EPS);
        const size_t trow = row0 + n;
#pragma unroll
        for (int eb = 0; eb < 2; ++eb)
#pragma unroll
            for (int g = 0; g < 4; ++g) { const int e0 = 32 * eb + 8 * g + 4 * hi; const f32x4 gn = *(const f32x4*)(gng + h * 64 + e0);
                const v2u gw = *(const v2u*)(proj + trow * NPJ + C_RG + h * 64 + e0); const float gt[4] = {bf2f(gw.x & 0xffffu), bf2f(gw.x >> 16), bf2f(gw.y & 0xffffu), bf2f(gw.y >> 16)}; float y[4];
#pragma unroll
                for (int q = 0; q < 4; ++q) { const float sg = gt[q] / (1.0f + __expf(-gt[q])); y[q] = (acc[eb][4 * g + q] - mean) * rstd * gn[q] * sg; }
                v2u o; o.x = pk2(y[0], y[1]); o.y = pk2(y[2], y[3]); *(v2u*)(mixed + trow * D + h * 64 + e0) = o; }
        __syncthreads();
    }
}
}

__device__ __forceinline__ void phase_ln1_router(const Params& p, int l, LAS unsigned char* lds, const int G, const int blk) {
    const int tid = tid_fresh(), lane = tid & 63, wave = tid >> 6;
    LAS float* yrow = (LAS float*)((LAS unsigned char*)lds + wave * 8192);
    LAS int* sel_e = (LAS int*)((LAS unsigned char*)lds + 65536); LAS float* sel_g = (LAS float*)((LAS unsigned char*)lds + 65536 + 1024);
    LAS int* wcnt = (LAS int*)((LAS unsigned char*)lds + 65536 + 2048);
    LAS int* ebase = (LAS int*)((LAS unsigned char*)lds + 65536 + 2048 + 512);
    const float* xin = (l == 0) ? p.in[0] : (const float*)(p.ws + WS_XF);
    const float* mix = (const float*)(p.ws + WS_MIX);
    float* x1 = (float*)(p.ws + WS_X1); bf16* x1b = (bf16*)(p.ws + WS_X1B);
    const float* g1 = p.in[10] + l * D; const float* b1 = p.in[11] + l * D;
    const float* Wr = p.in[12] + (size_t)l * D * NE; const float* rb = p.in[13] + l * NE;
    unsigned* cursor = (unsigned*)(p.ws + WS_CTL) + CW_CURSOR + 32 * l;
    for (int t0 = blk * 64; t0 < M; t0 += G * 64) {
        for (int pair = 0; pair < 4; ++pair) {
#pragma unroll
            for (int r2 = 0; r2 < 2; ++r2) { const int t = t0 + wave * 8 + pair * 2 + r2;
                const GAS f32x4* xr = (const GAS f32x4*)(xin + (size_t)t * D) + lane; const GAS f32x4* mr = (const GAS f32x4*)(mix + (size_t)t * D) + lane;
                f32x4 v[4]; float s = 0.f;
#pragma unroll
                for (int j = 0; j < 4; ++j) { v[j] = xr[64 * j] * ALPHA + mr[64 * j]; s += (v[j][0] + v[j][1]) + (v[j][2] + v[j][3]); }
                const float mean = wave_sum(s) * (1.0f / D); float s2 = 0.f;
#pragma unroll
                for (int j = 0; j < 4; ++j) { v[j] = v[j] - mean; s2 += (v[j][0] * v[j][0] + v[j][1] * v[j][1]) + (v[j][2] * v[j][2] + v[j][3] * v[j][3]); }
                const float rstd = rsqrtf(wave_sum(s2) * (1.0f / D) + LN_EPS);
#pragma unroll
                for (int j = 0; j < 4; ++j) { const f32x4 gg = *(const f32x4*)(g1 + 256 * j + 4 * lane), bb = *(const f32x4*)(b1 + 256 * j + 4 * lane); const f32x4 y = v[j] * rstd * gg + bb;
                    ((GAS f32x4*)(x1 + (size_t)t * D))[64 * j + lane] = y; v2u w; w.x = pk2(y[0], y[1]); w.y = pk2(y[2], y[3]); ((GAS v2u*)(x1b + (size_t)t * D))[64 * j + lane] = w;
                    *(LAS f32x4*)(yrow + r2 * 1024 + 256 * j + 4 * lane) = y; } }
            LDS_WAIT(); asm volatile("" ::: "memory");
            const int e = lane & 31, kh = lane >> 5; float a0 = 0.f, a1 = 0.f;
            for (int k = kh * 512; k < kh * 512 + 512; ++k) { const float w = Wr[(size_t)k * NE + e]; a0 += yrow[k] * w; a1 += yrow[1024 + k] * w; }
            a0 += __shfl_xor(a0, 32); a1 += __shfl_xor(a1, 32);
            a0 += rb[e]; a1 += rb[e];
#pragma unroll
            for (int r2 = 0; r2 < 2; ++r2) { float val = (lane < 32) ? (r2 ? a1 : a0) : -INFINITY; float tv[4]; int ti[4];
#pragma unroll
                for (int r = 0; r < 4; ++r) { const float mxv = wave_max(val); const unsigned long long bal = __ballot(val == mxv); const int who = __ffsll((long long)bal) - 1; tv[r] = mxv; ti[r] = who; if (lane == who) val = -INFINITY; }
                const float e1 = expf(tv[1] - tv[0]), e2 = expf(tv[2] - tv[0]), e3 = expf(tv[3] - tv[0]); const float inv = 1.0f / (1.0f + e1 + e2 + e3);
                const int tl = wave * 8 + pair * 2 + r2;
                if (lane == 0) { sel_e[tl * 4 + 0] = ti[0]; sel_e[tl * 4 + 1] = ti[1]; sel_e[tl * 4 + 2] = ti[2]; sel_e[tl * 4 + 3] = ti[3];
                    sel_g[tl * 4 + 0] = inv; sel_g[tl * 4 + 1] = e1 * inv; sel_g[tl * 4 + 2] = e2 * inv; sel_g[tl * 4 + 3] = e3 * inv; } }
            LDS_WAIT(); asm volatile("" ::: "memory");
        }
        __syncthreads();
        int mye = 0, myrank = 0;
        if (wave < 4) { mye = sel_e[tid];
            for (int e2 = 0; e2 < 32; ++e2) { const unsigned long long bal = __ballot(mye == e2); if (mye == e2) myrank = __popcll(bal & ((1ull << lane) - 1ull)); if (lane == 0) wcnt[wave * 32 + e2] = __popcll(bal); } }
        __syncthreads();
        if (tid < 32) { const int tot = wcnt[tid] + wcnt[32 + tid] + wcnt[64 + tid] + wcnt[96 + tid]; ebase[tid] = tot ? (int)atomicAdd(cursor + tid, (unsigned)tot) : 0; }
        __syncthreads();
        if (wave < 4) { int pos = ebase[mye] + myrank; for (int w = 0; w < wave; ++w) pos += wcnt[w * 32 + mye];
            ((int*)(p.ws + WS_TK))[(size_t)mye * CAP + pos] = t0 * 4 + tid; ((float*)(p.ws + WS_GATE))[(size_t)mye * CAP + pos] = sel_g[tid]; }
        __syncthreads();
    }
}
__device__ __forceinline__ void phase_ln2(const Params& p, int l, LAS unsigned char* lds, const int G, const int blk) {
    const int tid = tid_fresh(), lane = tid & 63, wave = tid >> 6;
    const int gw = blk * NWAVES + wave, NGW = G * NWAVES;
    const float* x1 = (const float*)(p.ws + WS_X1); const bf16* y4 = (const bf16*)(p.ws + WS_Y4);
    float* xo = (l == NL - 1) ? p.out : (float*)(p.ws + WS_XF); bf16* xb = (bf16*)(p.ws + WS_XB);
    const float* g2 = p.in[18] + l * D; const float* b2 = p.in[19] + l * D;
    for (int t = gw; t < M; t += NGW) {
        f32x4 v[4]; float s = 0.f;
#pragma unroll
        for (int j = 0; j < 4; ++j) { v[j] = ((const GAS f32x4*)(x1 + (size_t)t * D))[64 * j + lane] * ALPHA;
#pragma unroll
            for (int k = 0; k < 4; ++k) { const v2u w = ((const GAS v2u*)(y4 + ((size_t)t * 4 + k) * D))[64 * j + lane];
                v[j][0] += bf2f(w.x & 0xffffu); v[j][1] += bf2f(w.x >> 16); v[j][2] += bf2f(w.y & 0xffffu); v[j][3] += bf2f(w.y >> 16); }
            s += (v[j][0] + v[j][1]) + (v[j][2] + v[j][3]); }
        const float mean = wave_sum(s) * (1.0f / D); float s2 = 0.f;
#pragma unroll
        for (int j = 0; j < 4; ++j) { v[j] = v[j] - mean; s2 += (v[j][0] * v[j][0] + v[j][1] * v[j][1]) + (v[j][2] * v[j][2] + v[j][3] * v[j][3]); }
        const float rstd = rsqrtf(wave_sum(s2) * (1.0f / D) + LN_EPS);
#pragma unroll
        for (int j = 0; j < 4; ++j) { const f32x4 gg = *(const f32x4*)(g2 + 256 * j + 4 * lane), bb = *(const f32x4*)(b2 + 256 * j + 4 * lane); v[j] = v[j] * rstd * gg + bb;
            ((GAS f32x4*)(xo + (size_t)t * D))[64 * j + lane] = v[j]; }
        if (l < NL - 1) {
#pragma unroll
            for (int j = 0; j < 4; ++j) { v2u w; w.x = pk2(v[j][0], v[j][1]); w.y = pk2(v[j][2], v[j][3]); ((GAS v2u*)(xb + (size_t)t * D))[64 * j + lane] = w; }
            row_logf(v, p.in[1] + (size_t)(l + 1) * D * DIN, p.in[2] + (l + 1) * 4, (float*)(p.ws + WS_LOGF) + (size_t)t * 4, lane);
        }
    }
}

typedef __attribute__((address_space(4))) const Params* kparams_t;
__device__ __forceinline__ Params params_fresh() {
    Params r{};
#if defined(__HIP_DEVICE_COMPILE__)
    kparams_t k = (kparams_t)__builtin_amdgcn_kernarg_segment_ptr(); asm volatile("" : "+s"(k));
#pragma unroll
    for (int i = 0; i < 20; ++i) r.in[i] = k->in[i];
    r.out = k->out; r.ws = k->ws;
#endif
    return r;
}
__global__ void __launch_bounds__(NTHR, 2) fwd(Params p_arg) {
    extern __shared__ __attribute__((aligned(16))) unsigned char lds_raw[];
    LAS unsigned char* lds = (LAS unsigned char*)lds_raw;
    const int G = gridDim.x, blk = blockIdx.x;
    { const int tid = tid_fresh(); for (int u = tid; u < (LDS_BYTES - LDSCTL_OFF) / 4; u += NTHR) ((LAS unsigned*)(lds + LDSCTL_OFF))[u] = 0u; }
    __syncthreads();
    { const Params p = params_fresh(); (void)xcd_barrier_post((unsigned*)(p.ws + WS_CTL) + CW_BAR, (volatile LAS unsigned*)(lds + LDSCTL_OFF + 352)); }
#define PH(call) do { const Params p = params_fresh(); call; } while (0)
#define xcd_barrier(dummy) do { const Params p = params_fresh(); XcdBarrier b_; b_.bar = (unsigned*)(p.ws + WS_CTL) + CW_BAR; b_.x = xb_xcc_id(); b_.st = (volatile LAS unsigned*)(lds + LDSCTL_OFF + 352); (xcd_barrier)(b_); } while (0)
    PH(phase_prologue(p, lds, G, blk));
    xcd_barrier(bar);
    for (int l = 0; l < NL; ++l) {
        PH(phase_inproj(p, l, lds, G, blk));
        xcd_barrier(bar);
        PH(ret::phase_kv(p, lds, G, blk)); PH(phase_conv(p, l, lds, G, blk)); __syncthreads(); PH(phase_fscan(p, lds, G, blk));
        xcd_barrier(bar);
        PH(ret::phase_scan(p, lds, G, blk)); PH(phase_attn(p, lds, G, blk));
        xcd_barrier(bar);
        PH(ret::phase_out(p, l, lds, G, blk));
        xcd_barrier(bar);
        PH(phase_outproj(p, l, lds, G, blk));
        xcd_barrier(bar);
        PH(phase_ln1_router(p, l, lds, G, blk));
        xcd_barrier(bar);
        PH(phase_gemm1(p, l, lds, G, blk));
        xcd_barrier(bar);
        PH(phase_gemm2(p, l, lds, G, blk));
        xcd_barrier(bar);
        PH(phase_ln2(p, l, lds, G, blk));
        if (l < NL - 1) xcd_barrier(bar);
    }
#undef PH
#undef xcd_barrier
}

extern "C" void kernel_launch(void* const* d_in, const int* in_sizes, int n_in, void* d_out, int out_size, void* d_ws, size_t ws_size, hipStream_t stream) {
    static int grid = 0;
    if (grid == 0) {
        if (n_in != 20 || in_sizes[0] != M * D || out_size != M * D || ws_size < WS_END) { fprintf(stderr, "kernel_launch: unexpected shapes / workspace (n_in %d, in0 %d, out %d, ws %zu, need %zu)\n", n_in, n_in > 0 ? in_sizes[0] : -1, out_size, ws_size, (size_t)WS_END); grid = -1; return; }
        int dev = 0, cus = 0, per_cu = 0;
        if (hipGetDevice(&dev) != hipSuccess || hipDeviceGetAttribute(&cus, hipDeviceAttributeMultiprocessorCount, dev) != hipSuccess) { grid = -1; return; }
        if (hipFuncSetAttribute((const void*)fwd, hipFuncAttributeMaxDynamicSharedMemorySize, LDS_BYTES) != hipSuccess) { fprintf(stderr, "kernel_launch: hipFuncSetAttribute failed\n"); grid = -1; return; }
        if (hipOccupancyMaxActiveBlocksPerMultiprocessor(&per_cu, (const void*)fwd, NTHR, LDS_BYTES) != hipSuccess || per_cu < 1) { fprintf(stderr, "kernel_launch: occupancy query reports %d blocks per CU\n", per_cu); per_cu = 1; }
        (void)hipGetLastError();
        grid = cus;
    }
    if (grid < 0) return;
    (void)hipMemsetAsync((char*)d_ws + WS_CTL, 0, CTL_ZERO_BYTES, stream);
    Params p{};
    for (int i = 0; i < 20; ++i) p.in[i] = (const float*)d_in[i];
    p.out = (float*)d_out; p.ws = (unsigned char*)d_ws;
    hipLaunchKernelGGL(fwd, dim3(grid), dim3(NTHR), LDS_BYTES, stream, p);
}
```

```cpp
#include <hip/hip_runtime.h>
#include <cstdio>
#include <cstdint>
#include <cmath>
__device__ __forceinline__ int tid_fresh() { int t = (int)threadIdx.x; asm volatile("" : "+v"(t)); return t; }
namespace pg8 {
#define PG8_LAS __attribute__((address_space(3)))
typedef unsigned short bf16_t;
typedef short bf16x8 __attribute__((ext_vector_type(8)));
typedef float f32x4 __attribute__((ext_vector_type(4)));
typedef unsigned u32x4 __attribute__((ext_vector_type(4)));
constexpr int BM = 256, BK = 64, HALF = 128, HTB = HALF * BK * 2  , STAGE_BYTES = 8 * HTB, NXCD = 8, WGM = 8;

__host__ __device__ __forceinline__ int lds_byte(int r, int c) { const int st = (r >> 4) * 2 + (c >> 5), rr = r & 15, cc = c & 31, ob = rr * 64 + cc * 2; return st * 1024 + (ob ^ (((ob >> 9) & 1) << 5)); }
__host__ __device__ __forceinline__ void stage_rc(int b, int& R, int& C) { const int st = b / 1024, sb = b % 1024, swz = sb ^ (((sb >> 9) & 1) << 5); R = (st >> 1) * 16 + swz / 64; C = (st & 1) * 32 + (swz % 64) / 2; }
__host__ __device__ __forceinline__ int perm32(int rho) { const int n = rho >> 4, i = rho & 15; return 8 * (i >> 2) + 4 * n + (i & 3); }

struct Unit { int pm, pn; };
struct Gemm { const bf16_t* A; const bf16_t* Bt; int M, N, K; };

struct StaticOrder {
    int nM, nN, nwg, G, c;
    __host__ __device__ void init(int M, int N, int G_, int c_) { nM = M / BM; nN = N / BM; nwg = nM * nN; G = G_; c = c_; }
    __host__ __device__ bool next(int i, Unit& u) const {
        const long L = (long)i * G + c; if (L >= nwg) return false;
        int wgid = (int)L; { const int q = nwg / NXCD, r = nwg % NXCD, xcd = wgid % NXCD, off = wgid / NXCD; wgid = (xcd < r ? xcd * (q + 1) : r * (q + 1) + (xcd - r) * q) + off; }
        const int nig = WGM * nN, gid = wgid / nig, fm = gid * WGM, gsz = (nM - fm) < WGM ? (nM - fm) : WGM;
        u.pm = fm + ((wgid % nig) % gsz); u.pn = (wgid % nig) / gsz; return true;
    }
    __device__ __forceinline__ void a_ready(const Unit&) const {}
    __device__ __forceinline__ void done(const Unit&) const {}
};

__device__ __forceinline__ unsigned cvt_pk_bf16(float lo, float hi) { unsigned r; asm volatile("v_cvt_pk_bf16_f32 %0, %1, %2" : "=v"(r) : "v"(lo), "v"(hi)); return r; }
typedef float f32x2 __attribute__((ext_vector_type(2)));
__device__ __forceinline__ f32x2 gelu_pk(f32x2 v) {
    const f32x2 av = __builtin_elementwise_abs(v), d = av * 0.2316418882f + 1.0f;
    f32x2 t; t.x = __builtin_amdgcn_rcpf(d.x); t.y = __builtin_amdgcn_rcpf(d.y);
    f32x2 q = t * 0.5307027145f + (-0.7265760135f); q = q * t + 0.7107068705f; q = q * t + (-0.142248368f); q = q * t + 0.127414796f; q = q * t;
    const f32x2 s = (v * v) * (-0.72134752044f);
    f32x2 e; e.x = __builtin_amdgcn_exp2f(s.x); e.y = __builtin_amdgcn_exp2f(s.y);
    const f32x2 m = v * (q * e), r = v - m;
    f32x2 o; o.x = v.x < 0.f ? m.x : r.x; o.y = v.y < 0.f ? m.y : r.y; return o;
}

template <int ACT  > struct EpiBf16 {
    static constexpr bool PERM = true, AFTER_DRAIN = false; static_assert(ACT == 0 || ACT == 1, "EpiBf16: ACT is 0 (none) or 1 (gelu_pk)");
    bf16_t* O; int ldc; const float* bias; int split_cols; size_t split_stride; float scale0;
    __device__ __forceinline__ void operator()(const f32x4 (&acc)[2][2][4][2], const Unit& u, int wr, int wc, int fr, int fq) const {
        const int row0 = u.pm * BM + wr * 64 + fr; int colt = u.pn * BM; bf16_t* base = O;
        float sc = 1.f; if (split_cols) { const int t = colt / split_cols; base += (size_t)t * split_stride; colt -= t * split_cols; if (t == 0) sc = scale0; }
        const int col0 = colt + wc * 32 + 8 * fq, bcol0 = u.pn * BM + wc * 32 + 8 * fq;
        f32x4 bv[2][2];
#pragma unroll
        for (int bj = 0; bj < 2; ++bj)
#pragma unroll
            for (int n = 0; n < 2; ++n) bv[bj][n] = bias ? *(const f32x4*)(bias + bcol0 + bj * HALF + 4 * n) : (f32x4){0.f, 0.f, 0.f, 0.f};
#pragma unroll
        for (int ai = 0; ai < 2; ++ai)
#pragma unroll
            for (int m = 0; m < 4; ++m) { bf16_t* rowp = base + (size_t)(row0 + ai * HALF + m * 16) * ldc + col0;
#pragma unroll
                for (int bj = 0; bj < 2; ++bj) { f32x4 v0 = acc[ai][bj][m][0] + bv[bj][0], v1 = acc[ai][bj][m][1] + bv[bj][1];
                    if (ACT == 1) { f32x2 a = gelu_pk((f32x2){v0[0], v0[1]}), b = gelu_pk((f32x2){v0[2], v0[3]}), c = gelu_pk((f32x2){v1[0], v1[1]}), d = gelu_pk((f32x2){v1[2], v1[3]});
                        v0 = (f32x4){a.x, a.y, b.x, b.y}; v1 = (f32x4){c.x, c.y, d.x, d.y}; }
                    v0 = v0 * sc; v1 = v1 * sc; u32x4 w; w.x = cvt_pk_bf16(v0[0], v0[1]); w.y = cvt_pk_bf16(v0[2], v0[3]); w.z = cvt_pk_bf16(v1[0], v1[1]); w.w = cvt_pk_bf16(v1[2], v1[3]);
                    *(u32x4*)(rowp + bj * HALF) = w; } }
    }
};

struct PanelStats {
    unsigned* xbuf;
    unsigned* cnt;
    unsigned* tmo;
    int ntn; float eps;
    unsigned code;
    __device__ __forceinline__ bool run(const f32x4 (&v)[2][2][4][2], const Unit& u, int wr, int wc, int fr, int fq, PG8_LAS unsigned char* lds, int wid, int lane) const {
        typedef float f32x2v __attribute__((ext_vector_type(2)));
        PG8_LAS f32x2v* P = (PG8_LAS f32x2v*)lds;
        PG8_LAS f32x2v* S = (PG8_LAS f32x2v*)(lds + 8192);
        PG8_LAS unsigned* flag = (PG8_LAS unsigned*)(lds + 8192 + 2048);
#pragma unroll
        for (int ai = 0; ai < 2; ++ai)
#pragma unroll
            for (int m = 0; m < 4; ++m) {
                float s = 0.f;
#pragma unroll
                for (int bj = 0; bj < 2; ++bj)
#pragma unroll
                    for (int n = 0; n < 2; ++n) { const f32x4 x = v[ai][bj][m][n]; s += (x[0] + x[1]) + (x[2] + x[3]); }
                s += __shfl_xor(s, 16); s += __shfl_xor(s, 32);
                const float mw = s * (1.0f / 64.0f); float q = 0.f;
#pragma unroll
                for (int bj = 0; bj < 2; ++bj)
#pragma unroll
                    for (int n = 0; n < 2; ++n) { const f32x4 d = v[ai][bj][m][n] - mw; q += (d[0] * d[0] + d[1] * d[1]) + (d[2] * d[2] + d[3] * d[3]); }
                q += __shfl_xor(q, 16); q += __shfl_xor(q, 32);
                if (fq == 0) P[(ai * HALF + wr * 64 + m * 16 + fr) * 4 + wc] = (f32x2v){mw, q};
            }
        asm volatile("s_waitcnt lgkmcnt(0)" ::: "memory"); __builtin_amdgcn_s_barrier(); asm volatile("" ::: "memory");
#if defined(BROKEN_EXCHANGE_NO_WAIT)
#warning BROKEN CONTROL BUILD: the row-statistics exchange does not wait; results are wrong by design
        if (blockIdx.x >= 64) { const long long t0_ = clock64(); while (clock64() - t0_ < 60000) __builtin_amdgcn_s_sleep(8); }
#endif
        const int row = wid * 32 + (lane & 31);
        if (lane < 32) {
            const f32x2v a = P[row * 4 + 0], b = P[row * 4 + 1], c = P[row * 4 + 2], d = P[row * 4 + 3];
            const float mt = (a.x + b.x + c.x + d.x) * 0.25f;
            const float da = a.x - mt, db = b.x - mt, dc = c.x - mt, dd = d.x - mt;
            const float m2 = (a.y + b.y) + (c.y + d.y) + 64.0f * ((da * da + db * db) + (dc * dc + dd * dd));
            unsigned long long* slot = (unsigned long long*)xbuf + ((size_t)(u.pm * BM + row) * 4 + u.pn);
            __hip_atomic_store(slot, ((unsigned long long)__float_as_uint(m2) << 32) | __float_as_uint(mt), __ATOMIC_RELAXED, __HIP_MEMORY_SCOPE_AGENT);
        }
        asm volatile("s_waitcnt vmcnt(0)" ::: "memory");
        if (lane == 0) __hip_atomic_fetch_add(cnt + 64 * u.pm, 1u, __ATOMIC_RELAXED, __HIP_MEMORY_SCOPE_AGENT);
        if (wid == 0) {
            bool dead = false; const unsigned long long t0 = __builtin_amdgcn_s_memrealtime(); const unsigned want = 8u * (unsigned)ntn;
            for (;;) {
#if defined(BROKEN_EXCHANGE_NO_WAIT)
                break;
#endif
                if ((unsigned)__builtin_amdgcn_readfirstlane(__hip_atomic_load(cnt + 64 * u.pm, __ATOMIC_RELAXED, __HIP_MEMORY_SCOPE_AGENT)) >= want) break;
                if (__builtin_amdgcn_s_memrealtime() - t0 > 2000000ull) {
                    if (lane == 0) { unsigned expect = 0u; __hip_atomic_compare_exchange_strong(tmo + 1, &expect, code | (unsigned)(u.pm & 0xff), __ATOMIC_RELAXED, __ATOMIC_RELAXED, __HIP_MEMORY_SCOPE_AGENT);
                                     __hip_atomic_store(tmo, 1u, __ATOMIC_RELAXED, __HIP_MEMORY_SCOPE_AGENT); }
                    dead = true; break; }
                __builtin_amdgcn_s_sleep(2);
            }
            __builtin_amdgcn_fence(__ATOMIC_ACQUIRE, "agent");
            if (lane == 0) flag[0] = dead ? 1u : 0u;
        }
        asm volatile("s_waitcnt vmcnt(0) lgkmcnt(0)" ::: "memory"); __builtin_amdgcn_s_barrier(); asm volatile("" ::: "memory");
        const bool bad = flag[0] != 0u;
        if (lane < 32) {
            const unsigned long long* slot = (const unsigned long long*)xbuf + (size_t)(u.pm * BM + row) * 4; float mt[4], m2[4]; float ms = 0.f;
#pragma unroll
            for (int t = 0; t < 4; ++t) { if (t < ntn) { const unsigned long long w = __hip_atomic_load(slot + t, __ATOMIC_RELAXED, __HIP_MEMORY_SCOPE_AGENT); mt[t] = __uint_as_float((unsigned)w); m2[t] = __uint_as_float((unsigned)(w >> 32)); } else { mt[t] = 0.f; m2[t] = 0.f; } ms += mt[t]; }
            const float mean = ms / (float)ntn; float q = 0.f;
#pragma unroll
            for (int t = 0; t < 4; ++t) if (t < ntn) { const float dm = mt[t] - mean; q += m2[t] + 256.0f * dm * dm; }
            S[row] = (f32x2v){mean, 1.0f / sqrtf(q / (256.0f * (float)ntn) + eps)};
        }
        asm volatile("s_waitcnt lgkmcnt(0)" ::: "memory"); __builtin_amdgcn_s_barrier(); asm volatile("" ::: "memory");
        return bad;
    }
};
struct EpiLnRes {
    static constexpr bool PERM = false, AFTER_DRAIN = true;
    const float* base; float* out; int ldc; const float* bias; PanelStats st; unsigned poison;
    __device__ __forceinline__ void fused(f32x4 (&acc)[2][2][4][2], const Unit& u, int wr, int wc, int fr, int fq, PG8_LAS unsigned char* lds, int wid, int lane) const {
        typedef float f32x2v __attribute__((ext_vector_type(2)));
        const PG8_LAS f32x2v* S = (const PG8_LAS f32x2v*)(lds + 8192);
        const int col0 = u.pn * BM + wc * 32 + 4 * fq;
#pragma unroll
        for (int bj = 0; bj < 2; ++bj)
#pragma unroll
            for (int n = 0; n < 2; ++n) { const f32x4 bv = bias ? *(const f32x4*)(bias + col0 + bj * HALF + n * 16) : (f32x4){0.f, 0.f, 0.f, 0.f};
#pragma unroll
                for (int ai = 0; ai < 2; ++ai)
#pragma unroll
                    for (int m = 0; m < 4; ++m) acc[ai][bj][m][n] += bv; }
        f32x4 pre[4][2][2];
#pragma unroll
        for (int m = 0; m < 4; ++m) { const size_t off = (size_t)(u.pm * BM + wr * 64 + m * 16 + fr) * ldc + col0;
#pragma unroll
            for (int bj = 0; bj < 2; ++bj)
#pragma unroll
                for (int n = 0; n < 2; ++n) pre[m][bj][n] = *(const f32x4*)(base + off + bj * HALF + n * 16); }
        const bool bad = st.run(acc, u, wr, wc, fr, fq, lds, wid, lane) || poison != 0u;
        const float qnan = __builtin_nanf("");
#pragma unroll
        for (int ai = 0; ai < 2; ++ai)
#pragma unroll
            for (int m = 0; m < 4; ++m) { const int r = ai * HALF + wr * 64 + m * 16 + fr; const f32x2v sr = S[r]; const size_t off = (size_t)(u.pm * BM + r) * ldc + col0;
#pragma unroll
                for (int bj = 0; bj < 2; ++bj)
#pragma unroll
                    for (int n = 0; n < 2; ++n) { const f32x4 bs = ai == 0 ? pre[m][bj][n] : *(const f32x4*)(base + off + bj * HALF + n * 16); f32x4 o = bs + (acc[ai][bj][m][n] - sr.x) * sr.y;
                        if (bad) o = (f32x4){qnan, qnan, qnan, qnan}; *(f32x4*)(out + off + bj * HALF + n * 16) = o; }
                if (m & 1) asm volatile("" ::: "memory"); }
    }
};
struct EpiLnResLn {
    static constexpr bool PERM = false, AFTER_DRAIN = true;
    const float* base; float* out; bf16_t* xn; int ldc; const float* bias; PanelStats st1, st2; unsigned poison;
    __device__ __forceinline__ void fused(f32x4 (&acc)[2][2][4][2], const Unit& u, int wr, int wc, int fr, int fq, PG8_LAS unsigned char* lds, int wid, int lane) const {
        typedef float f32x2v __attribute__((ext_vector_type(2))); typedef unsigned u32x2v __attribute__((ext_vector_type(2)));
        const PG8_LAS f32x2v* S = (const PG8_LAS f32x2v*)(lds + 8192);
        const int col0 = u.pn * BM + wc * 32 + 4 * fq;
#pragma unroll
        for (int bj = 0; bj < 2; ++bj)
#pragma unroll
            for (int n = 0; n < 2; ++n) { const f32x4 bv = bias ? *(const f32x4*)(bias + col0 + bj * HALF + n * 16) : (f32x4){0.f, 0.f, 0.f, 0.f};
#pragma unroll
                for (int ai = 0; ai < 2; ++ai)
#pragma unroll
                    for (int m = 0; m < 4; ++m) acc[ai][bj][m][n] += bv; }
        bool bad = st1.run(acc, u, wr, wc, fr, fq, lds, wid, lane) || poison != 0u;
        const float qnan = __builtin_nanf("");
#pragma unroll
        for (int ai = 0; ai < 2; ++ai)
#pragma unroll
            for (int m = 0; m < 4; ++m) { const int r = ai * HALF + wr * 64 + m * 16 + fr; const f32x2v sr = S[r]; const size_t off = (size_t)(u.pm * BM + r) * ldc + col0;
#pragma unroll
                for (int bj = 0; bj < 2; ++bj)
#pragma unroll
                    for (int n = 0; n < 2; ++n) { const f32x4 bs = *(const f32x4*)(base + off + bj * HALF + n * 16); acc[ai][bj][m][n] = bs + (acc[ai][bj][m][n] - sr.x) * sr.y; }
                asm volatile("" : "+v"(acc[ai][0][m][0]), "+v"(acc[ai][0][m][1]), "+v"(acc[ai][1][m][0]), "+v"(acc[ai][1][m][1]));
                if (m & 1) asm volatile("" ::: "memory"); }
        const bool bad1 = bad;
        bad = st2.run(acc, u, wr, wc, fr, fq, lds, wid, lane) || bad;
#pragma unroll
        for (int ai = 0; ai < 2; ++ai)
#pragma unroll
            for (int m = 0; m < 4; ++m) { const int r = ai * HALF + wr * 64 + m * 16 + fr; const f32x2v sr = S[r]; const size_t off = (size_t)(u.pm * BM + r) * ldc + col0;
#pragma unroll
                for (int bj = 0; bj < 2; ++bj)
#pragma unroll
                    for (int n = 0; n < 2; ++n) { const f32x4 x1 = acc[ai][bj][m][n]; *(f32x4*)(out + off + bj * HALF + n * 16) = bad1 ? (f32x4){qnan, qnan, qnan, qnan} : x1;
                        const f32x4 o = (x1 - sr.x) * sr.y; u32x2v w; w.x = cvt_pk_bf16(o[0], o[1]); w.y = cvt_pk_bf16(o[2], o[3]);
                        if (bad) { w.x = 0x7fc07fc0u; w.y = 0x7fc07fc0u; } *(u32x2v*)(xn + off + bj * HALF + n * 16) = w; }
                asm volatile("" ::: "memory"); }
    }
};

template <class Epi, class Sched, bool ALIGN_EPI = false, bool SP2 = false>
__device__ __forceinline__ void gemm_phase(PG8_LAS unsigned char* lds, const Gemm g, const Sched& S, const Epi& E) {
    const int tid = tid_fresh(), wid = __builtin_amdgcn_readfirstlane(tid >> 6), lane = tid & 63, wr = wid >> 2, wc = wid & 3, fr = lane & 15, fq = lane >> 4;
    const int K = g.K, nt = K / BK;
    unsigned voffA[2], voffB[2];
#pragma unroll
    for (int i = 0; i < 2; ++i) { int R, C; stage_rc(tid * 16 + i * 8192, R, C); const int Rb = Epi::PERM ? ((R & ~31) + perm32(R & 31)) : R;
        voffA[i] = (unsigned)(R * K + C) * 2u; voffB[i] = (unsigned)(Rb * K + C) * 2u; }
    const size_t kstep = (size_t)(BK * 2);
    const size_t hstep = (size_t)HALF * K * 2;
    const size_t tstep = 2 * hstep;
    const unsigned ldsw = (unsigned)wid * 1024u;
    const int aoff = lds_byte(wr * 64 + fr, fq * 8), boff = lds_byte(wc * 32 + fr, fq * 8);
#define PG8_SA(b, h) (((b) * 2 + (h)) * HTB)
#define PG8_SB(b, h) ((4 + (b) * 2 + (h)) * HTB)
#define PG8_STAGE(bufoff, gbase, voff) do { _Pragma("unroll") for (int _i = 0; _i < 2; ++_i) \
        __builtin_amdgcn_global_load_lds((const unsigned*)((const char*)(gbase) + (voff)[_i]), (PG8_LAS unsigned*)(lds + (bufoff) + ldsw + _i * 8192), 16, 0, 0); } while (0)
#define PG8_LDA(dst, b, h) do { _Pragma("unroll") for (int m = 0; m < 4; ++m) _Pragma("unroll") for (int k = 0; k < 2; ++k) dst[m][k] = *(const PG8_LAS bf16x8*)(lds + PG8_SA(b, h) + aoff + m * 2048 + k * 1024); } while (0)
#define PG8_LDB(dst, b, h) do { _Pragma("unroll") for (int n = 0; n < 2; ++n) _Pragma("unroll") for (int k = 0; k < 2; ++k) dst[n][k] = *(const PG8_LAS bf16x8*)(lds + PG8_SB(b, h) + boff + n * 2048 + k * 1024); } while (0)
#define PG8_MMA(ai, bj, At, Bt) do { __builtin_amdgcn_s_setprio(1); _Pragma("unroll") for (int m = 0; m < 4; ++m) _Pragma("unroll") for (int n = 0; n < 2; ++n) _Pragma("unroll") for (int k = 0; k < 2; ++k) \
        acc[ai][bj][m][n] = __builtin_amdgcn_mfma_f32_16x16x32_bf16(Bt[n][k], At[m][k], acc[ai][bj][m][n], 0, 0, 0); __builtin_amdgcn_s_setprio(0); } while (0)
#define PG8_WAIT_V(n) asm volatile("s_waitcnt vmcnt(" #n ")" ::: "memory")
#define PG8_WAIT_L(n) asm volatile("s_waitcnt lgkmcnt(" #n ")" ::: "memory")
#define PG8_BAR __builtin_amdgcn_s_barrier()
#define PG8_SCHED __builtin_amdgcn_sched_barrier(0)
    Unit cur, nxt; int ui = 0;
    if (!S.next(0, cur)) return;
    f32x4 acc[2][2][4][2];
#pragma unroll
    for (int a = 0; a < 2; ++a)
#pragma unroll
        for (int b = 0; b < 2; ++b)
#pragma unroll
            for (int m = 0; m < 4; ++m)
#pragma unroll
                for (int n = 0; n < 2; ++n) acc[a][b][m][n] = (f32x4){0.f, 0.f, 0.f, 0.f};
    bf16x8 At[4][2], B0[2][2], B1[2][2];
    const char* cA = (const char*)g.A + (size_t)cur.pm * tstep; const char* cB = (const char*)g.Bt + (size_t)cur.pn * tstep;
    S.a_ready(cur);
    if constexpr (SP2) {
        PG8_STAGE(PG8_SB(0, 0), cB, voffB); PG8_STAGE(PG8_SB(0, 1), cB + hstep, voffB); PG8_STAGE(PG8_SA(0, 0), cA, voffA); PG8_STAGE(PG8_SA(0, 1), cA + hstep, voffA);
        if (wr == 1) PG8_BAR;
        PG8_WAIT_V(2); PG8_BAR;
        PG8_STAGE(PG8_SB(1, 0), cB + kstep, voffB); PG8_STAGE(PG8_SA(1, 0), cA + kstep, voffA); PG8_STAGE(PG8_SB(1, 1), cB + hstep + kstep, voffB);
        PG8_WAIT_V(6); PG8_BAR;
    } else {
        PG8_STAGE(PG8_SB(0, 0), cB, voffB); PG8_STAGE(PG8_SA(0, 0), cA, voffA); PG8_STAGE(PG8_SB(0, 1), cB + hstep, voffB); PG8_STAGE(PG8_SA(0, 1), cA + hstep, voffA);
        if (wr == 1) PG8_BAR;
        PG8_WAIT_V(4); PG8_BAR;
        PG8_STAGE(PG8_SB(1, 0), cB + kstep, voffB); PG8_STAGE(PG8_SA(1, 0), cA + kstep, voffA); PG8_STAGE(PG8_SB(1, 1), cB + hstep + kstep, voffB);
        PG8_WAIT_V(6); PG8_BAR;
    }
    for (;;) {
        const bool has_next = S.next(ui + 1, nxt);
        const char* nA = has_next ? (const char*)g.A + (size_t)nxt.pm * tstep : cA; const char* nB = has_next ? (const char*)g.Bt + (size_t)nxt.pn * tstep : cB;
        for (int t = 0; t < nt; t += 2) {
            const bool last = (t == nt - 2);
            const char* a1 = cA + (size_t)(t + 1) * kstep;
            const char* a2 = last ? nA : cA + (size_t)(t + 2) * kstep; const char* b2 = last ? nB : cB + (size_t)(t + 2) * kstep;
            const char* a3 = a2 + kstep; const char* b3 = b2 + kstep;
            if (last && has_next) S.a_ready(nxt);
            if constexpr (SP2) {
            PG8_LDB(B0, 0, 0); PG8_LDB(B1, 0, 1); PG8_SCHED; PG8_LDA(At, 0, 0); PG8_STAGE(PG8_SA(1, 1), a1 + hstep, voffA);
            PG8_WAIT_V(8); PG8_WAIT_L(0); PG8_BAR; PG8_MMA(0, 0, At, B0); PG8_MMA(0, 1, At, B1); PG8_BAR; PG8_SCHED;
            PG8_LDA(At, 0, 1); PG8_STAGE(PG8_SB(0, 0), b2, voffB); PG8_STAGE(PG8_SB(0, 1), b2 + hstep, voffB); PG8_STAGE(PG8_SA(0, 0), a2, voffA);
            PG8_WAIT_V(8); PG8_WAIT_L(0); PG8_BAR; PG8_MMA(1, 0, At, B0); PG8_MMA(1, 1, At, B1); PG8_BAR; PG8_SCHED;
            PG8_LDB(B0, 1, 0); PG8_LDB(B1, 1, 1); PG8_SCHED; PG8_LDA(At, 1, 0); PG8_STAGE(PG8_SA(0, 1), a2 + hstep, voffA);
            PG8_WAIT_V(8); PG8_WAIT_L(0); PG8_BAR; PG8_MMA(0, 0, At, B0); PG8_MMA(0, 1, At, B1); PG8_BAR; PG8_SCHED;
            PG8_LDA(At, 1, 1); PG8_STAGE(PG8_SB(1, 0), b3, voffB); PG8_STAGE(PG8_SB(1, 1), b3 + hstep, voffB); PG8_STAGE(PG8_SA(1, 0), a3, voffA);
            PG8_WAIT_V(8); PG8_WAIT_L(0); PG8_BAR; PG8_MMA(1, 0, At, B0); PG8_MMA(1, 1, At, B1); PG8_BAR; PG8_SCHED;
            } else {
            PG8_LDB(B0, 0, 0); PG8_SCHED; PG8_LDA(At, 0, 0); PG8_STAGE(PG8_SA(1, 1), a1 + hstep, voffA);
            PG8_WAIT_L(8); PG8_BAR; PG8_WAIT_L(0); PG8_MMA(0, 0, At, B0); PG8_BAR; PG8_SCHED;
            PG8_LDB(B1, 0, 1); PG8_STAGE(PG8_SB(0, 0), b2, voffB);
            PG8_BAR; PG8_WAIT_L(0); PG8_MMA(0, 1, At, B1); PG8_BAR;
            PG8_LDA(At, 0, 1); PG8_STAGE(PG8_SA(0, 0), a2, voffA);
            PG8_BAR; PG8_WAIT_L(0); PG8_MMA(1, 0, At, B0); PG8_BAR; PG8_SCHED;
            PG8_STAGE(PG8_SB(0, 1), b2 + hstep, voffB);
            PG8_WAIT_V(6); PG8_BAR; PG8_MMA(1, 1, At, B1); PG8_BAR;
            PG8_LDB(B0, 1, 0); PG8_SCHED; PG8_LDA(At, 1, 0); PG8_STAGE(PG8_SA(0, 1), a2 + hstep, voffA);
            PG8_WAIT_L(8); PG8_BAR; PG8_WAIT_L(0); PG8_MMA(0, 0, At, B0); PG8_BAR; PG8_SCHED;
            PG8_LDB(B1, 1, 1); PG8_STAGE(PG8_SB(1, 0), b3, voffB);
            PG8_BAR; PG8_WAIT_L(0); PG8_MMA(0, 1, At, B1); PG8_BAR;
            PG8_LDA(At, 1, 1); PG8_STAGE(PG8_SA(1, 0), a3, voffA);
            PG8_BAR; PG8_WAIT_L(0); PG8_MMA(1, 0, At, B0); PG8_BAR; PG8_SCHED;
            PG8_STAGE(PG8_SB(1, 1), b3 + hstep, voffB);
            PG8_WAIT_V(6); PG8_BAR; PG8_MMA(1, 1, At, B1); PG8_BAR;
            }
        }
        if constexpr (ALIGN_EPI) { if (wr == 0) PG8_BAR; }
        if constexpr (!Epi::AFTER_DRAIN) { E(acc, cur, wr, wc, fr, fq); S.done(cur); }
        if (!has_next) break;
#pragma unroll
        for (int a = 0; a < 2; ++a)
#pragma unroll
            for (int b = 0; b < 2; ++b)
#pragma unroll
                for (int m = 0; m < 4; ++m)
#pragma unroll
                    for (int n = 0; n < 2; ++n) acc[a][b][m][n] = (f32x4){0.f, 0.f, 0.f, 0.f};
        cur = nxt; cA = nA; cB = nB; ++ui;
        if constexpr (ALIGN_EPI) { if (wr == 1) PG8_BAR; }
    }
    PG8_WAIT_V(0);
    if constexpr (!ALIGN_EPI) { if (wr == 0) PG8_BAR; }
    PG8_BAR;
    if constexpr (Epi::AFTER_DRAIN) { E.fused(acc, cur, wr, wc, fr, fq, lds, wid, lane); S.done(cur); }
#undef PG8_SA
#undef PG8_SB
#undef PG8_STAGE
#undef PG8_LDA
#undef PG8_LDB
#undef PG8_MMA
#undef PG8_WAIT_V
#undef PG8_WAIT_L
#undef PG8_BAR
#undef PG8_SCHED
}
}
namespace pg8 {
struct EpiF32 {
    static constexpr bool PERM = false, AFTER_DRAIN = false;
    float* C; int ldc; const float* bias;
    __device__ __forceinline__ void operator()(const f32x4 (&acc)[2][2][4][2], const Unit& u, int wr, int wc, int fr, int fq) const {
        const int row0 = u.pm * BM + wr * 64 + fr, col0 = u.pn * BM + wc * 32 + 4 * fq;
        f32x4 bv[2][2];
#pragma unroll
        for (int bj = 0; bj < 2; ++bj)
#pragma unroll
            for (int n = 0; n < 2; ++n) bv[bj][n] = bias ? *(const f32x4*)(bias + col0 + bj * HALF + n * 16) : (f32x4){0.f, 0.f, 0.f, 0.f};
#pragma unroll
        for (int ai = 0; ai < 2; ++ai)
#pragma unroll
            for (int m = 0; m < 4; ++m) { float* rowp = C + (size_t)(row0 + ai * HALF + m * 16) * ldc + col0;
#pragma unroll
                for (int bj = 0; bj < 2; ++bj)
#pragma unroll
                    for (int n = 0; n < 2; ++n) *(f32x4*)(rowp + bj * HALF + n * 16) = acc[ai][bj][m][n] + bv[bj][n]; }
    }
};

constexpr int MOE_CAP = 16384;
struct MUnit { int e, rt, pn, nvalid; };
struct MoeSched {
    const PG8_LAS int* tp; const PG8_LAS int* cnt; int NPn, G, c;
    __device__ __forceinline__ bool next(int i, MUnit& u) const {
        const int T = tp[32]; const long Lx = (long)i * G + c; if (Lx >= (long)T * NPn) return false;
        const int L = (int)Lx, tile = L / NPn; int e = 0;
#pragma unroll
        for (int k = 1; k < 32; ++k) e += (tp[k] <= tile) ? 1 : 0;
        const int rt = tile - tp[e]; int rem = cnt[e] - rt * 256; rem = rem < 256 ? rem : 256;
        u.e = __builtin_amdgcn_readfirstlane(e); u.rt = __builtin_amdgcn_readfirstlane(rt); u.pn = __builtin_amdgcn_readfirstlane(L % NPn); u.nvalid = __builtin_amdgcn_readfirstlane(rem);
        return true;
    }
};
__device__ __forceinline__ float sigmoid_fast(float z) { return __builtin_amdgcn_rcpf(1.0f + __builtin_amdgcn_exp2f(-1.4426950408889634f * z)); }
struct EpiSwiglu {
    static constexpr bool PERM = true;
    bf16_t* act; const float* b1;
    __device__ __forceinline__ void operator()(const f32x4 (&acc)[2][2][4][2], const MUnit& u, int wr, int wc, int fr, int fq) const {
        const int c0 = wc * 32 + 8 * fq; const float* bb = b1 + (size_t)u.e * 2048 + 128 * u.pn + c0;
        f32x4 bg[2], bl[2];
#pragma unroll
        for (int n = 0; n < 2; ++n) { bg[n] = *(const f32x4*)(bb + 4 * n); bl[n] = *(const f32x4*)(bb + 1024 + 4 * n); }
        bf16_t* base = act + ((size_t)u.e * MOE_CAP + (size_t)u.rt * 256 + wr * 64 + fr) * 1024 + 128 * u.pn + c0;
#pragma unroll
        for (int ai = 0; ai < 2; ++ai)
#pragma unroll
            for (int m = 0; m < 4; ++m) {
                unsigned w[4];
#pragma unroll
                for (int n = 0; n < 2; ++n) { const f32x4 g4 = acc[ai][0][m][n] + bg[n], l4 = acc[ai][1][m][n] + bl[n]; float a[4];
#pragma unroll
                    for (int j = 0; j < 4; ++j) { const float g = fminf(g4[j], 7.0f), li = fminf(fmaxf(l4[j], -7.0f), 7.0f); a[j] = g * sigmoid_fast(1.702f * g) * (li + 1.0f); }
                    w[2 * n] = cvt_pk_bf16(a[0], a[1]); w[2 * n + 1] = cvt_pk_bf16(a[2], a[3]); }
                u32x4 o; o.x = w[0]; o.y = w[1]; o.z = w[2]; o.w = w[3];
                *(u32x4*)(base + (size_t)(ai * HALF + m * 16) * 1024) = o; }
    }
};
struct EpiGateScatter {
    static constexpr bool PERM = true;
    bf16_t* y4; const float* b2; const int* tk; const float* gate;
    __device__ __forceinline__ void operator()(const f32x4 (&acc)[2][2][4][2], const MUnit& u, int wr, int wc, int fr, int fq) const {
        const int c0 = 256 * u.pn + wc * 32 + 8 * fq; const float* bb = b2 + (size_t)u.e * 1024 + c0;
        f32x4 bv[2][2];
#pragma unroll
        for (int bj = 0; bj < 2; ++bj)
#pragma unroll
            for (int n = 0; n < 2; ++n) bv[bj][n] = *(const f32x4*)(bb + bj * HALF + 4 * n);
        const size_t lbase = (size_t)u.e * MOE_CAP + (size_t)u.rt * 256;
#pragma unroll
        for (int ai = 0; ai < 2; ++ai)
#pragma unroll
            for (int m = 0; m < 4; ++m) { const int r = ai * HALF + wr * 64 + m * 16 + fr;
                if (r < u.nvalid) { const int t = tk[lbase + r]; const float g = gate[lbase + r]; bf16_t* dst = y4 + (size_t)t * 1024 + c0;
#pragma unroll
                    for (int bj = 0; bj < 2; ++bj) { const f32x4 v0 = (acc[ai][bj][m][0] + bv[bj][0]) * g, v1 = (acc[ai][bj][m][1] + bv[bj][1]) * g;
                        u32x4 o; o.x = cvt_pk_bf16(v0[0], v0[1]); o.y = cvt_pk_bf16(v0[2], v0[3]); o.z = cvt_pk_bf16(v1[0], v1[1]); o.w = cvt_pk_bf16(v1[2], v1[3]);
                        *(u32x4*)(dst + bj * HALF) = o; } } }
    }
};

template <class Epi, bool GATHER>
__device__ __forceinline__ void gemm_phase_moe(PG8_LAS unsigned char* lds, const bf16_t* A, const bf16_t* Bt, const int K, const int NB, const int* rowlist, const MoeSched& S, const Epi& E) {
    const int tid = tid_fresh(), wid = __builtin_amdgcn_readfirstlane(tid >> 6), lane = tid & 63, wr = wid >> 2, wc = wid & 3, fr = lane & 15, fq = lane >> 4;
    const int nt = K / BK;
    int RA[2]; unsigned cbA[2], voffB[2];
#pragma unroll
    for (int i = 0; i < 2; ++i) { int R, C; stage_rc(tid * 16 + i * 8192, R, C); const int Rb = Epi::PERM ? ((R & ~31) + perm32(R & 31)) : R;
        RA[i] = R; cbA[i] = (unsigned)C * 2u; voffB[i] = (unsigned)(Rb * K + C) * 2u; }
    const size_t kstep = (size_t)(BK * 2);
    const size_t hstep = (size_t)HALF * K * 2;
    const unsigned ldsw = (unsigned)wid * 1024u;
    const int aoff = lds_byte(wr * 64 + fr, fq * 8), boff = lds_byte(wc * 32 + fr, fq * 8);
#define PG8_SA(b, h) (((b) * 2 + (h)) * HTB)
#define PG8_SB(b, h) ((4 + (b) * 2 + (h)) * HTB)
#define PG8_STAGE(bufoff, gbase, voff) do { _Pragma("unroll") for (int _i = 0; _i < 2; ++_i) \
        __builtin_amdgcn_global_load_lds((const unsigned*)((const char*)(gbase) + (voff)[_i]), (PG8_LAS unsigned*)(lds + (bufoff) + ldsw + _i * 8192), 16, 0, 0); } while (0)
#define PG8_LDA(dst, b, h) do { _Pragma("unroll") for (int m = 0; m < 4; ++m) _Pragma("unroll") for (int k = 0; k < 2; ++k) dst[m][k] = *(const PG8_LAS bf16x8*)(lds + PG8_SA(b, h) + aoff + m * 2048 + k * 1024); } while (0)
#define PG8_LDB(dst, b, h) do { _Pragma("unroll") for (int n = 0; n < 2; ++n) _Pragma("unroll") for (int k = 0; k < 2; ++k) dst[n][k] = *(const PG8_LAS bf16x8*)(lds + PG8_SB(b, h) + boff + n * 2048 + k * 1024); } while (0)
#define PG8_MMA(ai, bj, At, Bt_) do { __builtin_amdgcn_s_setprio(1); _Pragma("unroll") for (int m = 0; m < 4; ++m) _Pragma("unroll") for (int n = 0; n < 2; ++n) _Pragma("unroll") for (int k = 0; k < 2; ++k) \
        acc[ai][bj][m][n] = __builtin_amdgcn_mfma_f32_16x16x32_bf16(Bt_[n][k], At[m][k], acc[ai][bj][m][n], 0, 0, 0); __builtin_amdgcn_s_setprio(0); } while (0)
#define PG8_WAIT_V(n) asm volatile("s_waitcnt vmcnt(" #n ")" ::: "memory")
#define PG8_WAIT_L(n) asm volatile("s_waitcnt lgkmcnt(" #n ")" ::: "memory")
#define PG8_BAR __builtin_amdgcn_s_barrier()
#define PG8_SCHED __builtin_amdgcn_sched_barrier(0)
#define PG8_AOFFS(dst, u) do { _Pragma("unroll") for (int _h = 0; _h < 2; ++_h) _Pragma("unroll") for (int _i = 0; _i < 2; ++_i) { \
        if constexpr (GATHER) { int _r = _h * HALF + RA[_i]; _r = _r < (u).nvalid ? _r : (u).nvalid - 1; \
            const int _tk = rowlist[(size_t)(u).e * MOE_CAP + (size_t)(u).rt * 256 + _r]; dst[_h][_i] = (unsigned)(_tk >> 2) * (unsigned)(K * 2) + cbA[_i]; } \
        else dst[_h][_i] = (unsigned)((_h * HALF + RA[_i]) * K) * 2u + cbA[_i]; } } while (0)
#define PG8_ABASE(u) (GATHER ? (const char*)A : (const char*)A + ((size_t)(u).e * MOE_CAP + (size_t)(u).rt * 256) * (size_t)K * 2)
#define PG8_BBASE(u) ((const char*)Bt + ((size_t)(u).e * NB + (size_t)(u).pn * 256) * (size_t)K * 2)
    MUnit cur, nxt; int ui = 0;
    if (!S.next(0, cur)) return;
    f32x4 acc[2][2][4][2];
#pragma unroll
    for (int a = 0; a < 2; ++a)
#pragma unroll
        for (int b = 0; b < 2; ++b)
#pragma unroll
            for (int m = 0; m < 4; ++m)
#pragma unroll
                for (int n = 0; n < 2; ++n) acc[a][b][m][n] = (f32x4){0.f, 0.f, 0.f, 0.f};
    bf16x8 At[4][2], B0[2][2], B1[2][2];
    unsigned ca[2][2], na[2][2];
    PG8_AOFFS(ca, cur);
    const char* cA = PG8_ABASE(cur); const char* cB = PG8_BBASE(cur);
    PG8_STAGE(PG8_SB(0, 0), cB, voffB); PG8_STAGE(PG8_SB(0, 1), cB + hstep, voffB); PG8_STAGE(PG8_SA(0, 0), cA, ca[0]); PG8_STAGE(PG8_SA(0, 1), cA, ca[1]);
    if (wr == 1) PG8_BAR;
    PG8_WAIT_V(2); PG8_BAR;
    PG8_STAGE(PG8_SB(1, 0), cB + kstep, voffB); PG8_STAGE(PG8_SA(1, 0), cA + kstep, ca[0]); PG8_STAGE(PG8_SB(1, 1), cB + hstep + kstep, voffB);
    PG8_WAIT_V(6); PG8_BAR;
    for (;;) {
        const bool has_next = S.next(ui + 1, nxt);
        const char* nA = has_next ? PG8_ABASE(nxt) : cA; const char* nB = has_next ? PG8_BBASE(nxt) : cB;
#pragma unroll
        for (int h = 0; h < 2; ++h)
#pragma unroll
            for (int i = 0; i < 2; ++i) na[h][i] = ca[h][i];
        for (int t = 0; t < nt; t += 2) {
            const bool last = (t == nt - 2);
            if constexpr (GATHER) { if (t == nt - 4 && has_next) PG8_AOFFS(na, nxt); }
            const char* a1 = cA + (size_t)(t + 1) * kstep;
            const char* a2 = last ? nA : cA + (size_t)(t + 2) * kstep; const char* b2 = last ? nB : cB + (size_t)(t + 2) * kstep;
            const char* a3 = a2 + kstep; const char* b3 = b2 + kstep;
            PG8_LDB(B0, 0, 0); PG8_LDB(B1, 0, 1); PG8_SCHED; PG8_LDA(At, 0, 0); PG8_STAGE(PG8_SA(1, 1), a1, ca[1]);
            if constexpr (GATHER) { if (last) {
#pragma unroll
                for (int h = 0; h < 2; ++h)
#pragma unroll
                    for (int i = 0; i < 2; ++i) ca[h][i] = na[h][i]; } }
            PG8_WAIT_V(8); PG8_WAIT_L(0); PG8_BAR; PG8_MMA(0, 0, At, B0); PG8_MMA(0, 1, At, B1); PG8_BAR; PG8_SCHED;
            PG8_LDA(At, 0, 1); PG8_STAGE(PG8_SB(0, 0), b2, voffB); PG8_STAGE(PG8_SB(0, 1), b2 + hstep, voffB); PG8_STAGE(PG8_SA(0, 0), a2, ca[0]);
            PG8_WAIT_V(8); PG8_WAIT_L(0); PG8_BAR; PG8_MMA(1, 0, At, B0); PG8_MMA(1, 1, At, B1); PG8_BAR; PG8_SCHED;
            PG8_LDB(B0, 1, 0); PG8_LDB(B1, 1, 1); PG8_SCHED; PG8_LDA(At, 1, 0); PG8_STAGE(PG8_SA(0, 1), a2, ca[1]);
            PG8_WAIT_V(8); PG8_WAIT_L(0); PG8_BAR; PG8_MMA(0, 0, At, B0); PG8_MMA(0, 1, At, B1); PG8_BAR; PG8_SCHED;
            PG8_LDA(At, 1, 1); PG8_STAGE(PG8_SB(1, 0), b3, voffB); PG8_STAGE(PG8_SB(1, 1), b3 + hstep, voffB); PG8_STAGE(PG8_SA(1, 0), a3, ca[0]);
            PG8_WAIT_V(8); PG8_WAIT_L(0); PG8_BAR; PG8_MMA(1, 0, At, B0); PG8_MMA(1, 1, At, B1); PG8_BAR; PG8_SCHED;
        }
        if (wr == 0) PG8_BAR;
        E(acc, cur, wr, wc, fr, fq);
        if (!has_next) break;
#pragma unroll
        for (int a = 0; a < 2; ++a)
#pragma unroll
            for (int b = 0; b < 2; ++b)
#pragma unroll
                for (int m = 0; m < 4; ++m)
#pragma unroll
                    for (int n = 0; n < 2; ++n) acc[a][b][m][n] = (f32x4){0.f, 0.f, 0.f, 0.f};
        cur = nxt; cA = nA; cB = nB; ++ui;
        if (wr == 1) PG8_BAR;
    }
    PG8_WAIT_V(0);
    PG8_BAR;
#undef PG8_SA
#undef PG8_SB
#undef PG8_STAGE
#undef PG8_LDA
#undef PG8_LDB
#undef PG8_MMA
#undef PG8_WAIT_V
#undef PG8_WAIT_L
#undef PG8_BAR
#undef PG8_SCHED
#undef PG8_AOFFS
#undef PG8_ABASE
#undef PG8_BBASE
}
}
#include <hip/hip_bf16.h>
namespace attn_body {
using bf16=__hip_bfloat16;
using bf16x8=__attribute__((ext_vector_type(8)))short;
using s16x4=__attribute__((ext_vector_type(4)))short;
using f32x16=__attribute__((ext_vector_type(16)))float;
using u32x4=__attribute__((ext_vector_type(4)))unsigned;
constexpr int BATCH=2,NHEAD=4,SEQ=8192,D=64,DM=2816,DO=1024;
constexpr int NW=8,QBLK=32,QB=QBLK*NW,KVBLK=64,NQB=SEQ/QB;
constexpr int ATTN_PITCH=DM, ATTN_UNIT_ROWS=QB;
constexpr float LOG2E_F=1.4426950408889634f;
#ifndef ATT_TAU
#define ATT_TAU 41.0f
#endif
__device__ __forceinline__ int crow(int r,int hi){return (r&3)+8*(r>>2)+4*hi;}
#define SBAR() __builtin_amdgcn_sched_barrier(0)
__device__ __forceinline__ void cmask(f32x16&p0,f32x16&p1,int jb,int qrel,int hi){
  const float NEG=-INFINITY; int kb=64*jb+4*hi;
  #pragma unroll
  for(int r=0;r<16;++r){int kv=kb+(r&3)+8*(r>>2); if(kv>qrel)p0[r]=NEG; if(kv+32>qrel)p1[r]=NEG;}
}

constexpr int NSLOT=3, SLOTB=8192;
constexpr int LDS_K=0, LDS_V=NSLOT*SLOTB, LDS_WS=2*NSLOT*SLOTB, LDS_OST=LDS_WS+NW*64*4, LDS_BYTES=LDS_OST+NW*4096, LDS_FB=86016, LDS_FB_BYTES=32768;
constexpr float C2=0.125f*1.4426950408889634f;
__device__ __forceinline__ void glds16(const void*gsrc,unsigned lds_dst){unsigned keep;
  asm volatile("s_mov_b32 %0, m0\n\ts_mov_b32 m0, %2\n\ts_nop 0\n\tglobal_load_lds_dwordx4 %1, off\n\ts_mov_b32 m0, %0":"=&s"(keep):"v"(gsrc),"s"(lds_dst):"memory");}
__device__ __forceinline__ float max3f(float a,float b,float c){float r;asm("v_max3_f32 %0, %1, %2, %3":"=v"(r):"v"(a),"v"(b),"v"(c));return r;}
__device__ __forceinline__ float max2f(float a,float b){float r;asm("v_max_f32_e32 %0, %1, %2":"=v"(r):"v"(a),"v"(b));return r;}
__device__ __forceinline__ float fadd_s(float a,float b){float r;asm("v_add_f32_e32 %0, %1, %2":"=v"(r):"v"(a),"v"(b));return r;}
__device__ __forceinline__ float fsub_s(float a,float b){float r;asm("v_sub_f32_e32 %0, %1, %2":"=v"(r):"v"(a),"v"(b));return r;}
typedef float f32x2_t __attribute__((ext_vector_type(2))); typedef __bf16 bf16x2_t __attribute__((ext_vector_type(2)));
__device__ __forceinline__ unsigned cvtpk_s(float lo,float hi){f32x2_t v={lo,hi};bf16x2_t b=__builtin_convertvector(v,bf16x2_t);return __builtin_bit_cast(unsigned,b);}
#define WAIT_BAR(N) asm volatile("s_waitcnt vmcnt(" #N ") lgkmcnt(0)\n\ts_barrier":::"memory")

__device__ __forceinline__ void qkt(f32x16&p0,f32x16&p1,const char*Kslot,const bf16x8*qr,int r32,int hi){
  const char*kb=Kslot+hi*1024+r32*16;
  #pragma unroll
  for(int d0=0;d0<4;++d0){
    const bf16x8 b0=*reinterpret_cast<const bf16x8*>(kb+d0*2048);
    const bf16x8 b1=*reinterpret_cast<const bf16x8*>(kb+d0*2048+512);
    {p0=__builtin_amdgcn_mfma_f32_32x32x16_bf16(b0,qr[d0],p0,0,0,0);p1=__builtin_amdgcn_mfma_f32_32x32x16_bf16(b1,qr[d0],p1,0,0,0);}}
}
typedef __attribute__((address_space(3))) const char* lds_cptr;
typedef short v4i16_t __attribute__((ext_vector_type(4)));
__device__ __forceinline__ void kload8(bf16x8*kf,lds_cptr kp){
  kf[0]=*(const __attribute__((address_space(3))) bf16x8*)(kp);      kf[1]=*(const __attribute__((address_space(3))) bf16x8*)(kp+512);
  kf[2]=*(const __attribute__((address_space(3))) bf16x8*)(kp+2048); kf[3]=*(const __attribute__((address_space(3))) bf16x8*)(kp+2560);
  kf[4]=*(const __attribute__((address_space(3))) bf16x8*)(kp+4096); kf[5]=*(const __attribute__((address_space(3))) bf16x8*)(kp+4608);
  kf[6]=*(const __attribute__((address_space(3))) bf16x8*)(kp+6144); kf[7]=*(const __attribute__((address_space(3))) bf16x8*)(kp+6656);
}
__device__ __forceinline__ void kload2(bf16x8*kf,lds_cptr kp,int j){ kf[2*j]=*(const __attribute__((address_space(3))) bf16x8*)(kp+j*2048); kf[2*j+1]=*(const __attribute__((address_space(3))) bf16x8*)(kp+j*2048+512); }
__device__ __forceinline__ s16x4 vtr(lds_cptr p){ return __builtin_bit_cast(s16x4,__builtin_amdgcn_ds_read_tr16_b64_v4i16((__attribute__((address_space(3))) v4i16_t*)p)); }
__device__ __forceinline__ float rowmax(const f32x16&p0,const f32x16&p1){
  float a=max3f(p0[0],p0[1],p1[0]),b=max3f(p0[2],p0[3],p1[1]);a=max3f(a,p1[2],p1[3]);
  #pragma unroll
  for(int r=4;r<16;r+=4){a=max3f(a,p0[r],p0[r+1]);b=max3f(b,p0[r+2],p0[r+3]);a=max3f(a,p1[r],p1[r+1]);b=max3f(b,p1[r+2],p1[r+3]);}
  const float m=max2f(a,b);
  auto rr=__builtin_amdgcn_permlane32_swap(__float_as_uint(m),__float_as_uint(m),false,false);
  return max2f(__uint_as_float(rr[0]),__uint_as_float(rr[1]));
}
__device__ __forceinline__ void pv(f32x16*o,int vb,bf16x8 pa0,bf16x8 pa1,bf16x8 pa2,bf16x8 pa3){
  #pragma unroll
  for(int d0=0;d0<2;++d0){s16x4 lo[4],hi[4];
    #pragma unroll
    for(int ks=0;ks<4;++ks){
      asm volatile("ds_read_b64_tr_b16 %0,%1 offset:%c2":"=&v"(lo[ks]):"v"(vb),"i"(d0*4096+ks*1024):"memory");
      asm volatile("ds_read_b64_tr_b16 %0,%1 offset:%c2":"=&v"(hi[ks]):"v"(vb),"i"(d0*4096+ks*1024+512):"memory");}
    asm volatile("s_waitcnt lgkmcnt(0)":::"memory");SBAR();
    #define PK(k) (bf16x8){lo[k][0],lo[k][1],lo[k][2],lo[k][3],hi[k][0],hi[k][1],hi[k][2],hi[k][3]}
    o[d0]=__builtin_amdgcn_mfma_f32_32x32x16_bf16(pa0,PK(0),o[d0],0,0,0);
    o[d0]=__builtin_amdgcn_mfma_f32_32x32x16_bf16(pa1,PK(1),o[d0],0,0,0);
    o[d0]=__builtin_amdgcn_mfma_f32_32x32x16_bf16(pa2,PK(2),o[d0],0,0,0);
    o[d0]=__builtin_amdgcn_mfma_f32_32x32x16_bf16(pa3,PK(3),o[d0],0,0,0);
    #undef PK
  }
}

#ifndef ATTN_STORE16
#define ATTN_STORE16(p,v) (*(u32x4*)(p)=(v))
#endif
template<int THRL> __device__ __forceinline__ void attn_unit(int b,int h,int qb,const bf16*Q,const bf16*__restrict__ K,const bf16*__restrict__ V,bf16*O,const float*__restrict__ Fg,const float*__restrict__ Ftg,const float*__restrict__ QNg,const float*__restrict__ DGg,const float*__restrict__ KMg,char*shm){
  const int tid=tid_fresh(),lane=tid&63,r32=lane&31,hi=lane>>5; const int wid=__builtin_amdgcn_readfirstlane(tid>>6);
  const long rowbase=(long)b*SEQ; const int q0=qb*QB;
  const bf16*Qw=Q+(rowbase+q0+wid*QBLK)*DM+h*D;
  typedef __attribute__((address_space(3))) float lds_f; typedef __attribute__((address_space(3))) const char* lds_cptr0;
  lds_f*const Fpre=(lds_f*)((lds_cptr0)shm+LDS_FB+LDS_FB_BYTES);
  const int NTF=(q0+QB)/KVBLK;
  if(wid==0){ const float a_=Ftg[2*lane],b_=Ftg[2*lane+1]; float s_=a_+b_;
    _Pragma("unroll") for(int o_=1;o_<64;o_<<=1){const float t_=__shfl_up(s_,o_); if(lane>=o_)s_+=t_;}
    const float pre0=s_-(a_+b_), pre1=s_-b_;
    Fpre[2*lane]=pre0; Fpre[2*lane+1]=pre1;
    float km=fmaxf((2*lane<NTF)?KMg[2*lane]:0.f,(2*lane+1<NTF)?KMg[2*lane+1]:0.f);
    _Pragma("unroll") for(int o_=1;o_<64;o_<<=1)km=fmaxf(km,__shfl_xor(km,o_));
    float um=-INFINITY;
    _Pragma("unroll") for(int r_=0;r_<4;++r_){ const int i_=q0+4*lane+r_; um=fmaxf(um,QNg[i_]*km-DGg[i_]); }
    _Pragma("unroll") for(int o_=1;o_<64;o_<<=1)um=fmaxf(um,__shfl_xor(um,o_));
    const float ffirst=__shfl(pre0,2*qb)+Fg[q0];
    const bool keep0=!(um+(ffirst-pre1)*LOG2E_F<-ATT_TAU), keep1=!(um+(ffirst-s_)*LOG2E_F<-ATT_TAU);
    const unsigned long long m0=__ballot(keep0), m1=__ballot(keep1);
    const int f0=m0?2*(__ffsll((long long)m0)-1):128, f1=m1?2*(__ffsll((long long)m1)-1)+1:129;
    int ts_=(f0<f1?f0:f1)&~1; ts_=ts_<NTF-4?ts_:NTF-4; if(ts_<0)ts_=0;
    if(lane==0)((__attribute__((address_space(3))) int*)Fpre)[128]=ts_; }
  asm volatile("s_waitcnt lgkmcnt(0)\n\ts_barrier":::"memory");
  const int ts=__builtin_amdgcn_readfirstlane(((__attribute__((address_space(3))) int*)Fpre)[128]);
  const bf16*Kh=K+(rowbase+(long)ts*KVBLK)*DM+h*D,*Vh=V+(rowbase+(long)ts*KVBLK)*DM+h*D;
  const unsigned lds0=(unsigned)(uintptr_t)shm;
  float*wsf=(float*)(shm+LDS_WS)+wid*64;
  const bf16*ksrc=Kh+(long)lane*DM+wid*8;
  const bf16*vsrc=Vh+(long)(16*(wid&3)+(lane>>2))*DM+(wid>>2)*32+(lane&3)*8;
  const unsigned kdst=lds0+LDS_K+wid*1024, vdst=lds0+LDS_V+wid*1024;
  #define DMA_K(t,slot) glds16(ksrc+(long)(t)*KVBLK*DM,(unsigned)__builtin_amdgcn_readfirstlane(kdst+(slot)))
  #define DMA_V(t,slot) glds16(vsrc+(long)(t)*KVBLK*DM,(unsigned)__builtin_amdgcn_readfirstlane(vdst+(slot)))
  const int vb0=(int)(lds0+LDS_V)+((lane>>4)&1)*32+(lane&3)*8+(4*hi+((lane&15)>>2))*64;
  const char*Kbase=shm+LDS_K; bf16x8 kf[8];
  const lds_cptr shm3=(lds_cptr)shm; const lds_cptr kp0=shm3+LDS_K+hi*1024+r32*16; const lds_cptr vp0=shm3+LDS_V+((lane>>4)&1)*32+(lane&3)*8+(4*hi+((lane&15)>>2))*64;
  const int NT=NTF-ts;
  typedef float f32x4b __attribute__((ext_vector_type(4)));
  lds_f*const Fb3=(lds_f*)(shm3+LDS_FB);
  { for(int j=tid;j<NT*KVBLK;j+=NW*64){ const int ja=ts*KVBLK+j; Fb3[j]=-(Fg[ja]+Fpre[ja>>6])*LOG2E_F; } }
  #define INITB(P0,P1,t) do{ const lds_f*fb_=Fb3+(t)*KVBLK+4*hi; \
    _Pragma("unroll") for(int g_=0;g_<4;++g_){ const f32x4b b0_=*(const __attribute__((address_space(3))) f32x4b*)(fb_+8*g_), b1_=*(const __attribute__((address_space(3))) f32x4b*)(fb_+32+8*g_); \
      P0[4*g_]=b0_[0]-mhat;P0[4*g_+1]=b0_[1]-mhat;P0[4*g_+2]=b0_[2]-mhat;P0[4*g_+3]=b0_[3]-mhat; P1[4*g_]=b1_[0]-mhat;P1[4*g_+1]=b1_[1]-mhat;P1[4*g_+2]=b1_[2]-mhat;P1[4*g_+3]=b1_[3]-mhat; } }while(0)
  DMA_K(0,0);DMA_V(0,0);DMA_K(1,SLOTB);
  bf16x8 qr[4];
  #pragma unroll
  for(int d0=0;d0<4;++d0)qr[d0]=*reinterpret_cast<const bf16x8*>(&Qw[(long)r32*DM+d0*16+hi*8]);
  float mhat=0.f,l_reg=0.f;f32x16 o[2];o[0]=f32x16{};o[1]=f32x16{};
  const int qrel=wid*QBLK+r32;
  #define CMASK(P0,P1,t) do{int jb_=(t)-(NT-4); if(jb_>=0)cmask(P0,P1,jb_,qrel,hi);}while(0)
  bool resc=false;
  #define START(P0,P1) do{ const float rm=rowmax(P0,P1); resc=false; \
    { const float dl=rm; mhat=fadd_s(mhat,dl); \
      _Pragma("unroll") for(int r=0;r<16;++r){P0[r]=fsub_s(P0[r],dl);P1[r]=fsub_s(P1[r],dl);} } \
    _Pragma("unroll") for(int r=0;r<16;++r)P0[r]=__builtin_amdgcn_exp2f(P0[r]); }while(0)
  #define RESC() do{ if(resc){ asm volatile("s_waitcnt lgkmcnt(0)":::"memory"); \
      _Pragma("unroll") for(int d_=0;d_<2;++d_) _Pragma("unroll") for(int r=0;r<16;++r)o[d_][r]*=wsf[crow(r,hi)]; } }while(0)
  f32x16 pA0,pA1,pB0,pB1;
  int sl_prev=0,sl_cur=0,sl_next=SLOTB;
  #define ROT() do{sl_prev=sl_cur;sl_cur=sl_next;sl_next=(sl_next==(NSLOT-1)*SLOTB)?0:sl_next+SLOTB;}while(0)
  DMA_K(2,2*SLOTB);
  WAIT_BAR(3);
  asm volatile("s_waitcnt lgkmcnt(0)":::"memory"); INITB(pA0,pA1,0);
  qkt(pA0,pA1,Kbase,qr,r32,hi);asm volatile("s_nop 15\n\ts_nop 7":"+v"(pA0),"+v"(pA1));CMASK(pA0,pA1,0);
  START(pA0,pA1);
  _Pragma("unroll") for(int r=0;r<16;++r)pA1[r]=__builtin_amdgcn_exp2f(pA1[r]);
  WAIT_BAR(0);
  DMA_K(3,0);DMA_V(1,SLOTB);
  ROT();
  kload8(kf,kp0+sl_cur);
  INITB(pB0,pB1,1);
  WAIT_BAR(2);
  s16x4 vlo[8],vhi[8]; u32x4 pw0,pw1,pw2,pw3;
  #define PKW(P,B) cvtpk_s(P[B],P[B+1])
  #define PAF(k) __builtin_bit_cast(bf16x8,pw##k)
  #define VFR(i) (bf16x8){vlo[i][0],vlo[i][1],vlo[i][2],vlo[i][3],vhi[i][0],vhi[i][1],vhi[i][2],vhi[i][3]}
  #define PIN(x) asm volatile("":"+v"(x))
  #define MX3(a,b,c) __builtin_fmaxf(__builtin_fmaxf((a),(b)),(c))
  #define GAPA(MF,A0,A1,A2,A3,W0,W1,PW) do{ MF; sacc+=A0; sacc+=A1; sacc+=A2; sacc+=A3; PIN(sacc); W0; W1; PIN(PW); SBAR(); }while(0)
  #define EX(v) __builtin_amdgcn_exp2f(v)
  #define GAPB(MF,X,B) do{ MF; X[B]=EX(X[B]); X[B+1]=EX(X[B+1]); X[B+2]=EX(X[B+2]); X[B+3]=EX(X[B+3]); PIN(X); SBAR(); }while(0)
  #define VRD(i) do{ vlo[i]=vtr(vp_+(((i)>>2)*4096+((i)&3)*1024)); vhi[i]=vtr(vp_+(((i)>>2)*4096+((i)&3)*1024+512)); }while(0)
  #define KRD(G,j) do{ if(G){ kload2(kf,kp0+sl_next,j); SBAR(); } }while(0)
  #define STEP(C0,C1,P0,P1,t,GK,GV,GL) do{ SBAR(); \
    const lds_cptr vp_=vp0+sl_prev; \
    VRD(0); SBAR(); float sacc=(P0[0]+P0[1]); \
    GAPA(C0=__builtin_amdgcn_mfma_f32_32x32x16_bf16(kf[0],qr[0],C0,0,0,0), P0[2],P0[3],P0[4],P0[5],     pw0[0]=PKW(P0,0), pw0[1]=PKW(P0,2), pw0); \
    VRD(4); SBAR(); GAPA(C1=__builtin_amdgcn_mfma_f32_32x32x16_bf16(kf[1],qr[0],C1,0,0,0), P0[6],P0[7],P0[8],P0[9],     pw0[2]=PKW(P0,4), pw0[3]=PKW(P0,6), pw0); \
    VRD(1); SBAR(); GAPA(C0=__builtin_amdgcn_mfma_f32_32x32x16_bf16(kf[2],qr[1],C0,0,0,0),   P0[10],P0[11],P0[12],P0[13], pw1[0]=PKW(P0,8), pw1[1]=PKW(P0,10), pw1); \
    VRD(5); SBAR(); GAPA(C1=__builtin_amdgcn_mfma_f32_32x32x16_bf16(kf[3],qr[1],C1,0,0,0),   P0[14],P0[15],P1[0],P1[1],   pw1[2]=PKW(P0,12),pw1[3]=PKW(P0,14), pw1); \
    VRD(2); SBAR(); GAPA(C0=__builtin_amdgcn_mfma_f32_32x32x16_bf16(kf[4],qr[2],C0,0,0,0),   P1[2],P1[3],P1[4],P1[5],     pw2[0]=PKW(P1,0), pw2[1]=PKW(P1,2), pw2); \
    VRD(6); SBAR(); GAPA(C1=__builtin_amdgcn_mfma_f32_32x32x16_bf16(kf[5],qr[2],C1,0,0,0),   P1[6],P1[7],P1[8],P1[9],     pw2[2]=PKW(P1,4), pw2[3]=PKW(P1,6), pw2); \
    VRD(3); SBAR(); GAPA(C0=__builtin_amdgcn_mfma_f32_32x32x16_bf16(kf[6],qr[3],C0,0,0,0),   P1[10],P1[11],P1[12],P1[13], pw3[0]=PKW(P1,8), pw3[1]=PKW(P1,10), pw3); \
    VRD(7); SBAR(); GAPA(C1=__builtin_amdgcn_mfma_f32_32x32x16_bf16(kf[7],qr[3],C1,0,0,0),   P1[14],P1[15],0.f,0.f,       pw3[2]=PKW(P1,12),pw3[3]=PKW(P1,14), pw3); \
    l_reg+=sacc; \
    if(GK){DMA_K((t)+3,sl_cur);} if(GV){DMA_V((t)+1,sl_next);} \
    CMASK(C0,C1,t); \
    { float a=MX3(C0[0],C0[1],C1[0]),b=MX3(C0[2],C0[3],C1[1]); a=MX3(a,C1[2],C1[3]); \
      _Pragma("unroll") for(int r=4;r<16;r+=4){a=MX3(a,C0[r],C0[r+1]);b=MX3(b,C0[r+2],C0[r+3]);a=MX3(a,C1[r],C1[r+1]);b=MX3(b,C1[r+2],C1[r+3]);} \
      float rm=__builtin_fmaxf(a,b); { auto rr=__builtin_amdgcn_permlane32_swap(__float_as_uint(rm),__float_as_uint(rm),false,false); rm=__builtin_fmaxf(__uint_as_float(rr[0]),__uint_as_float(rr[1])); } \
      resc=false; \
      if(__builtin_expect(__any(rm>(float)THRL),0)){ const float dl=__builtin_fmaxf(rm,0.f); mhat+=dl; \
        _Pragma("unroll") for(int r=0;r<16;++r){C0[r]-=dl;C1[r]-=dl;} \
        const float f=__builtin_amdgcn_exp2f(-dl); l_reg*=f; if(hi==0)wsf[r32]=f; resc=true; } } \
    SBAR(); \
    GAPB(o[0]=__builtin_amdgcn_mfma_f32_32x32x16_bf16(PAF(0),VFR(0),o[0],0,0,0), C0,0); \
    GAPB(o[1]=__builtin_amdgcn_mfma_f32_32x32x16_bf16(PAF(0),VFR(4),o[1],0,0,0), C0,4); \
    KRD(GL,0); GAPB(o[0]=__builtin_amdgcn_mfma_f32_32x32x16_bf16(PAF(1),VFR(1),o[0],0,0,0), C0,8); \
    KRD(GL,1); GAPB(o[1]=__builtin_amdgcn_mfma_f32_32x32x16_bf16(PAF(1),VFR(5),o[1],0,0,0), C0,12); \
    KRD(GL,2); GAPB(o[0]=__builtin_amdgcn_mfma_f32_32x32x16_bf16(PAF(2),VFR(2),o[0],0,0,0), C1,0); \
    KRD(GL,3); GAPB(o[1]=__builtin_amdgcn_mfma_f32_32x32x16_bf16(PAF(2),VFR(6),o[1],0,0,0), C1,4); \
    GAPB(o[0]=__builtin_amdgcn_mfma_f32_32x32x16_bf16(PAF(3),VFR(3),o[0],0,0,0), C1,8); \
    GAPB(o[1]=__builtin_amdgcn_mfma_f32_32x32x16_bf16(PAF(3),VFR(7),o[1],0,0,0), C1,12); \
    if((t)+1<NT){ INITB(P0,P1,(t)+1); } \
    }while(0)
  int t=1;
  #undef CMASK
  #define CMASK(P0,P1,t) do{}while(0)
  for(;t+5<NT;t+=2){
    STEP(pB0,pB1,pA0,pA1,t,true,true,true);     WAIT_BAR(2); RESC(); ROT();
    STEP(pA0,pA1,pB0,pB1,t+1,true,true,true);   WAIT_BAR(2); RESC(); ROT();
  }
  #undef CMASK
  #define CMASK(P0,P1,t) do{int jb_=(t)-(NT-4); if(jb_>=0)cmask(P0,P1,jb_,qrel,hi);}while(0)
  #define ENDW(tt) do{ if((tt)+3<NT){WAIT_BAR(2);} else if((tt)+2<NT){WAIT_BAR(1);} else {WAIT_BAR(0);} }while(0)
  for(;t+1<NT;t+=2){
    STEP(pB0,pB1,pA0,pA1,t,(t+3<NT),(t+1<NT),(t+1<NT));       ENDW(t);   RESC(); ROT();
    STEP(pA0,pA1,pB0,pB1,t+1,(t+4<NT),(t+2<NT),(t+2<NT));     ENDW(t+1); RESC(); ROT();
  }
  STEP(pB0,pB1,pA0,pA1,NT-1,false,false,false); RESC();
  { float sacc=pB0[0]+pB0[1]; _Pragma("unroll") for(int r=2;r<16;++r)sacc+=pB0[r]; _Pragma("unroll") for(int r=0;r<16;++r)sacc+=pB1[r]; l_reg+=sacc;
    pw0=(u32x4){PKW(pB0,0),PKW(pB0,2),PKW(pB0,4),PKW(pB0,6)};pw1=(u32x4){PKW(pB0,8),PKW(pB0,10),PKW(pB0,12),PKW(pB0,14)};pw2=(u32x4){PKW(pB1,0),PKW(pB1,2),PKW(pB1,4),PKW(pB1,6)};pw3=(u32x4){PKW(pB1,8),PKW(pB1,10),PKW(pB1,12),PKW(pB1,14)};
    SBAR(); pv(o,vb0+sl_cur,PAF(0),PAF(1),PAF(2),PAF(3)); }
  #undef PKW
  #undef PAF
  #undef VFR
  #undef PIN
  #undef MX3
  #undef GAPA
  #undef GAPB
  #undef EX
  #undef VRD
  #undef KRD
  #undef STEP
  #undef ENDW
  {auto rr=__builtin_amdgcn_permlane32_swap(__float_as_uint(l_reg),__float_as_uint(l_reg),false,false);l_reg=__uint_as_float(rr[0])+__uint_as_float(rr[1]);}
  if(hi==0)wsf[32+r32]=l_reg;asm volatile("s_waitcnt lgkmcnt(0)":::"memory");
  float rli[16];
  #pragma unroll
  for(int r=0;r<16;++r)rli[r]=__builtin_amdgcn_rcpf(wsf[32+crow(r,hi)]);
  bf16*Ow=O+(rowbase+q0+wid*QBLK)*DO+h*D;
  { bf16*stg=(bf16*)(shm+LDS_OST)+wid*2048;
    #pragma unroll
    for(int r=0;r<16;++r){const int orow=crow(r,hi);
      #pragma unroll
      for(int d0=0;d0<2;++d0)stg[orow*64+d0*32+r32]=__float2bfloat16(o[d0][r]*rli[r]);}
    asm volatile("s_waitcnt lgkmcnt(0)":::"memory");
    #pragma unroll
    for(int i=0;i<4;++i){const int row=i*8+(lane>>3),ch=lane&7; const u32x4 v=*(const u32x4*)(stg+row*64+ch*8); ATTN_STORE16(Ow+(long)row*DO+ch*8,v);} }
  asm volatile("s_waitcnt lgkmcnt(0)\n\ts_barrier":::"memory");
  #undef INITB
  #undef DMA_K
  #undef DMA_V
  #undef CMASK
  #undef START
  #undef RESC
  #undef ROT
}
constexpr int ATTN_LDS_BYTES=LDS_BYTES;
struct AttnTensors { const bf16* Q; const bf16* K; const bf16* V; bf16* O; const float* F; const float* Ftot; const float* QN; const float* DG; const float* KM; };
struct AttnUnit { int bh; int qb; };
struct StaticOrder {
  int vcu,G;
  __device__ __forceinline__ explicit StaticOrder(int grid,int block):vcu((grid%8==0)?(block%8)*(grid/8)+block/8:block),G(grid){}
  __device__ __forceinline__ bool next(int i,AttnUnit&u)const{ const int idx=vcu+i*G; if(idx>=BATCH*NHEAD*NQB)return false; u.bh=idx>>5; u.qb=idx&31; return true; }
  __device__ __forceinline__ void a_ready(const AttnUnit&)const{}
  __device__ __forceinline__ void done(const AttnUnit&)const{}
};
template<class Sched,int THRL=8> __device__ __forceinline__ void attn_phase(char*lds,const AttnTensors&T,const Sched&S){
  AttnUnit u;
  for(int i=0;S.next(i,u);++i){ S.a_ready(u); attn_unit<THRL>(u.bh/NHEAD,u.bh%NHEAD,u.qb,T.Q,T.K,T.V,T.O,T.F+(size_t)u.bh*SEQ,T.Ftot+u.bh*128,T.QN+(size_t)u.bh*SEQ,T.DG+(size_t)u.bh*SEQ,T.KM+u.bh*128,lds); S.done(u); }
}
#undef SBAR
#undef WAIT_BAR
}

#define LAS __attribute__((address_space(3)))
#define GAS __attribute__((address_space(1)))
typedef unsigned short bf16;
typedef float f32x4 __attribute__((ext_vector_type(4)));
typedef unsigned v4u __attribute__((ext_vector_type(4)));
typedef unsigned v2u __attribute__((ext_vector_type(2)));
constexpr int NB_ = 2, SEQ = 8192, M = NB_ * SEQ, D = 1024, DIN = 2820, NPJ = 2816, NL = 4, NE = 32, TOPK = 4, CAP = pg8::MOE_CAP;
constexpr float LN_EPS = 1e-5f, ALPHA = 1.6817928305074290f  , LOG2E = 1.4426950408889634f;
constexpr int NWAVES = 8, NTHR = 512, LDS_BYTES = 147456, RING_BYTES = 131072, LDSCTL_OFF = RING_BYTES;
constexpr int C_RQ = 0, C_RK = 128, C_RV = 256, C_RG = 512, C_CA = 768, C_CB = 1024, C_SB = 1280, C_SC = 1536, C_SH = 1792, C_FQ = 2048, C_FK = 2304, C_FV = 2560, C_FF = 2816;

constexpr size_t MiB = 1u << 20;
constexpr size_t WS_CTL = 0, CTL_ZERO_BYTES = 1 * MiB;
constexpr size_t WS_ROPE = 1 * MiB;
constexpr size_t WS_LOGF = 2 * MiB;
constexpr size_t WS_F = 3 * MiB;
constexpr size_t WS_FTOT = 3 * MiB + 512 * 1024;
constexpr size_t WS_KMX = 3 * MiB + 768 * 1024;
constexpr size_t WS_QN = 56 * MiB;
constexpr size_t WS_DG = 57 * MiB;
constexpr size_t WS_TK = 4 * MiB;
constexpr size_t WS_GATE = 6 * MiB;
constexpr size_t WS_WIN = 8 * MiB;
constexpr size_t WS_WO = 32 * MiB;
constexpr size_t WS_WR = 52 * MiB;
constexpr size_t WS_KV = 40 * MiB;
constexpr size_t WS_PREV = 48 * MiB;
constexpr size_t WS_XB = 64 * MiB;
constexpr size_t WS_X1B = 96 * MiB;
constexpr size_t WS_MIXED = 128 * MiB;
constexpr size_t WS_XF = 160 * MiB;
constexpr size_t WS_X1 = 224 * MiB;
constexpr size_t WS_MIX = 288 * MiB;
constexpr size_t WS_PROJ = 352 * MiB;
constexpr size_t WS_Y4 = 448 * MiB;
constexpr size_t WS_W1 = 576 * MiB;
constexpr size_t WS_W2 = 1088 * MiB;
constexpr size_t WS_ACT = 1344 * MiB;
constexpr size_t WS_END = 2368 * MiB;
constexpr int CW_CURSOR = 1024;
constexpr int CW_BAR = 4096;

__device__ __forceinline__ float bf2f(unsigned v) { return __uint_as_float(v << 16); }
__device__ __forceinline__ unsigned f2bf(float f) { unsigned u = __float_as_uint(f); return (u + 0x7fffu + ((u >> 16) & 1u)) >> 16; }
__device__ __forceinline__ unsigned pk2(float lo, float hi) { return f2bf(lo) | (f2bf(hi) << 16); }
#define LDS_WAIT() asm volatile("s_waitcnt lgkmcnt(0)" ::: "memory")
__device__ __forceinline__ float wave_sum(float v) {
#pragma unroll
    for (int o = 1; o < 64; o <<= 1) v += __shfl_xor(v, o);
    return v;
}
__device__ __forceinline__ float wave_max(float v) {
#pragma unroll
    for (int o = 1; o < 64; o <<= 1) v = fmaxf(v, __shfl_xor(v, o));
    return v;
}

struct Params {
    const float* in[20]; float* out; unsigned char* ws;
};

#define XB_TMO      128
#define XB_XCNT(j)  (256  + 64 * (j))
#define XB_XSUB(j)  (1280 + 64 * (j))
#define XB_XGEN(j)  (2304 + 64 * (j))
#define XB_TOP      3328
#define XB_TOPGEN   3392
#define XCD_BAR_WORDS 3456
#define XB_SPIN_CAP (1u << 18)

__device__ __forceinline__ unsigned xb_ld(unsigned* p)              { return __hip_atomic_load(p, __ATOMIC_RELAXED, __HIP_MEMORY_SCOPE_AGENT); }
__device__ __forceinline__ unsigned xb_add(unsigned* p, unsigned v) { return __hip_atomic_fetch_add(p, v, __ATOMIC_RELAXED, __HIP_MEMORY_SCOPE_AGENT); }
__device__ __forceinline__ unsigned xb_xcc_id() { return (unsigned)__builtin_amdgcn_s_getreg((3 << 11) | 20) & 0xFu; }
#define XB_SPIN(cond, bar) do { unsigned _sp = 0; while (cond) { __builtin_amdgcn_s_sleep(1); \
    if ((++_sp & 255u) == 0u) { if (xb_ld(&(bar)[XB_TMO])) break; if (_sp > XB_SPIN_CAP) { atomicAdd(&(bar)[XB_TMO], 1u); break; } } } } while (0)

struct XcdBarrier {
    unsigned* bar; unsigned x;
    volatile LAS unsigned* st;
};

__device__ __forceinline__ XcdBarrier xcd_barrier_post(unsigned* bar, volatile LAS unsigned* st) {
    XcdBarrier b; b.bar = bar; b.x = xb_xcc_id(); b.st = st;
    if (threadIdx.x == 0) (void)xb_add(&bar[XB_XCNT(b.x)], 1u);
    return b;
}
__device__ __forceinline__ void xcd_barrier_complete(unsigned* bar, unsigned x, unsigned& nloc, unsigned& nx) {
    const unsigned G = gridDim.x * gridDim.y * gridDim.z;
    unsigned sum, cnt, mine, sp = 0u;
    for (;;) {
        sum = 0u; cnt = 0u; mine = 0u;
#pragma unroll
        for (unsigned j = 0; j < 16; ++j) { const unsigned c = xb_ld(&bar[XB_XCNT(j)]); sum += c; cnt += (c > 0u) ? 1u : 0u; mine = (j == x) ? c : mine; }
        if (sum == G) break;
        __builtin_amdgcn_s_sleep(1);
        if ((++sp & 255u) == 0u) { if (xb_ld(&bar[XB_TMO])) break; if (sp > XB_SPIN_CAP) { atomicAdd(&bar[XB_TMO], 1u); break; } }
    }
    nloc = mine > 0u ? mine : 1u; nx = cnt > 0u ? cnt : 1u;
}

__device__ __forceinline__ void xcd_barrier(const XcdBarrier& b) {
    asm volatile("s_waitcnt vmcnt(0)" ::: "memory");
    __syncthreads();
    if (threadIdx.x == 0) {
        unsigned* bar = b.bar;
        __builtin_amdgcn_s_waitcnt(0);
        unsigned nloc = b.st[0], nx = b.st[1];
        if (nloc == 0u) { xcd_barrier_complete(bar, b.x, nloc, nx); b.st[0] = nloc; b.st[1] = nx; }
        const unsigned old = xb_add(&bar[XB_XSUB(b.x)], 1u);
        const unsigned gen = old / nloc;
        if (old + 1u == (gen + 1u) * nloc) {
            __builtin_amdgcn_fence(__ATOMIC_RELEASE, "agent");
            asm volatile("s_waitcnt vmcnt(0)" ::: "memory");
            const unsigned og = xb_add(&bar[XB_TOP], 1u);
            const unsigned tg = og / nx;
            if (og + 1u == (tg + 1u) * nx) xb_add(&bar[XB_TOPGEN], 1u);
            else XB_SPIN(xb_ld(&bar[XB_TOPGEN]) == tg, bar);
            __builtin_amdgcn_fence(__ATOMIC_ACQUIRE, "agent");
            xb_add(&bar[XB_XGEN(b.x)], 1u);
            asm volatile("s_waitcnt vmcnt(0)" ::: "memory");
        } else {
            XB_SPIN(xb_ld(&bar[XB_XGEN(b.x)]) == gen, bar);
            __builtin_amdgcn_fence(__ATOMIC_ACQUIRE, "agent");
            asm volatile("s_waitcnt vmcnt(0)" ::: "memory");
        }
    }
    __syncthreads();
}

__device__ __forceinline__ void transpose_item(const float* W, size_t ldw, bf16* WT, int Kd, int k0, int n0, int drow0, LAS float* scr, int lane) {
#pragma unroll 8
    for (int i = 0; i < 32; ++i) { const int kk = 2 * i + (lane >> 5); scr[kk * 33 + (lane & 31)] = W[(size_t)(k0 + kk) * ldw + n0 + (lane & 31)]; }
    LDS_WAIT(); asm volatile("" ::: "memory");
    const int c = lane & 7;
#pragma unroll
    for (int j = 0; j < 4; ++j) { const int n = (lane >> 3) + 8 * j; const LAS float* s = scr + (8 * c) * 33 + n;
        v4u o; o.x = pk2(s[0 * 33], s[1 * 33]); o.y = pk2(s[2 * 33], s[3 * 33]); o.z = pk2(s[4 * 33], s[5 * 33]); o.w = pk2(s[6 * 33], s[7 * 33]);
        *(GAS v4u*)(WT + (size_t)(drow0 + n) * Kd + k0 + 8 * c) = o; }
    LDS_WAIT(); asm volatile("" ::: "memory");
}
__device__ __forceinline__ float log_sigmoid(float z) { return fminf(z, 0.f) - log1pf(expf(-fabsf(z))); }
__device__ __forceinline__ void row_logf(const f32x4 (&v)[4], const float* w_in_l, const float* fox_b_l, float* logf_row, int lane) {
    float a0 = 0.f, a1 = 0.f, a2 = 0.f, a3 = 0.f;
#pragma unroll
    for (int j = 0; j < 4; ++j)
#pragma unroll
        for (int q = 0; q < 4; ++q) { const int k = 256 * j + 4 * lane + q; const f32x4 w = *(const f32x4*)(w_in_l + (size_t)k * DIN + C_FF); const float xv = v[j][q];
            a0 += xv * w[0]; a1 += xv * w[1]; a2 += xv * w[2]; a3 += xv * w[3]; }
    a0 = wave_sum(a0); a1 = wave_sum(a1); a2 = wave_sum(a2); a3 = wave_sum(a3);
    if (lane == 0) { f32x4 o; o[0] = log_sigmoid(a0 + fox_b_l[0]); o[1] = log_sigmoid(a1 + fox_b_l[1]); o[2] = log_sigmoid(a2 + fox_b_l[2]); o[3] = log_sigmoid(a3 + fox_b_l[3]); *(f32x4*)logf_row = o; }
}
__device__ __forceinline__ void phase_prologue(const Params& p, LAS unsigned char* lds, const int G, const int blk) {
    const int tid = tid_fresh(), lane = tid & 63, wave = tid >> 6;
    LAS float* scr = (LAS float*)((LAS unsigned char*)lds + wave * 16384);
    const int gw = blk * NWAVES + wave, NGW = G * NWAVES;
    unsigned char* ws = p.ws;
    constexpr int I_IN = 16 * 88, I_O = 16 * 32, I_W1 = 32 * 16 * 64, I_W2 = 32 * 16 * 32, I_L = I_IN + I_O + I_W1 + I_W2;
    for (int it = gw; it < NL * I_L; it += NGW) {
        const int l = it / I_L; int r = it % I_L;
        if (r < I_IN) { const int kb = r / 88, nb = r % 88; transpose_item(p.in[1] + (size_t)l * D * DIN, DIN, (bf16*)(ws + WS_WIN) + (size_t)l * NPJ * D, D, 64 * kb, 32 * nb, 32 * nb, scr, lane); continue; } r -= I_IN;
        if (r < I_O) { const int kb = r / 32, nb = r % 32; transpose_item(p.in[9] + (size_t)l * D * D, D, (bf16*)(ws + WS_WO) + (size_t)l * D * D, D, 64 * kb, 32 * nb, 32 * nb, scr, lane); continue; } r -= I_O;
        if (r < I_W1) { const int e = r / 1024, q = r % 1024, kb = q / 64, nb = q % 64, n0 = 32 * nb, s = n0 >> 10, c0 = n0 & 1023, drow0 = 256 * (c0 >> 7) + 128 * s + (c0 & 127);
            transpose_item(p.in[14] + ((size_t)l * NE + e) * D * 2048, 2048, (bf16*)(ws + WS_W1) + ((size_t)l * NE + e) * 2048 * D, D, 64 * kb, n0, drow0, scr, lane); continue; } r -= I_W1;
        { const int e = r / 512, q = r % 512, kb = q / 32, nb = q % 32;
            transpose_item(p.in[16] + ((size_t)l * NE + e) * D * D, D, (bf16*)(ws + WS_W2) + ((size_t)l * NE + e) * D * D, D, 64 * kb, 32 * nb, 32 * nb, scr, lane); }
    }
    for (int idx = blk * NTHR + tid; idx < NL * NE * D; idx += G * NTHR) { const int l = idx / (NE * D), r = idx % (NE * D), e = r / D, k = r % D;
        const float w = p.in[12][((size_t)l * D + k) * NE + e]; const unsigned h = f2bf(w); bf16* o = (bf16*)(ws + WS_WR) + (size_t)l * 2 * NE * D + (size_t)e * D + k; o[0] = (bf16)h; o[NE * D] = (bf16)f2bf(w - bf2f(h)); }
    for (int idx = blk * NTHR + tid; idx < SEQ * 16; idx += G * NTHR) { const int pos = idx >> 4, i = idx & 15;
        const float freq = powf(10000.0f, -(float)i / 16.0f); const float ang = (float)pos * freq; const double a = (double)ang;
        float* cs = (float*)(ws + WS_ROPE) + 2 * idx; cs[0] = (float)cos(a); cs[1] = (float)sin(a); }
    for (int m = gw; m < M; m += NGW) {
        const GAS f32x4* xr = (const GAS f32x4*)(p.in[0] + (size_t)m * D) + lane; f32x4 v[4];
#pragma unroll
        for (int j = 0; j < 4; ++j) v[j] = xr[64 * j];
        GAS v2u* o8 = (GAS v2u*)((bf16*)(ws + WS_XB) + (size_t)m * D) + lane;
#pragma unroll
        for (int j = 0; j < 4; ++j) { v2u w; w.x = pk2(v[j][0], v[j][1]); w.y = pk2(v[j][2], v[j][3]); o8[64 * j] = w; }
        row_logf(v, p.in[1], p.in[2], (float*)(ws + WS_LOGF) + (size_t)m * 4, lane);
    }
}

struct EpiProj {
    static constexpr bool PERM = true, AFTER_DRAIN = false;
    bf16* O;
    __device__ __forceinline__ void operator()(const pg8::f32x4 (&acc)[2][2][4][2], const pg8::Unit& u, int wr, int wc, int fr, int fq) const {
        const float sc = (u.pn == 8) ? attn_body::C2 : 1.0f;
        bf16* base = O + (size_t)(u.pm * 256 + wr * 64 + fr) * NPJ + u.pn * 256 + wc * 32 + 8 * fq;
#pragma unroll
        for (int ai = 0; ai < 2; ++ai)
#pragma unroll
            for (int m = 0; m < 4; ++m)
#pragma unroll
                for (int bj = 0; bj < 2; ++bj) { const pg8::f32x4 v0 = acc[ai][bj][m][0] * sc, v1 = acc[ai][bj][m][1] * sc;
                    pg8::u32x4 w; w.x = pg8::cvt_pk_bf16(v0[0], v0[1]); w.y = pg8::cvt_pk_bf16(v0[2], v0[3]); w.z = pg8::cvt_pk_bf16(v1[0], v1[1]); w.w = pg8::cvt_pk_bf16(v1[2], v1[3]);
                    *(pg8::u32x4*)(base + (size_t)(ai * 128 + m * 16) * NPJ + bj * 128) = w; }
    }
};
__device__ __forceinline__ void phase_attn(const Params& p, LAS unsigned char* lds, const int G, const int blk) {
    const bf16* proj = (const bf16*)(p.ws + WS_PROJ);
    const attn_body::AttnTensors AT{(const attn_body::bf16*)(proj + C_FQ), (const attn_body::bf16*)(proj + C_FK), (const attn_body::bf16*)(proj + C_FV), (attn_body::bf16*)((bf16*)(p.ws + WS_MIXED) + 768), (const float*)(p.ws + WS_F), (const float*)(p.ws + WS_FTOT), (const float*)(p.ws + WS_QN), (const float*)(p.ws + WS_DG), (const float*)(p.ws + WS_KMX)};
    const attn_body::StaticOrder S(G, blk);
    attn_body::attn_phase<attn_body::StaticOrder>((char*)lds, AT, S);
}
__device__ __forceinline__ void phase_inproj(const Params& p, int l, LAS unsigned char* lds, const int G, const int blk) {
    pg8::Gemm g{(const bf16*)(p.ws + WS_XB), (const bf16*)(p.ws + WS_WIN) + (size_t)l * NPJ * D, M, NPJ, D}; pg8::StaticOrder S; S.init(M, NPJ, G, (int)blk);
    EpiProj E{(bf16*)(p.ws + WS_PROJ)};
    pg8::gemm_phase<EpiProj, pg8::StaticOrder, true, true>((LAS unsigned char*)lds, g, S, E);
}
__device__ __forceinline__ void phase_outproj(const Params& p, int l, LAS unsigned char* lds, const int G, const int blk) {
    pg8::Gemm g{(const bf16*)(p.ws + WS_MIXED), (const bf16*)(p.ws + WS_WO) + (size_t)l * D * D, M, D, D}; pg8::StaticOrder S; S.init(M, D, G, (int)blk);
    pg8::EpiF32 E{(float*)(p.ws + WS_MIX), D, nullptr};
    pg8::gemm_phase<pg8::EpiF32, pg8::StaticOrder, true, true>((LAS unsigned char*)lds, g, S, E);
}
__device__ __forceinline__ void moe_table(LAS int* tp, LAS int* cnt, const unsigned* cursor) {
    const int tidm = tid_fresh();
    if (tidm < 32) cnt[tidm] = (int)__hip_atomic_load(cursor + tidm, __ATOMIC_RELAXED, __HIP_MEMORY_SCOPE_AGENT);
    __syncthreads();
    if (tidm == 0) { int s = 0; for (int e = 0; e < 32; ++e) { tp[e] = s; s += (cnt[e] + 255) >> 8; } tp[32] = s; }
    __syncthreads();
}
__device__ __forceinline__ void phase_gemm1(const Params& p, int l, LAS unsigned char* lds, const int G, const int blk) {
    LAS int* tp = (LAS int*)((LAS unsigned char*)lds + LDSCTL_OFF + 1024); LAS int* cnt = tp + 64;
    moe_table(tp, cnt, (const unsigned*)(p.ws + WS_CTL) + CW_CURSOR + 32 * l);
    pg8::MoeSched S{tp, cnt, 8, G, blk};
    pg8::EpiSwiglu E{(bf16*)(p.ws + WS_ACT), p.in[15] + (size_t)l * NE * 2048};
    pg8::gemm_phase_moe<pg8::EpiSwiglu, true>((LAS unsigned char*)lds, (const bf16*)(p.ws + WS_X1B), (const bf16*)(p.ws + WS_W1) + (size_t)l * NE * 2048 * D, D, 2048, (const int*)(p.ws + WS_TK), S, E);
}
__device__ __forceinline__ void phase_gemm2(const Params& p, int l, LAS unsigned char* lds, const int G, const int blk) {
    LAS int* tp = (LAS int*)((LAS unsigned char*)lds + LDSCTL_OFF + 1024); LAS int* cnt = tp + 64;
    moe_table(tp, cnt, (const unsigned*)(p.ws + WS_CTL) + CW_CURSOR + 32 * l);
    pg8::MoeSched S{tp, cnt, 4, G, blk};
    pg8::EpiGateScatter E{(bf16*)(p.ws + WS_Y4), p.in[17] + (size_t)l * NE * D, (const int*)(p.ws + WS_TK), (const float*)(p.ws + WS_GATE)};
    pg8::gemm_phase_moe<pg8::EpiGateScatter, false>((LAS unsigned char*)lds, (const bf16*)(p.ws + WS_ACT), (const bf16*)(p.ws + WS_W2) + (size_t)l * NE * D * D, D, 1024, nullptr, S, E);
}

__device__ __forceinline__ void conv_unit(const Params& p, int l, LAS unsigned char* lds, int b, int c) {
    const int tid = tid_fresh(), lane = tid & 63, wave = tid >> 6;
    LAS float* us = (LAS float*)lds;
    const bf16* proj = (const bf16*)(p.ws + WS_PROJ); bf16* mixed = (bf16*)(p.ws + WS_MIXED);
    const size_t row0 = (size_t)b * SEQ + 64 * c;
    for (int it = tid; it < 94 * 32; it += NTHR) { const int tk = it >> 5, cg = it & 31, pos = 64 * c - 30 + tk; f32x4 o0 = {0.f, 0.f, 0.f, 0.f}, o1 = o0;
        if (pos >= 0) { const bf16* src = proj + ((size_t)b * SEQ + pos) * NPJ + 8 * cg; const v4u a = *(const v4u*)(src + C_CA), g = *(const v4u*)(src + C_CB);
            const unsigned aw[4] = {a.x, a.y, a.z, a.w}, gw[4] = {g.x, g.y, g.z, g.w}; float r[8];
#pragma unroll
            for (int q = 0; q < 4; ++q) { const float a0 = bf2f(aw[q] & 0xffffu), a1 = bf2f(aw[q] >> 16), g0 = bf2f(gw[q] & 0xffffu), g1 = bf2f(gw[q] >> 16);
                r[2 * q] = a0 * pg8::sigmoid_fast(g0); r[2 * q + 1] = a1 * pg8::sigmoid_fast(g1); }
            o0 = (f32x4){r[0], r[1], r[2], r[3]}; o1 = (f32x4){r[4], r[5], r[6], r[7]}; }
        *(LAS f32x4*)(us + tk * 256 + 8 * cg) = o0; *(LAS f32x4*)(us + tk * 256 + 8 * cg + 4) = o1; }
    __syncthreads();
    const int ch = tid & 255, half = tid >> 8;
    { const float* dw = p.in[3] + (size_t)l * 31 * 256 + ch; float w[31];
#pragma unroll
      for (int k = 0; k < 31; ++k) w[k] = dw[k * 256];
      const float bias = p.in[4][l * 256 + ch]; float acc[32];
#pragma unroll
      for (int i = 0; i < 32; ++i) acc[i] = bias;
#pragma unroll
      for (int j = 0; j < 62; ++j) { const float uv = us[(32 * half + j) * 256 + ch];
#pragma unroll
          for (int i = 0; i < 32; ++i) if (j - i >= 0 && j - i <= 30) acc[i] += w[j - i] * uv; }
      __syncthreads();
#pragma unroll
      for (int i = 0; i < 32; ++i) us[(32 * half + i) * 256 + ch] = acc[i]; }
    __syncthreads();
    { const f32x4 lg = *(const f32x4*)(p.in[5] + l * 256 + 4 * lane), lb = *(const f32x4*)(p.in[6] + l * 256 + 4 * lane);
#pragma unroll
      for (int r = 0; r < 8; ++r) { const int tok = 8 * wave + r; f32x4 v = *(const LAS f32x4*)(us + tok * 256 + 4 * lane);
          const float mean = wave_sum((v[0] + v[1]) + (v[2] + v[3])) * (1.0f / 256.0f); v = v - mean;
          const float rstd = rsqrtf(wave_sum((v[0] * v[0] + v[1] * v[1]) + (v[2] * v[2] + v[3] * v[3])) * (1.0f / 256.0f) + LN_EPS);
          f32x4 y = v * rstd * lg + lb;
#pragma unroll
          for (int q = 0; q < 4; ++q) y[q] = y[q] * pg8::sigmoid_fast(y[q]);
          v2u o; o.x = pk2(y[0], y[1]); o.y = pk2(y[2], y[3]); *(GAS v2u*)(mixed + (row0 + tok) * D + 256 + 4 * lane) = o; } }
    __syncthreads();
}
__device__ __forceinline__ void shortconv_logf_unit(const Params& p, int l, LAS unsigned char* lds, int b, int c) {
    const int tid = tid_fresh(), lane = tid & 63, wave = tid >> 6;
    const bf16* proj = (const bf16*)(p.ws + WS_PROJ); bf16* mixed = (bf16*)(p.ws + WS_MIXED); const float* sw = p.in[7] + (size_t)l * 3 * 256;
    const size_t row0 = (size_t)b * SEQ + 64 * c;
    for (int it = tid; it < 64 * 32; it += NTHR) { const int tok = it >> 5, cg = it & 31, pos = 64 * c + tok; float acc[8];
#pragma unroll
        for (int q = 0; q < 8; ++q) acc[q] = 0.f;
#pragma unroll
        for (int j = 0; j < 3; ++j) { if (pos - 2 + j >= 0) { const bf16* src = proj + (row0 + tok - 2 + j) * NPJ + 8 * cg; const v4u cc = *(const v4u*)(src + C_SC), hh = *(const v4u*)(src + C_SH);
                const f32x4 w0 = *(const f32x4*)(sw + j * 256 + 8 * cg), w1 = *(const f32x4*)(sw + j * 256 + 8 * cg + 4); const float wv[8] = {w0[0], w0[1], w0[2], w0[3], w1[0], w1[1], w1[2], w1[3]};
                const unsigned cw[4] = {cc.x, cc.y, cc.z, cc.w}, hw[4] = {hh.x, hh.y, hh.z, hh.w};
#pragma unroll
                for (int q = 0; q < 4; ++q) { acc[2 * q] += wv[2 * q] * (bf2f(cw[q] & 0xffffu) * bf2f(hw[q] & 0xffffu)); acc[2 * q + 1] += wv[2 * q + 1] * (bf2f(cw[q] >> 16) * bf2f(hw[q] >> 16)); } } }
        const v4u bb = *(const v4u*)(proj + (row0 + tok) * NPJ + C_SB + 8 * cg); const unsigned bw[4] = {bb.x, bb.y, bb.z, bb.w}; v4u o; unsigned ow[4];
#pragma unroll
        for (int q = 0; q < 4; ++q) ow[q] = pk2(bf2f(bw[q] & 0xffffu) * acc[2 * q], bf2f(bw[q] >> 16) * acc[2 * q + 1]);
        o.x = ow[0]; o.y = ow[1]; o.z = ow[2]; o.w = ow[3]; *(GAS v4u*)(mixed + (row0 + tok) * D + 512 + 8 * cg) = o; }
    LAS float* kn_s = (LAS float*)lds;
    if (tid < 256) { const int tok = tid >> 2, h = tid & 3; const bf16* qs = proj + (row0 + tok) * NPJ + C_FQ + h * 64; const bf16* ks = proj + (row0 + tok) * NPJ + C_FK + h * 64; float qq = 0.f, kk = 0.f, qk = 0.f;
#pragma unroll
        for (int g = 0; g < 8; ++g) { const v4u qv = *(const v4u*)(qs + 8 * g), kv = *(const v4u*)(ks + 8 * g); const unsigned qw[4] = {qv.x, qv.y, qv.z, qv.w}, kw[4] = {kv.x, kv.y, kv.z, kv.w};
#pragma unroll
            for (int q = 0; q < 4; ++q) { const float q0 = bf2f(qw[q] & 0xffffu), q1 = bf2f(qw[q] >> 16), k0 = bf2f(kw[q] & 0xffffu), k1 = bf2f(kw[q] >> 16); qq += q0 * q0 + q1 * q1; kk += k0 * k0 + k1 * k1; qk += q0 * k0 + q1 * k1; } }
        ((float*)(p.ws + WS_QN))[(size_t)(b * 4 + h) * SEQ + 64 * c + tok] = sqrtf(qq) * 1.0001f; ((float*)(p.ws + WS_DG))[(size_t)(b * 4 + h) * SEQ + 64 * c + tok] = qk; kn_s[tok * 4 + h] = sqrtf(kk) * 1.0001f; }
    __syncthreads();
    if (tid < 4) { float mxk = 0.f; for (int t = 0; t < 64; ++t) mxk = fmaxf(mxk, kn_s[t * 4 + tid]); ((float*)(p.ws + WS_KMX))[(b * 4 + tid) * 128 + c] = mxk; }
    __syncthreads();
    if (wave == 0) { const f32x4 lf = *(const f32x4*)((const float*)(p.ws + WS_LOGF) + (row0 + lane) * 4); float v[4] = {lf[0], lf[1], lf[2], lf[3]};
#pragma unroll
        for (int o = 1; o < 64; o <<= 1) {
#pragma unroll
            for (int h = 0; h < 4; ++h) { const float t = __shfl_up(v[h], o); if (lane >= o) v[h] += t; } }
#pragma unroll
        for (int h = 0; h < 4; ++h) { ((float*)(p.ws + WS_F))[(size_t)(b * 4 + h) * SEQ + 64 * c + lane] = v[h]; if (lane == 63) ((float*)(p.ws + WS_FTOT))[(b * 4 + h) * 128 + c] = v[h]; } }
}
namespace ret {
typedef short bf16x8 __attribute__((ext_vector_type(8)));
typedef short bf16x4 __attribute__((ext_vector_type(4)));
typedef float f32x16 __attribute__((ext_vector_type(16)));
constexpr int QP = 40, VP = 68, KTP = 72;
constexpr int PAIR_BYTES = 24576;
constexpr int OFF_Q = 0, OFF_K = 5120, OFF_V = 10240, OFF_P = 18944, OFF_KT = 0;
constexpr int WS_KV_FLOATS = NB_ * 128 * 4 * 2048;
__device__ __forceinline__ int crow(int r, int hi) { return (r & 3) + 8 * (r >> 2) + 4 * hi; }
__device__ __forceinline__ float lg2_gamma(int h) { return log2f(1.0f - exp2f(-5.0f - (float)h)); }
__device__ __forceinline__ void rope8(const bf16* src, const float* cs, int dd0, float sc, float (&o1)[8], float (&o2)[8]) {
    const v4u lo = *(const v4u*)(src + dd0), hi = *(const v4u*)(src + 16 + dd0);
    const f32x4 c0 = *(const f32x4*)(cs), c1 = *(const f32x4*)(cs + 4), c2 = *(const f32x4*)(cs + 8), c3 = *(const f32x4*)(cs + 12);
    const float cv[16] = {c0[0], c0[1], c0[2], c0[3], c1[0], c1[1], c1[2], c1[3], c2[0], c2[1], c2[2], c2[3], c3[0], c3[1], c3[2], c3[3]};
    const unsigned lw[4] = {lo.x, lo.y, lo.z, lo.w}, hw[4] = {hi.x, hi.y, hi.z, hi.w};
#pragma unroll
    for (int i = 0; i < 8; ++i) { const float x1 = (i & 1) ? bf2f(lw[i >> 1] >> 16) : bf2f(lw[i >> 1] & 0xffffu), x2 = (i & 1) ? bf2f(hw[i >> 1] >> 16) : bf2f(hw[i >> 1] & 0xffffu);
        const float c = cv[2 * i], s = cv[2 * i + 1]; o1[i] = (x1 * c - x2 * s) * sc; o2[i] = (x1 * s + x2 * c) * sc; }
}
__device__ __forceinline__ void stage_vt(const bf16* proj, size_t row0, int h, LAS bf16* Vt, int tp) {
    const int m = tp >> 1, e0 = (tp & 1) * 32; const bf16* src = proj + (row0 + m) * NPJ + C_RV + h * 64 + e0;
#pragma unroll
    for (int q = 0; q < 4; ++q) { const v4u w = *(const v4u*)(src + 8 * q); const unsigned ww[4] = {w.x, w.y, w.z, w.w};
#pragma unroll
        for (int i = 0; i < 8; ++i) Vt[(e0 + 8 * q + i) * VP + m] = (bf16)((i & 1) ? (ww[i >> 1] >> 16) : (ww[i >> 1] & 0xffffu)); }
}
__device__ __forceinline__ bf16x8 ld_vt8(const LAS bf16* p) {
    const bf16x4 a = *(const LAS bf16x4*)p, b = *(const LAS bf16x4*)(p + 4); return (bf16x8){a[0], a[1], a[2], a[3], b[0], b[1], b[2], b[3]};
}
__device__ __forceinline__ void phase_kv(const Params& p, LAS unsigned char* lds, int nblk, int blk) {
    const int tid = tid_fresh(), lane = tid & 63, wave = tid >> 6, pw = wave >> 1, sw = wave & 1, tp = tid & 127, r32 = lane & 31, hi = lane >> 5;
    const bf16* proj = (const bf16*)(p.ws + WS_PROJ); const float* rope = (const float*)(p.ws + WS_ROPE); float* kvT = (float*)(p.ws + WS_KV);
    LAS unsigned char* base = lds + pw * PAIR_BYTES; LAS bf16* KdT = (LAS bf16*)(base + OFF_KT); LAS bf16* Vt = (LAS bf16*)(base + OFF_V);
    for (int u0 = blk * 4; u0 < NB_ * 128 * 4; u0 += nblk * 4) {
        const int unit = u0 + pw, h = unit & 3, bc = unit >> 2, c = bc & 127, b = bc >> 7; const size_t row0 = (size_t)b * SEQ + 64 * c;
        const float lg = lg2_gamma(h);
        { const int m = tp >> 1, dd0 = (tp & 1) * 8; float o1[8], o2[8];
          rope8(proj + (row0 + m) * NPJ + C_RK + h * 32, rope + ((size_t)(64 * c + m) * 16 + dd0) * 2, dd0, 0.17677669529663687f * exp2f(lg * (float)(63 - m)), o1, o2);
#pragma unroll
          for (int i = 0; i < 8; ++i) { KdT[(dd0 + i) * KTP + m] = (bf16)f2bf(o1[i]); KdT[(16 + dd0 + i) * KTP + m] = (bf16)f2bf(o2[i]); } }
        stage_vt(proj, row0, h, Vt, tp);
        __syncthreads();
        f32x16 acc = {};
#pragma unroll
        for (int ks = 0; ks < 4; ++ks) { const bf16x8 a = ld_vt8(Vt + (32 * sw + r32) * VP + 16 * ks + 8 * hi); const bf16x8 bq = *(const LAS bf16x8*)(KdT + r32 * KTP + 16 * ks + 8 * hi);
            acc = __builtin_amdgcn_mfma_f32_32x32x16_bf16(a, bq, acc, 0, 0, 0); }
        float* dst = kvT + (size_t)unit * 2048 + r32;
#pragma unroll
        for (int r = 0; r < 16; ++r) dst[(32 * sw + crow(r, hi)) * 32] = acc[r];
        __syncthreads();
    }
}
__device__ __forceinline__ void phase_scan(const Params& p, LAS unsigned char* lds, int nblk, int blk) {
    const int tid = tid_fresh(), elem = tid & 63, seg = tid >> 6;
    const float* kvT = (const float*)(p.ws + WS_KV); bf16* prevT = (bf16*)(p.ws + WS_PREV); LAS float* agg = (LAS float*)lds;
    for (int blkid = blk; blkid < 256; blkid += nblk) {
        const int bh = blkid >> 5, b = bh >> 2, h = bh & 3, el = (blkid & 31) * 64 + elem;
        const float Dk = exp2f(64.0f * lg2_gamma(h));
        float kv[16];
#pragma unroll
        for (int j = 0; j < 16; ++j) kv[j] = kvT[((size_t)((b * 128 + 16 * seg + j) * 4 + h)) * 2048 + el];
        float loc[17]; loc[0] = 0.f;
#pragma unroll
        for (int j = 0; j < 16; ++j) loc[j + 1] = Dk * loc[j] + kv[j];
        agg[seg * 64 + elem] = loc[16];
        __syncthreads();
        const float D16 = exp2f(1024.0f * lg2_gamma(h)); float sin_ = 0.f;
        for (int s2 = 0; s2 < seg; ++s2) sin_ = D16 * sin_ + agg[s2 * 64 + elem];
        float dj = 1.0f;
#pragma unroll
        for (int j = 0; j < 16; ++j) { prevT[((size_t)((b * 128 + 16 * seg + j) * 4 + h)) * 2048 + el] = (bf16)f2bf(dj * sin_ + loc[j]); dj *= Dk; }
        __syncthreads();
    }
}
__device__ __forceinline__ void phase_out(const Params& p, int l, LAS unsigned char* lds, int nblk, int blk) {
    const int tid = tid_fresh(), lane = tid & 63, wave = tid >> 6, pw = wave >> 1, sw = wave & 1, tp = tid & 127, r32 = lane & 31, hi = lane >> 5;
    const bf16* proj = (const bf16*)(p.ws + WS_PROJ); const float* rope = (const float*)(p.ws + WS_ROPE); const bf16* prevT = (const bf16*)(p.ws + WS_PREV); bf16* mixed = (bf16*)(p.ws + WS_MIXED);
    const float* gng = p.in[8] + l * 256;
    LAS unsigned char* base = lds + pw * PAIR_BYTES; LAS bf16* Qs = (LAS bf16*)(base + OFF_Q); LAS bf16* Ks = (LAS bf16*)(base + OFF_K); LAS bf16* Vt = (LAS bf16*)(base + OFF_V); LAS bf16* Ps = (LAS bf16*)(base + OFF_P);
    for (int u0 = blk * 4; u0 < NB_ * 128 * 4; u0 += nblk * 4) {
        const int unit = u0 + pw, h = unit & 3, bc = unit >> 2, c = bc & 127, b = bc >> 7; const size_t row0 = (size_t)b * SEQ + 64 * c;
        const float lg = lg2_gamma(h);
        { const int m = tp >> 1, dd0 = (tp & 1) * 8; float o1[8], o2[8]; const float* cs = rope + ((size_t)(64 * c + m) * 16 + dd0) * 2;
          rope8(proj + (row0 + m) * NPJ + C_RQ + h * 32, cs, dd0, 1.0f, o1, o2);
          v4u w; w.x = pk2(o1[0], o1[1]); w.y = pk2(o1[2], o1[3]); w.z = pk2(o1[4], o1[5]); w.w = pk2(o1[6], o1[7]); *(LAS v4u*)(Qs + m * QP + dd0) = w;
          w.x = pk2(o2[0], o2[1]); w.y = pk2(o2[2], o2[3]); w.z = pk2(o2[4], o2[5]); w.w = pk2(o2[6], o2[7]); *(LAS v4u*)(Qs + m * QP + 16 + dd0) = w;
          rope8(proj + (row0 + m) * NPJ + C_RK + h * 32, cs, dd0, 0.17677669529663687f, o1, o2);
          w.x = pk2(o1[0], o1[1]); w.y = pk2(o1[2], o1[3]); w.z = pk2(o1[4], o1[5]); w.w = pk2(o1[6], o1[7]); *(LAS v4u*)(Ks + m * QP + dd0) = w;
          w.x = pk2(o2[0], o2[1]); w.y = pk2(o2[2], o2[3]); w.z = pk2(o2[4], o2[5]); w.w = pk2(o2[6], o2[7]); *(LAS v4u*)(Ks + m * QP + 16 + dd0) = w;
          const bf16* ps = prevT + (size_t)unit * 2048 + (tp >> 1) * 32 + (tp & 1) * 16; const v4u p0 = *(const v4u*)ps, p1 = *(const v4u*)(ps + 8);
          *(LAS v4u*)(Ps + (tp >> 1) * QP + (tp & 1) * 16) = p0; *(LAS v4u*)(Ps + (tp >> 1) * QP + (tp & 1) * 16 + 8) = p1; }
        stage_vt(proj, row0, h, Vt, tp);
        __syncthreads();
        const int n = 32 * sw + r32;
        bf16x8 qf[2];
#pragma unroll
        for (int s = 0; s < 2; ++s) qf[s] = *(const LAS bf16x8*)(Qs + n * QP + 16 * s + 8 * hi);
        f32x16 acc[2];
#pragma unroll
        for (int eb = 0; eb < 2; ++eb) { acc[eb] = (f32x16){};
#pragma unroll
            for (int s = 0; s < 2; ++s) { const bf16x8 a = *(const LAS bf16x8*)(Ps + (32 * eb + r32) * QP + 16 * s + 8 * hi); acc[eb] = __builtin_amdgcn_mfma_f32_32x32x16_bf16(a, qf[s], acc[eb], 0, 0, 0); } }
        const float qd = exp2f(lg * (float)(n + 1));
#pragma unroll
        for (int eb = 0; eb < 2; ++eb)
#pragma unroll
            for (int r = 0; r < 16; ++r) acc[eb][r] *= qd;
#pragma unroll
        for (int mb = 0; mb < 2; ++mb) {
            f32x16 st = {};
#pragma unroll
            for (int s = 0; s < 2; ++s) { const bf16x8 a = *(const LAS bf16x8*)(Ks + (32 * mb + r32) * QP + 16 * s + 8 * hi); st = __builtin_amdgcn_mfma_f32_32x32x16_bf16(a, qf[s], st, 0, 0, 0); }
#pragma unroll
            for (int r = 0; r < 16; ++r) { const int m = 32 * mb + crow(r, hi); const int dist = n > m ? n - m : m - n; st[r] *= exp2f(lg * (float)dist); }
#pragma unroll
            for (int pp = 0; pp < 2; ++pp) {
                v4u pk; pk.x = pk2(st[8 * pp + 0], st[8 * pp + 1]); pk.y = pk2(st[8 * pp + 2], st[8 * pp + 3]); pk.z = pk2(st[8 * pp + 4], st[8 * pp + 5]); pk.w = pk2(st[8 * pp + 6], st[8 * pp + 7]);
                const bf16x8 pf = __builtin_bit_cast(bf16x8, pk);
#pragma unroll
                for (int eb = 0; eb < 2; ++eb) { const LAS bf16* vp = Vt + (32 * eb + r32) * VP + 32 * mb + 16 * pp + 4 * hi;
                    const bf16x4 a0 = *(const LAS bf16x4*)vp, a1 = *(const LAS bf16x4*)(vp + 8); const bf16x8 af = (bf16x8){a0[0], a0[1], a0[2], a0[3], a1[0], a1[1], a1[2], a1[3]};
                    acc[eb] = __builtin_amdgcn_mfma_f32_32x32x16_bf16(af, pf, acc[eb], 0, 0, 0); } }
        }
        float s1 = 0.f;
#pragma unroll
        for (int eb = 0; eb < 2; ++eb)
#pragma unroll
            for (int r = 0; r < 16; ++r) s1 += acc[eb][r];
        s1 += __shfl_xor(s1, 32); const float mean = s1 * (1.0f / 64.0f); float s2 = 0.f;
#pragma unroll
        for (int eb = 0; eb < 2; ++eb)
#pragma unroll
            for (int r = 0; r < 16; ++r) { const float d = acc[eb][r] - mean; s2 += d * d; }
        s2 += __shfl_xor(s2, 32); const float rstd = rsqrtf(s2 * (1.0f / 64.0f) + LN_EPS);
        const size_t trow = row0 + n;
#pragma unroll
        for (int eb = 0; eb < 2; ++eb)
#pragma unroll
            for (int g = 0; g < 4; ++g) { const int e0 = 32 * eb + 8 * g + 4 * hi; const f32x4 gn = *(const f32x4*)(gng + h * 64 + e0);
                const v2u gw = *(const v2u*)(proj + trow * NPJ + C_RG + h * 64 + e0); const float gt[4] = {bf2f(gw.x & 0xffffu), bf2f(gw.x >> 16), bf2f(gw.y & 0xffffu), bf2f(gw.y >> 16)}; float y[4];
#pragma unroll
                for (int q = 0; q < 4; ++q) { const float sg = gt[q] / (1.0f + __expf(-gt[q])); y[q] = (acc[eb][4 * g + q] - mean) * rstd * gn[q] * sg; }
                v2u o; o.x = pk2(y[0], y[1]); o.y = pk2(y[2], y[3]); *(v2u*)(mixed + trow * D + h * 64 + e0) = o; }
        __syncthreads();
    }
}
}

__device__ __forceinline__ void phase_local(const Params& p, int l, LAS unsigned char* lds, const int G, const int blk) {
    for (int ch = blk; ch < NB_ * 128; ch += G) { conv_unit(p, l, lds, ch >> 7, ch & 127); shortconv_logf_unit(p, l, lds, ch >> 7, ch & 127); }
}
constexpr int RT_PITCH = 36;
__device__ __forceinline__ void ln1_two_rows(const float* xin, const float* mix, float* x1, bf16* x1b, const float* g1, const float* b1, int t, int lane) {
    f32x4 v[2][4]; float s[2] = {0.f, 0.f};
#pragma unroll
    for (int r2 = 0; r2 < 2; ++r2) { const GAS f32x4* xr = (const GAS f32x4*)(xin + (size_t)(t + r2) * D) + lane; const GAS f32x4* mr = (const GAS f32x4*)(mix + (size_t)(t + r2) * D) + lane;
#pragma unroll
        for (int j = 0; j < 4; ++j) { v[r2][j] = xr[64 * j] * ALPHA + mr[64 * j]; } }
#pragma unroll
    for (int r2 = 0; r2 < 2; ++r2) {
#pragma unroll
        for (int j = 0; j < 4; ++j) s[r2] += (v[r2][j][0] + v[r2][j][1]) + (v[r2][j][2] + v[r2][j][3]);
        const float mean = wave_sum(s[r2]) * (1.0f / D); float s2 = 0.f;
#pragma unroll
        for (int j = 0; j < 4; ++j) { v[r2][j] = v[r2][j] - mean; s2 += (v[r2][j][0] * v[r2][j][0] + v[r2][j][1] * v[r2][j][1]) + (v[r2][j][2] * v[r2][j][2] + v[r2][j][3] * v[r2][j][3]); }
        const float rstd = rsqrtf(wave_sum(s2) * (1.0f / D) + LN_EPS);
#pragma unroll
        for (int j = 0; j < 4; ++j) { const f32x4 gg = *(const f32x4*)(g1 + 256 * j + 4 * lane), bb = *(const f32x4*)(b1 + 256 * j + 4 * lane); const f32x4 y = v[r2][j] * rstd * gg + bb;
            ((GAS f32x4*)(x1 + (size_t)(t + r2) * D))[64 * j + lane] = y; v2u w; w.x = pk2(y[0], y[1]); w.y = pk2(y[2], y[3]); ((GAS v2u*)(x1b + (size_t)(t + r2) * D))[64 * j + lane] = w; } }
}
__device__ __forceinline__ void phase_ln1_router(const Params& p, int l, LAS unsigned char* lds, const int G, const int blk) {
    typedef short bf16x8 __attribute__((ext_vector_type(8)));
    const int tid = tid_fresh(), lane = tid & 63, wave = tid >> 6;
    LAS float* part = (LAS float*)lds;
    LAS int* sel_e = (LAS int*)(lds + 32768); LAS float* sel_g = (LAS float*)(lds + 32768 + 1024);
    LAS int* wcnt = (LAS int*)(lds + 32768 + 2048);
    LAS int* ebase = (LAS int*)(lds + 32768 + 2048 + 512);
    const float* xin = (l == 0) ? p.in[0] : (const float*)(p.ws + WS_XF);
    const float* mix = (const float*)(p.ws + WS_MIX);
    float* x1 = (float*)(p.ws + WS_X1); bf16* x1b = (bf16*)(p.ws + WS_X1B);
    const float* g1 = p.in[10] + l * D; const float* b1 = p.in[11] + l * D; const float* rb = p.in[13] + l * NE;
    const bf16* wrh = (const bf16*)(p.ws + WS_WR) + (size_t)l * 2 * NE * D; const bf16* wrl = wrh + NE * D;
    unsigned* cursor = (unsigned*)(p.ws + WS_CTL) + CW_CURSOR + 32 * l;
    for (int t0 = blk * 64; t0 < M; t0 += G * 64) {
        for (int pair = 0; pair < 4; ++pair) ln1_two_rows(xin, mix, x1, x1b, g1, b1, t0 + wave * 8 + pair * 2, lane);
        __syncthreads();
        { const int tg = wave & 3, kh = wave >> 2, fr = lane & 15, fq = lane >> 4;
          const float* xr = x1 + (size_t)(t0 + 16 * tg + fr) * D + kh * 512 + 8 * fq;
          const bf16* wh0 = wrh + (size_t)fr * D + kh * 512 + 8 * fq; const bf16* wl0 = wrl + (size_t)fr * D + kh * 512 + 8 * fq;
          pg8::f32x4 acc0 = {0.f, 0.f, 0.f, 0.f}, acc1 = {0.f, 0.f, 0.f, 0.f};
#pragma unroll 4
          for (int ks = 0; ks < 16; ++ks) {
              const f32x4 xa = *(const f32x4*)(xr + 32 * ks), xb = *(const f32x4*)(xr + 32 * ks + 4);
              const bf16x8 h0 = *(const bf16x8*)(wh0 + 32 * ks), h1 = *(const bf16x8*)(wh0 + 16 * D + 32 * ks), l0 = *(const bf16x8*)(wl0 + 32 * ks), l1 = *(const bf16x8*)(wl0 + 16 * D + 32 * ks);
              const float xv[8] = {xa[0], xa[1], xa[2], xa[3], xb[0], xb[1], xb[2], xb[3]}; unsigned hw[4], lw[4];
#pragma unroll
              for (int q = 0; q < 4; ++q) { const unsigned b0 = f2bf(xv[2 * q]), b1_ = f2bf(xv[2 * q + 1]); hw[q] = b0 | (b1_ << 16); lw[q] = pk2(xv[2 * q] - bf2f(b0), xv[2 * q + 1] - bf2f(b1_)); }
              const v4u hv = {hw[0], hw[1], hw[2], hw[3]}, lv = {lw[0], lw[1], lw[2], lw[3]};
              const bf16x8 xh = __builtin_bit_cast(bf16x8, hv), xl = __builtin_bit_cast(bf16x8, lv);
              acc0 = __builtin_amdgcn_mfma_f32_16x16x32_bf16(h0, xh, acc0, 0, 0, 0); acc0 = __builtin_amdgcn_mfma_f32_16x16x32_bf16(h0, xl, acc0, 0, 0, 0); acc0 = __builtin_amdgcn_mfma_f32_16x16x32_bf16(l0, xh, acc0, 0, 0, 0);
              acc1 = __builtin_amdgcn_mfma_f32_16x16x32_bf16(h1, xh, acc1, 0, 0, 0); acc1 = __builtin_amdgcn_mfma_f32_16x16x32_bf16(h1, xl, acc1, 0, 0, 0); acc1 = __builtin_amdgcn_mfma_f32_16x16x32_bf16(l1, xh, acc1, 0, 0, 0);
          }
          LAS float* dst = part + (kh * 64 + 16 * tg + fr) * RT_PITCH + 4 * fq;
          *(LAS f32x4*)dst = acc0; *(LAS f32x4*)(dst + 16) = acc1; }
        __syncthreads();
        if (tid < 64) {
            float v[32];
#pragma unroll
            for (int e4 = 0; e4 < 8; ++e4) { const f32x4 a = *(const LAS f32x4*)(part + tid * RT_PITCH + 4 * e4), b = *(const LAS f32x4*)(part + (64 + tid) * RT_PITCH + 4 * e4), c = *(const f32x4*)(rb + 4 * e4);
                v[4 * e4] = a[0] + b[0] + c[0]; v[4 * e4 + 1] = a[1] + b[1] + c[1]; v[4 * e4 + 2] = a[2] + b[2] + c[2]; v[4 * e4 + 3] = a[3] + b[3] + c[3]; }
            unsigned taken = 0u; float tv[4]; int ti[4];
#pragma unroll
            for (int r = 0; r < 4; ++r) { float best = -INFINITY; int bi = 0;
#pragma unroll
                for (int e = 0; e < 32; ++e) { const float c = ((taken >> e) & 1u) ? -INFINITY : v[e]; if (c > best) { best = c; bi = e; } }
                taken |= 1u << bi; tv[r] = best; ti[r] = bi; }
            const float e1 = expf(tv[1] - tv[0]), e2 = expf(tv[2] - tv[0]), e3 = expf(tv[3] - tv[0]); const float inv = 1.0f / (1.0f + e1 + e2 + e3);
            sel_e[tid * 4 + 0] = ti[0]; sel_e[tid * 4 + 1] = ti[1]; sel_e[tid * 4 + 2] = ti[2]; sel_e[tid * 4 + 3] = ti[3];
            sel_g[tid * 4 + 0] = inv; sel_g[tid * 4 + 1] = e1 * inv; sel_g[tid * 4 + 2] = e2 * inv; sel_g[tid * 4 + 3] = e3 * inv;
        }
        __syncthreads();
        int mye = 0, myrank = 0;
        if (wave < 4) { mye = sel_e[tid];
            for (int e2 = 0; e2 < 32; ++e2) { const unsigned long long bal = __ballot(mye == e2); if (mye == e2) myrank = __popcll(bal & ((1ull << lane) - 1ull)); if (lane == 0) wcnt[wave * 32 + e2] = __popcll(bal); } }
        __syncthreads();
        if (tid < 32) { const int tot = wcnt[tid] + wcnt[32 + tid] + wcnt[64 + tid] + wcnt[96 + tid]; ebase[tid] = tot ? (int)atomicAdd(cursor + tid, (unsigned)tot) : 0; }
        __syncthreads();
        if (wave < 4) { int pos = ebase[mye] + myrank; for (int w = 0; w < wave; ++w) pos += wcnt[w * 32 + mye];
            ((int*)(p.ws + WS_TK))[(size_t)mye * CAP + pos] = t0 * 4 + tid; ((float*)(p.ws + WS_GATE))[(size_t)mye * CAP + pos] = sel_g[tid]; }
        __syncthreads();
    }
}
__device__ __forceinline__ void phase_ln2(const Params& p, int l, LAS unsigned char* lds, const int G, const int blk) {
    const int tid = tid_fresh(), lane = tid & 63, wave = tid >> 6;
    const int gw = blk * NWAVES + wave, NGW = G * NWAVES;
    const float* x1 = (const float*)(p.ws + WS_X1); const bf16* y4 = (const bf16*)(p.ws + WS_Y4);
    float* xo = (l == NL - 1) ? p.out : (float*)(p.ws + WS_XF); bf16* xb = (bf16*)(p.ws + WS_XB);
    const float* g2 = p.in[18] + l * D; const float* b2 = p.in[19] + l * D;
    for (int t = gw; t < M; t += NGW) {
        f32x4 v[4]; float s = 0.f;
#pragma unroll
        for (int j = 0; j < 4; ++j) { v[j] = ((const GAS f32x4*)(x1 + (size_t)t * D))[64 * j + lane] * ALPHA;
#pragma unroll
            for (int k = 0; k < 4; ++k) { const v2u w = ((const GAS v2u*)(y4 + ((size_t)t * 4 + k) * D))[64 * j + lane];
                v[j][0] += bf2f(w.x & 0xffffu); v[j][1] += bf2f(w.x >> 16); v[j][2] += bf2f(w.y & 0xffffu); v[j][3] += bf2f(w.y >> 16); }
            s += (v[j][0] + v[j][1]) + (v[j][2] + v[j][3]); }
        const float mean = wave_sum(s) * (1.0f / D); float s2 = 0.f;
#pragma unroll
        for (int j = 0; j < 4; ++j) { v[j] = v[j] - mean; s2 += (v[j][0] * v[j][0] + v[j][1] * v[j][1]) + (v[j][2] * v[j][2] + v[j][3] * v[j][3]); }
        const float rstd = rsqrtf(wave_sum(s2) * (1.0f / D) + LN_EPS);
#pragma unroll
        for (int j = 0; j < 4; ++j) { const f32x4 gg = *(const f32x4*)(g2 + 256 * j + 4 * lane), bb = *(const f32x4*)(b2 + 256 * j + 4 * lane); v[j] = v[j] * rstd * gg + bb;
            ((GAS f32x4*)(xo + (size_t)t * D))[64 * j + lane] = v[j]; }
        if (l < NL - 1) {
#pragma unroll
            for (int j = 0; j < 4; ++j) { v2u w; w.x = pk2(v[j][0], v[j][1]); w.y = pk2(v[j][2], v[j][3]); ((GAS v2u*)(xb + (size_t)t * D))[64 * j + lane] = w; }
            row_logf(v, p.in[1] + (size_t)(l + 1) * D * DIN, p.in[2] + (l + 1) * 4, (float*)(p.ws + WS_LOGF) + (size_t)t * 4, lane);
        }
    }
}

typedef __attribute__((address_space(4))) const Params* kparams_t;
__device__ __forceinline__ Params params_fresh() {
    Params r{};
#if defined(__HIP_DEVICE_COMPILE__)
    kparams_t k = (kparams_t)__builtin_amdgcn_kernarg_segment_ptr(); asm volatile("" : "+s"(k));
#pragma unroll
    for (int i = 0; i < 20; ++i) r.in[i] = k->in[i];
    r.out = k->out; r.ws = k->ws;
#endif
    return r;
}
#ifndef MK_CUT
#define MK_CUT 0
#endif
struct Args { Params p; int s_lo, s_hi; };
__global__ void __launch_bounds__(NTHR, 2) fwd(Args a_arg) {
    extern __shared__ __attribute__((aligned(16))) unsigned char lds_raw[];
    LAS unsigned char* lds = (LAS unsigned char*)lds_raw;
    const int G = gridDim.x, blk = blockIdx.x, s_lo = a_arg.s_lo, s_hi = a_arg.s_hi;
    { const int tid = tid_fresh(); for (int u = tid; u < (LDS_BYTES - LDSCTL_OFF) / 4; u += NTHR) ((LAS unsigned*)(lds + LDSCTL_OFF))[u] = 0u; }
    __syncthreads();
    if (!MK_CUT) { const Params p = params_fresh(); (void)xcd_barrier_post((unsigned*)(p.ws + WS_CTL) + CW_BAR, (volatile LAS unsigned*)(lds + LDSCTL_OFF + 352)); }
#ifndef MK_REPEAT
#define MK_REPEAT 0
#endif
#define PH(call) do { const Params p = params_fresh(); call; } while (0)
#define PHR(bit, call) do { PH(call); if (MK_REPEAT & (1 << (bit))) { __syncthreads(); PH(call); } } while (0)
#define SEAM(s) do { if ((s) + 1 < s_hi) { const Params p = params_fresh(); XcdBarrier b_; b_.bar = (unsigned*)(p.ws + WS_CTL) + CW_BAR; b_.x = xb_xcc_id(); b_.st = (volatile LAS unsigned*)(lds + LDSCTL_OFF + 352); xcd_barrier(b_); } } while (0)
#define IN(s) (s_lo <= (s) && (s) < s_hi)
    if (IN(0)) { PHR(0, phase_prologue(p, lds, G, blk)); SEAM(0); }
    for (int l = 0; l < NL; ++l) {
        const int s0 = 1 + 9 * l;
        if (IN(s0 + 0)) { PHR(1, phase_inproj(p, l, lds, G, blk)); SEAM(s0 + 0); }
        if (IN(s0 + 1)) { PHR(2, ret::phase_kv(p, lds, G, blk)); PHR(3, phase_local(p, l, lds, G, blk)); SEAM(s0 + 1); }
        if (IN(s0 + 2)) { PHR(2, ret::phase_scan(p, lds, G, blk)); PHR(4, phase_attn(p, lds, G, blk)); SEAM(s0 + 2); }
        if (IN(s0 + 3)) { PHR(2, ret::phase_out(p, l, lds, G, blk)); SEAM(s0 + 3); }
        if (IN(s0 + 4)) { PHR(5, phase_outproj(p, l, lds, G, blk)); SEAM(s0 + 4); }
        if (IN(s0 + 5)) { PH(phase_ln1_router(p, l, lds, G, blk)); SEAM(s0 + 5); }
        if (IN(s0 + 6)) { PHR(6, phase_gemm1(p, l, lds, G, blk)); SEAM(s0 + 6); }
        if (IN(s0 + 7)) { PHR(7, phase_gemm2(p, l, lds, G, blk)); SEAM(s0 + 7); }
        if (IN(s0 + 8)) { PHR(8, phase_ln2(p, l, lds, G, blk)); SEAM(s0 + 8); }
    }
#undef PH
#undef PHR
#undef SEAM
#undef IN
}

extern "C" void kernel_launch(void* const* d_in, const int* in_sizes, int n_in, void* d_out, int out_size, void* d_ws, size_t ws_size, hipStream_t stream) {
    static int grid = 0;
    if (grid == 0) {
        if (n_in != 20 || in_sizes[0] != M * D || out_size != M * D || ws_size < WS_END) { fprintf(stderr, "kernel_launch: unexpected shapes / workspace (n_in %d, in0 %d, out %d, ws %zu, need %zu)\n", n_in, n_in > 0 ? in_sizes[0] : -1, out_size, ws_size, (size_t)WS_END); grid = -1; return; }
        int dev = 0, cus = 0, per_cu = 0;
        if (hipGetDevice(&dev) != hipSuccess || hipDeviceGetAttribute(&cus, hipDeviceAttributeMultiprocessorCount, dev) != hipSuccess) { grid = -1; return; }
        if (hipFuncSetAttribute((const void*)fwd, hipFuncAttributeMaxDynamicSharedMemorySize, LDS_BYTES) != hipSuccess) { fprintf(stderr, "kernel_launch: hipFuncSetAttribute failed\n"); grid = -1; return; }
        if (hipOccupancyMaxActiveBlocksPerMultiprocessor(&per_cu, (const void*)fwd, NTHR, LDS_BYTES) != hipSuccess || per_cu < 1) { fprintf(stderr, "kernel_launch: occupancy query reports %d blocks per CU\n", per_cu); per_cu = 1; }
        (void)hipGetLastError();
        grid = cus;
    }
    if (grid < 0) return;
    (void)hipMemsetAsync((char*)d_ws + WS_CTL, 0, CTL_ZERO_BYTES, stream);
    Args a{};
    for (int i = 0; i < 20; ++i) a.p.in[i] = (const float*)d_in[i];
    a.p.out = (float*)d_out; a.p.ws = (unsigned char*)d_ws;
    constexpr int NSTEP = 1 + 9 * NL;
#if MK_CUT
    for (int s = 0; s < NSTEP; ++s) { a.s_lo = s; a.s_hi = s + 1; hipLaunchKernelGGL(fwd, dim3(grid), dim3(NTHR), LDS_BYTES, stream, a); }
#else
    a.s_lo = 0; a.s_hi = NSTEP;
    hipLaunchKernelGGL(fwd, dim3(grid), dim3(NTHR), LDS_BYTES, stream, a);
#endif
}
```
